# Optimizing an MI355X kernel written in HIP

```python
import jax, jax.numpy as jnp
from jax import lax
import numpy as np

D_MODEL = 1024
BATCH = 8
SEQ = 4096
DEPTH = 2

HEAD_DIM = 64
N_MIXERS = 4
GROUP_WIDTH = D_MODEL // N_MIXERS
N_GROUP_HEADS = GROUP_WIDTH // HEAD_DIM
MIX_WIDTH = N_MIXERS * GROUP_WIDTH
N_IN_SLICES = 13
IN_WIDTH = N_IN_SLICES * GROUP_WIDTH
DILATED_PAIRS = ((128, 1), (512, 4), (2048, 16))
ATT_BLOCK = 128
SGU_CHUNK = 128
POOL_SIZES = (2, 4, 8, 16)
POOL_CH = GROUP_WIDTH // len(POOL_SIZES)
RET_CHUNK = 128
NORM_EPS = 1e-6

kernel_name = "hymba_hybrid_dilated_sgu_pool_retention"


def _rms_norm(x, g):
    xf = x.astype(jnp.float32)
    y = xf * lax.rsqrt(jnp.mean(xf * xf, axis=-1, keepdims=True) + NORM_EPS)
    return (y * g.astype(jnp.float32)).astype(x.dtype)


def _layer_norm(x, g):
    xf = x.astype(jnp.float32)
    mu = jnp.mean(xf, axis=-1, keepdims=True)
    var = jnp.mean(jnp.square(xf - mu), axis=-1, keepdims=True)
    return ((xf - mu) * lax.rsqrt(var + NORM_EPS) * g.astype(jnp.float32)).astype(x.dtype)


def _alibi_slopes(n):
    return jnp.exp2(-8.0 * (jnp.arange(n, dtype=jnp.float32) + 1.0) / n)


def _dilated_branch(q, k, v, window, dil, slopes):
    b, h, s, hd = q.shape
    span = dil * ATT_BLOCK
    s_pad = -(-s // span) * span
    L = s_pad // dil
    nb = L // ATT_BLOCK

    def stride_blocks(t):
        t = jnp.pad(t, ((0, 0), (0, 0), (0, s_pad - s), (0, 0))).reshape(b, h, L, dil, hd)
        return jnp.swapaxes(t, 2, 3).reshape(b, h, dil, nb, ATT_BLOCK, hd)

    def with_prev(t):
        prev = jnp.pad(t[:, :, :, :-1], ((0, 0), (0, 0), (0, 0), (1, 0), (0, 0), (0, 0)))
        return jnp.concatenate([prev, t], axis=4)

    qb = stride_blocks(q)
    kc = with_prev(stride_blocks(k))
    vc = with_prev(stride_blocks(v))
    scores = jnp.einsum('bhrnqd,bhrnkd->bhrnqk', qb, kc).astype(jnp.float32) * (hd ** -0.5)
    qi = jnp.arange(ATT_BLOCK)[:, None]
    ki = jnp.arange(2 * ATT_BLOCK)[None, :]
    dist = qi + ATT_BLOCK - ki
    band = (dist >= 0) & (dist <= window // dil)
    valid = (jnp.arange(nb)[:, None] * ATT_BLOCK + ki - ATT_BLOCK) >= 0
    mask = band[None, :, :] & valid[:, None, :]
    bias = -slopes[:, None, None, None, None] * (dist * dil).astype(jnp.float32)
    scores = jnp.where(mask, scores + bias, -jnp.inf)
    m = jnp.max(scores, axis=-1, keepdims=True)
    p = jnp.exp(scores - m)
    den = jnp.sum(p, axis=-1, keepdims=True)
    o = jnp.einsum('bhrnqk,bhrnkd->bhrnqd', (p / den).astype(v.dtype), vc)
    lse = (m + jnp.log(den))[..., 0]

    def unstride(t):
        tail = t.shape[5:]
        t = t.reshape(b, h, dil, L, *tail)
        return jnp.swapaxes(t, 2, 3).reshape(b, h, s_pad, *tail)[:, :, :s]

    return unstride(o), unstride(lse)


def _dilated_mixture(q, k, v):
    slopes = _alibi_slopes(q.shape[1])
    outs, lses = [], []
    for window, dil in DILATED_PAIRS:
        o, lse = _dilated_branch(q, k, v, window, dil, slopes)
        outs.append(o)
        lses.append(lse)
    w = jax.nn.softmax(jnp.stack(lses), axis=0)
    o = jnp.einsum('gbhs,gbhsd->bhsd', w.astype(v.dtype), jnp.stack(outs))
    b, h, s, hd = o.shape
    return o.transpose(0, 2, 1, 3).reshape(b, s, h * hd)


def _spatial_gating(u, v, norm_g, w_s, b_s):
    b, s, _ = u.shape
    v = _layer_norm(v, norm_g)
    nc = s // SGU_CHUNK
    v = v.reshape(b, nc, SGU_CHUNK, N_GROUP_HEADS, HEAD_DIM)
    causal = jnp.tril(jnp.ones((SGU_CHUNK, SGU_CHUNK), dtype=bool))
    w = jnp.where(causal, w_s, 0.0)
    mixed = jnp.einsum('gts,bcsgd->bctgd', w, v) + b_s.T[:, :, None]
    return u * mixed.reshape(b, s, GROUP_WIDTH)


def _multiscale_pool(xc, pool_w, pool_scale):
    b, s, _ = xc.shape
    xg = xc.reshape(b, s, len(POOL_SIZES), POOL_CH)
    csum = jnp.pad(lax.cumsum(xg.astype(jnp.float32), axis=1), ((0, 0), (1, 0), (0, 0), (0, 0)))
    t = jnp.arange(s)
    pooled = []
    for g, p in enumerate(POOL_SIZES):
        lo = jnp.maximum(t + 1 - p, 0)
        win_sum = csum[:, 1:, g] - csum[:, lo, g]
        cnt = jnp.minimum(t + 1, p).astype(jnp.float32)
        pooled.append(win_sum / cnt[None, :, None])
    pooled = jnp.stack(pooled, axis=2).astype(xc.dtype) - xg
    y = jnp.einsum('bsgc,gcd->bsgd', pooled, pool_w)
    return y.reshape(b, s, GROUP_WIDTH) * pool_scale


def _retention(q, k, v, norm_g):
    b, s, _ = q.shape
    H, C = N_GROUP_HEADS, RET_CHUNK
    n = s // C

    def chunks(t):
        return t.reshape(b, n, C, H, HEAD_DIM).transpose(0, 3, 1, 2, 4)

    q, k, v = chunks(q), chunks(k) * (HEAD_DIM ** -0.5), chunks(v)
    log_g = jnp.log(1.0 - jnp.exp2(-5.0 - jnp.arange(H, dtype=jnp.float32)))
    i = jnp.arange(C, dtype=jnp.float32)
    diff = i[:, None] - i[None, :]
    decay = jnp.where(diff >= 0, jnp.exp(log_g[:, None, None] * jnp.maximum(diff, 0.0)), 0.0)
    zeta = jnp.exp(log_g[:, None] * (C - 1 - i))
    xi = jnp.exp(log_g[:, None] * (i + 1))
    chunk_decay = jnp.exp(log_g * C)
    inner = jnp.einsum('bhnid,bhnjd->bhnij', q, k) * decay[:, None].astype(q.dtype)
    inner = jnp.einsum('bhnij,bhnje->bhnie', inner, v)
    kv = jnp.einsum('bhnjd,bhnje->nbhde', k * zeta[:, None, :, None].astype(k.dtype), v).astype(jnp.float32)

    def step(state, kv_n):
        return state * chunk_decay[None, :, None, None] + kv_n, state

    _, prev = lax.scan(step, jnp.zeros_like(kv[0]), kv)
    cross = jnp.einsum('bhnid,nbhde->bhnie', q * xi[:, None, :, None].astype(q.dtype), prev.astype(q.dtype))
    of = (inner + cross).astype(jnp.float32)
    mu = jnp.mean(of, axis=-1, keepdims=True)
    var = jnp.mean(jnp.square(of - mu), axis=-1, keepdims=True)
    on = (of - mu) * lax.rsqrt(var + NORM_EPS)
    on = on.transpose(0, 2, 3, 1, 4).reshape(b, s, GROUP_WIDTH)
    return (on * norm_g.astype(jnp.float32)).astype(v.dtype)


def _layer(x, pre_g, w_in, sgu_g, sgu_w, sgu_b, pool_w, pool_scale, ret_g, w_out, post_g):
    b, s, _ = x.shape
    h = _rms_norm(x, pre_g)
    proj = jnp.einsum('bsd,de->bse', h, w_in)
    aq, ak, av, ag, bu, bv, bg, cx, cg, dq, dk, dv, dg = jnp.split(proj, N_IN_SLICES, axis=-1)

    def heads(t):
        return t.reshape(b, s, N_GROUP_HEADS, HEAD_DIM).transpose(0, 2, 1, 3)

    ya = _dilated_mixture(heads(aq), heads(ak), heads(av))
    yb = _spatial_gating(bu, bv, sgu_g, sgu_w, sgu_b)
    yc = _multiscale_pool(cx, pool_w, pool_scale)
    yd = _retention(dq, dk, dv, ret_g)
    y = jnp.concatenate([ya * jax.nn.silu(ag), yb * jax.nn.silu(bg),
                         yc * jax.nn.silu(cg), yd * jax.nn.silu(dg)], axis=-1)
    y = jnp.einsum('bse,ed->bsd', y, w_out)
    return x + _rms_norm(y, post_g).astype(x.dtype)


def setup_inputs(seed: int = 0) -> dict:
    key = jax.random.key(seed)
    ks = jax.random.split(key, 12)
    f32 = jnp.float32
    nrm = lambda k, shape: jax.random.normal(k, shape, f32)
    return {
        "x": nrm(ks[0], (BATCH, SEQ, D_MODEL)),
        "pre_g": 1.0 + 0.05 * nrm(ks[1], (DEPTH, D_MODEL)),
        "w_in": nrm(ks[2], (DEPTH, D_MODEL, IN_WIDTH)) * D_MODEL ** -0.5,
        "sgu_g": 1.0 + 0.05 * nrm(ks[3], (DEPTH, GROUP_WIDTH)),
        "sgu_w": nrm(ks[4], (DEPTH, N_GROUP_HEADS, SGU_CHUNK, SGU_CHUNK)) * SGU_CHUNK ** -0.5,
        "sgu_b": 1.0 + 0.05 * nrm(ks[5], (DEPTH, N_GROUP_HEADS, SGU_CHUNK)),
        "pool_w": nrm(ks[6], (DEPTH, len(POOL_SIZES), POOL_CH, POOL_CH)) * POOL_CH ** -0.5,
        "pool_scale": 1.0 + 0.1 * nrm(ks[7], (DEPTH, GROUP_WIDTH)),
        "ret_g": 1.0 + 0.05 * nrm(ks[8], (DEPTH, GROUP_WIDTH)),
        "w_out": nrm(ks[9], (DEPTH, MIX_WIDTH, D_MODEL)) * MIX_WIDTH ** -0.5,
        "post_g": 1.0 + 0.05 * nrm(ks[10], (DEPTH, D_MODEL)),
    }


def reference(x, pre_g, w_in, sgu_g, sgu_w, sgu_b, pool_w, pool_scale, ret_g, w_out, post_g):
    for l in range(DEPTH):
        x = _layer(x, pre_g[l], w_in[l], sgu_g[l], sgu_w[l], sgu_b[l], pool_w[l],
                   pool_scale[l], ret_g[l], w_out[l], post_g[l])
    return x
```

```cpp
#include <hip/hip_runtime.h>
#include <hip/hip_cooperative_groups.h>
#include <cstdio>
#include <cstdint>
namespace cg = cooperative_groups;
namespace pg8 {
#define PG8_LAS __attribute__((address_space(3)))
typedef unsigned short bf16_t;
typedef short bf16x8 __attribute__((ext_vector_type(8)));
typedef float f32x4 __attribute__((ext_vector_type(4)));
typedef unsigned u32x4 __attribute__((ext_vector_type(4)));
constexpr int BM = 256, BK = 64, HALF = 128, HTB = HALF * BK * 2  , STAGE_BYTES = 8 * HTB, NXCD = 8, WGM = 8;

__host__ __device__ __forceinline__ int lds_byte(int r, int c) { const int st = (r >> 4) * 2 + (c >> 5), rr = r & 15, cc = c & 31, ob = rr * 64 + cc * 2; return st * 1024 + (ob ^ (((ob >> 9) & 1) << 5)); }
__host__ __device__ __forceinline__ void stage_rc(int b, int& R, int& C) { const int st = b / 1024, sb = b % 1024, swz = sb ^ (((sb >> 9) & 1) << 5); R = (st >> 1) * 16 + swz / 64; C = (st & 1) * 32 + (swz % 64) / 2; }
__host__ __device__ __forceinline__ int perm32(int rho) { const int n = rho >> 4, i = rho & 15; return 8 * (i >> 2) + 4 * n + (i & 3); }

struct Unit { int pm, pn; };
struct Gemm { const bf16_t* A; const bf16_t* Bt; int M, N, K; };

struct StaticOrder {
    int nM, nN, nwg, G, c;
    __host__ __device__ void init(int M, int N, int G_, int c_) { nM = M / BM; nN = N / BM; nwg = nM * nN; G = G_; c = c_; }
    __host__ __device__ bool next(int i, Unit& u) const {
        const long L = (long)i * G + c; if (L >= nwg) return false;
        int wgid = (int)L; { const int q = nwg / NXCD, r = nwg % NXCD, xcd = wgid % NXCD, off = wgid / NXCD; wgid = (xcd < r ? xcd * (q + 1) : r * (q + 1) + (xcd - r) * q) + off; }
        const int nig = WGM * nN, gid = wgid / nig, fm = gid * WGM, gsz = (nM - fm) < WGM ? (nM - fm) : WGM;
        u.pm = fm + ((wgid % nig) % gsz); u.pn = (wgid % nig) / gsz; return true;
    }
    __device__ __forceinline__ void a_ready(const Unit&) const {}
    __device__ __forceinline__ void done(const Unit&) const {}
};

__device__ __forceinline__ unsigned cvt_pk_bf16(float lo, float hi) { unsigned r; asm volatile("v_cvt_pk_bf16_f32 %0, %1, %2" : "=v"(r) : "v"(lo), "v"(hi)); return r; }
__device__ __forceinline__ float silu_f(float x) { return x / (1.0f + __expf(-x)); }
struct EpiOut {
    static constexpr bool PERM = true, AFTER_DRAIN = false;
    bf16_t* O; int ldc; unsigned gate_mask;
    __device__ __forceinline__ void operator()(const f32x4 (&acc)[2][2][4][2], const Unit& u, int wr, int wc, int fr, int fq) const {
        const int row0 = u.pm * BM + wr * 64 + fr; const int col0 = u.pn * BM + wc * 32 + 8 * fq;
        const bool gate = (gate_mask >> u.pn) & 1u;
#pragma unroll
        for (int ai = 0; ai < 2; ++ai)
#pragma unroll
            for (int m = 0; m < 4; ++m) { bf16_t* rowp = O + (size_t)(row0 + ai * HALF + m * 16) * ldc + col0;
#pragma unroll
                for (int bj = 0; bj < 2; ++bj) { f32x4 v0 = acc[ai][bj][m][0], v1 = acc[ai][bj][m][1];
                    if (gate) { v0 = (f32x4){silu_f(v0[0]), silu_f(v0[1]), silu_f(v0[2]), silu_f(v0[3])}; v1 = (f32x4){silu_f(v1[0]), silu_f(v1[1]), silu_f(v1[2]), silu_f(v1[3])}; }
                    u32x4 w; w.x = cvt_pk_bf16(v0[0], v0[1]); w.y = cvt_pk_bf16(v0[2], v0[3]); w.z = cvt_pk_bf16(v1[0], v1[1]); w.w = cvt_pk_bf16(v1[2], v1[3]);
                    *(u32x4*)(rowp + bj * HALF) = w; } }
    }
};
template <class Epi, class Sched, bool ALIGN_EPI = false, bool SP2 = false>
__device__ __forceinline__ void gemm_phase(PG8_LAS unsigned char* lds, const Gemm g, const Sched& S, const Epi& E) {
    const int tid = threadIdx.x, wid = __builtin_amdgcn_readfirstlane(tid >> 6), lane = tid & 63, wr = wid >> 2, wc = wid & 3, fr = lane & 15, fq = lane >> 4;
    const int K = g.K, nt = K / BK;
    unsigned voffA[2], voffB[2];
#pragma unroll
    for (int i = 0; i < 2; ++i) { int R, C; stage_rc(tid * 16 + i * 8192, R, C); const int Rb = Epi::PERM ? ((R & ~31) + perm32(R & 31)) : R;
        voffA[i] = (unsigned)(R * K + C) * 2u; voffB[i] = (unsigned)(Rb * K + C) * 2u; }
    const size_t kstep = (size_t)(BK * 2);
    const size_t hstep = (size_t)HALF * K * 2;
    const size_t tstep = 2 * hstep;
    const unsigned ldsw = (unsigned)wid * 1024u;
    const int aoff = lds_byte(wr * 64 + fr, fq * 8), boff = lds_byte(wc * 32 + fr, fq * 8);
#define PG8_SA(b, h) (((b) * 2 + (h)) * HTB)
#define PG8_SB(b, h) ((4 + (b) * 2 + (h)) * HTB)
#define PG8_STAGE(bufoff, gbase, voff) do { _Pragma("unroll") for (int _i = 0; _i < 2; ++_i) \
        __builtin_amdgcn_global_load_lds((const unsigned*)((const char*)(gbase) + (voff)[_i]), (PG8_LAS unsigned*)(lds + (bufoff) + ldsw + _i * 8192), 16, 0, 0); } while (0)
#define PG8_LDA(dst, b, h) do { _Pragma("unroll") for (int m = 0; m < 4; ++m) _Pragma("unroll") for (int k = 0; k < 2; ++k) dst[m][k] = *(const PG8_LAS bf16x8*)(lds + PG8_SA(b, h) + aoff + m * 2048 + k * 1024); } while (0)
#define PG8_LDB(dst, b, h) do { _Pragma("unroll") for (int n = 0; n < 2; ++n) _Pragma("unroll") for (int k = 0; k < 2; ++k) dst[n][k] = *(const PG8_LAS bf16x8*)(lds + PG8_SB(b, h) + boff + n * 2048 + k * 1024); } while (0)
#define PG8_MMA(ai, bj, At, Bt) do { __builtin_amdgcn_s_setprio(1); _Pragma("unroll") for (int m = 0; m < 4; ++m) _Pragma("unroll") for (int n = 0; n < 2; ++n) _Pragma("unroll") for (int k = 0; k < 2; ++k) \
        acc[ai][bj][m][n] = __builtin_amdgcn_mfma_f32_16x16x32_bf16(Bt[n][k], At[m][k], acc[ai][bj][m][n], 0, 0, 0); __builtin_amdgcn_s_setprio(0); } while (0)
#define PG8_WAIT_V(n) asm volatile("s_waitcnt vmcnt(" #n ")" ::: "memory")
#define PG8_WAIT_L(n) asm volatile("s_waitcnt lgkmcnt(" #n ")" ::: "memory")
#define PG8_BAR __builtin_amdgcn_s_barrier()
#define PG8_SCHED __builtin_amdgcn_sched_barrier(0)
    Unit cur, nxt; int ui = 0;
    if (!S.next(0, cur)) return;
    f32x4 acc[2][2][4][2];
#pragma unroll
    for (int a = 0; a < 2; ++a)
#pragma unroll
        for (int b = 0; b < 2; ++b)
#pragma unroll
            for (int m = 0; m < 4; ++m)
#pragma unroll
                for (int n = 0; n < 2; ++n) acc[a][b][m][n] = (f32x4){0.f, 0.f, 0.f, 0.f};
    bf16x8 At[4][2], B0[2][2], B1[2][2];
    const char* cA = (const char*)g.A + (size_t)cur.pm * tstep; const char* cB = (const char*)g.Bt + (size_t)cur.pn * tstep;
    S.a_ready(cur);
    if constexpr (SP2) {
        PG8_STAGE(PG8_SB(0, 0), cB, voffB); PG8_STAGE(PG8_SB(0, 1), cB + hstep, voffB); PG8_STAGE(PG8_SA(0, 0), cA, voffA); PG8_STAGE(PG8_SA(0, 1), cA + hstep, voffA);
        if (wr == 1) PG8_BAR;
        PG8_WAIT_V(2); PG8_BAR;
        PG8_STAGE(PG8_SB(1, 0), cB + kstep, voffB); PG8_STAGE(PG8_SA(1, 0), cA + kstep, voffA); PG8_STAGE(PG8_SB(1, 1), cB + hstep + kstep, voffB);
        PG8_WAIT_V(6); PG8_BAR;
    } else {
        PG8_STAGE(PG8_SB(0, 0), cB, voffB); PG8_STAGE(PG8_SA(0, 0), cA, voffA); PG8_STAGE(PG8_SB(0, 1), cB + hstep, voffB); PG8_STAGE(PG8_SA(0, 1), cA + hstep, voffA);
        if (wr == 1) PG8_BAR;
        PG8_WAIT_V(4); PG8_BAR;
        PG8_STAGE(PG8_SB(1, 0), cB + kstep, voffB); PG8_STAGE(PG8_SA(1, 0), cA + kstep, voffA); PG8_STAGE(PG8_SB(1, 1), cB + hstep + kstep, voffB);
        PG8_WAIT_V(6); PG8_BAR;
    }
    for (;;) {
        const bool has_next = S.next(ui + 1, nxt);
        const char* nA = has_next ? (const char*)g.A + (size_t)nxt.pm * tstep : cA; const char* nB = has_next ? (const char*)g.Bt + (size_t)nxt.pn * tstep : cB;
        for (int t = 0; t < nt; t += 2) {
            const bool last = (t == nt - 2);
            const char* a1 = cA + (size_t)(t + 1) * kstep;
            const char* a2 = last ? nA : cA + (size_t)(t + 2) * kstep; const char* b2 = last ? nB : cB + (size_t)(t + 2) * kstep;
            const char* a3 = a2 + kstep; const char* b3 = b2 + kstep;
            if (last && has_next) S.a_ready(nxt);
            if constexpr (SP2) {
            PG8_LDB(B0, 0, 0); PG8_LDB(B1, 0, 1); PG8_SCHED; PG8_LDA(At, 0, 0); PG8_STAGE(PG8_SA(1, 1), a1 + hstep, voffA);
            PG8_WAIT_V(8); PG8_WAIT_L(0); PG8_BAR; PG8_MMA(0, 0, At, B0); PG8_MMA(0, 1, At, B1); PG8_BAR; PG8_SCHED;
            PG8_LDA(At, 0, 1); PG8_STAGE(PG8_SB(0, 0), b2, voffB); PG8_STAGE(PG8_SB(0, 1), b2 + hstep, voffB); PG8_STAGE(PG8_SA(0, 0), a2, voffA);
            PG8_WAIT_V(8); PG8_WAIT_L(0); PG8_BAR; PG8_MMA(1, 0, At, B0); PG8_MMA(1, 1, At, B1); PG8_BAR; PG8_SCHED;
            PG8_LDB(B0, 1, 0); PG8_LDB(B1, 1, 1); PG8_SCHED; PG8_LDA(At, 1, 0); PG8_STAGE(PG8_SA(0, 1), a2 + hstep, voffA);
            PG8_WAIT_V(8); PG8_WAIT_L(0); PG8_BAR; PG8_MMA(0, 0, At, B0); PG8_MMA(0, 1, At, B1); PG8_BAR; PG8_SCHED;
            PG8_LDA(At, 1, 1); PG8_STAGE(PG8_SB(1, 0), b3, voffB); PG8_STAGE(PG8_SB(1, 1), b3 + hstep, voffB); PG8_STAGE(PG8_SA(1, 0), a3, voffA);
            PG8_WAIT_V(8); PG8_WAIT_L(0); PG8_BAR; PG8_MMA(1, 0, At, B0); PG8_MMA(1, 1, At, B1); PG8_BAR; PG8_SCHED;
            } else {
            PG8_LDB(B0, 0, 0); PG8_SCHED; PG8_LDA(At, 0, 0); PG8_STAGE(PG8_SA(1, 1), a1 + hstep, voffA);
            PG8_WAIT_L(8); PG8_BAR; PG8_WAIT_L(0); PG8_MMA(0, 0, At, B0); PG8_BAR; PG8_SCHED;
            PG8_LDB(B1, 0, 1); PG8_STAGE(PG8_SB(0, 0), b2, voffB);
            PG8_BAR; PG8_WAIT_L(0); PG8_MMA(0, 1, At, B1); PG8_BAR;
            PG8_LDA(At, 0, 1); PG8_STAGE(PG8_SA(0, 0), a2, voffA);
            PG8_BAR; PG8_WAIT_L(0); PG8_MMA(1, 0, At, B0); PG8_BAR; PG8_SCHED;
            PG8_STAGE(PG8_SB(0, 1), b2 + hstep, voffB);
            PG8_WAIT_V(6); PG8_BAR; PG8_MMA(1, 1, At, B1); PG8_BAR;
            PG8_LDB(B0, 1, 0); PG8_SCHED; PG8_LDA(At, 1, 0); PG8_STAGE(PG8_SA(0, 1), a2 + hstep, voffA);
            PG8_WAIT_L(8); PG8_BAR; PG8_WAIT_L(0); PG8_MMA(0, 0, At, B0); PG8_BAR; PG8_SCHED;
            PG8_LDB(B1, 1, 1); PG8_STAGE(PG8_SB(1, 0), b3, voffB);
            PG8_BAR; PG8_WAIT_L(0); PG8_MMA(0, 1, At, B1); PG8_BAR;
            PG8_LDA(At, 1, 1); PG8_STAGE(PG8_SA(1, 0), a3, voffA);
            PG8_BAR; PG8_WAIT_L(0); PG8_MMA(1, 0, At, B0); PG8_BAR; PG8_SCHED;
            PG8_STAGE(PG8_SB(1, 1), b3 + hstep, voffB);
            PG8_WAIT_V(6); PG8_BAR; PG8_MMA(1, 1, At, B1); PG8_BAR;
            }
        }
        if constexpr (ALIGN_EPI) { if (wr == 0) PG8_BAR; }
        if constexpr (!Epi::AFTER_DRAIN) { E(acc, cur, wr, wc, fr, fq); S.done(cur); }
        if (!has_next) break;
#pragma unroll
        for (int a = 0; a < 2; ++a)
#pragma unroll
            for (int b = 0; b < 2; ++b)
#pragma unroll
                for (int m = 0; m < 4; ++m)
#pragma unroll
                    for (int n = 0; n < 2; ++n) acc[a][b][m][n] = (f32x4){0.f, 0.f, 0.f, 0.f};
        cur = nxt; cA = nA; cB = nB; ++ui;
        if constexpr (ALIGN_EPI) { if (wr == 1) PG8_BAR; }
    }
    PG8_WAIT_V(0);
    if constexpr (!ALIGN_EPI) { if (wr == 0) PG8_BAR; }
    PG8_BAR;
    if constexpr (Epi::AFTER_DRAIN) { E.fused(acc, cur, wr, wc, fr, fq, lds, wid, lane); S.done(cur); }
#undef PG8_SA
#undef PG8_SB
#undef PG8_STAGE
#undef PG8_LDA
#undef PG8_LDB
#undef PG8_MMA
#undef PG8_WAIT_V
#undef PG8_WAIT_L
#undef PG8_BAR
#undef PG8_SCHED
}
}
#define LAS __attribute__((address_space(3)))
typedef unsigned short bf16;
typedef unsigned v4u __attribute__((ext_vector_type(4)));
typedef unsigned v2u __attribute__((ext_vector_type(2)));
typedef float f32x4 __attribute__((ext_vector_type(4)));
constexpr int SEQ = 4096, BATCH = 8, DM = 1024, M = BATCH * SEQ, NIN = 3328, DEPTH = 2;
constexpr float EPS = 1e-6f;
constexpr float LOG2E = 1.4426950408889634f;
constexpr float QSCALE = 0.125f * LOG2E;
constexpr int C_AQ = 0, C_AK = 256, C_AV = 512, C_AG = 768, C_BU = 1024, C_BV = 1280, C_BG = 1536, C_CX = 1792, C_CG = 2048, C_DQ = 2304, C_DK = 2560, C_DV = 2816, C_DG = 3072;
constexpr size_t MiB = 1u << 20;
constexpr size_t WS_WIN = 0, WS_WOUT = 13 * MiB, WS_SMALL = 17 * MiB, WS_XB = 18 * MiB, WS_PROJ = 82 * MiB, WS_Y = 290 * MiB, WS_Z = 354 * MiB, WS_OG = 418 * MiB, WS_LSE = 466 * MiB, WS_KV = 468 * MiB, WS_R0 = 484 * MiB, WS_END = 486 * MiB;
constexpr size_t R0_PPART = 0, R0_Y = 1 * MiB, R0_ZPART = R0_Y + 65536;
constexpr int LDS_BYTES = 147456;
constexpr int P_PREG = 0, P_SGUG = 2048, P_SGUW = 2560, P_SGUB = 133632, P_POOLW = 134656, P_POOLS = 167424, P_RETG = 167936, P_POSTG = 168448, P_END = 170496;

__device__ __forceinline__ float bf2f(unsigned short u) { return __uint_as_float(((unsigned)u) << 16); }
__device__ __forceinline__ unsigned f2bf(float f) { unsigned u = __float_as_uint(f); return (u + 0x7fffu + ((u >> 16) & 1u)) >> 16; }
__device__ __forceinline__ unsigned pk2(float lo, float hi) { return f2bf(lo) | (f2bf(hi) << 16); }
__device__ __forceinline__ float wave_sum(float v) {
#pragma unroll
    for (int o = 1; o < 64; o <<= 1) v += __shfl_xor(v, o);
    return v;
}
#define LDS_WAIT() asm volatile("s_waitcnt lgkmcnt(0)" ::: "memory")

struct Params { const float* in[11]; float* out; unsigned char* ws; };

__device__ __forceinline__ void p0_transpose_item(const float* W, int K, int N, bf16* WT, const float* rs, int col_mode, LAS float* scr, int item, int lane) {
    const int nblk = N / 32, kb = item / nblk, nb = item % nblk, k0 = 64 * kb, n0 = 32 * nb;
    float cs = 1.f;
    if (col_mode) { const int n = n0 + (lane & 31); if (n < 256) cs = QSCALE; else if (n >= C_DK && n < C_DK + 256) cs = 0.125f; }
#pragma unroll 8
    for (int i = 0; i < 32; ++i) { const int kk = 2 * i + (lane >> 5); float v = W[(size_t)(k0 + kk) * N + n0 + (lane & 31)] * cs; if (rs) v *= rs[k0 + kk]; scr[kk * 33 + (lane & 31)] = v; }
    LDS_WAIT(); asm volatile("" ::: "memory");
    const int c = lane & 7;
#pragma unroll
    for (int j = 0; j < 4; ++j) { const int n = (lane >> 3) + 8 * j; const LAS float* s = scr + (8 * c) * 33 + n;
        v4u o; o.x = pk2(s[0 * 33], s[1 * 33]); o.y = pk2(s[2 * 33], s[3 * 33]); o.z = pk2(s[4 * 33], s[5 * 33]); o.w = pk2(s[6 * 33], s[7 * 33]);
        *(v4u*)(WT + (size_t)(n0 + n) * K + k0 + 8 * c) = o; }
    LDS_WAIT(); asm volatile("" ::: "memory");
}

__device__ __forceinline__ void rms_row_to_bf16(const float* xrow, bf16* orow, int lane) {
    const f32x4* xr = (const f32x4*)xrow + lane;
    f32x4 v[4]; float s = 0.f;
#pragma unroll
    for (int j = 0; j < 4; ++j) { v[j] = xr[64 * j]; s += (v[j].x * v[j].x + v[j].y * v[j].y) + (v[j].z * v[j].z + v[j].w * v[j].w); }
    const float rstd = 1.f / sqrtf(wave_sum(s) * (1.f / DM) + EPS);
    v2u* o8 = (v2u*)orow + lane;
#pragma unroll
    for (int j = 0; j < 4; ++j) { v2u w; w.x = pk2(v[j].x * rstd, v[j].y * rstd); w.y = pk2(v[j].z * rstd, v[j].w * rstd); o8[64 * j] = w; }
}

__device__ __forceinline__ void post_row_z(const float* xres, const f32x4 (&z)[4], const float* pg, float* orow, bf16* xbrow, int lane) {
    const f32x4* xr = (const f32x4*)xres + lane; const f32x4* gr = (const f32x4*)pg + lane;
    float s = 0.f;
#pragma unroll
    for (int j = 0; j < 4; ++j) s += (z[j].x * z[j].x + z[j].y * z[j].y) + (z[j].z * z[j].z + z[j].w * z[j].w);
    const float rstd = 1.f / sqrtf(wave_sum(s) * (1.f / DM) + EPS);
    f32x4 xn[4]; float s2 = 0.f;
#pragma unroll
    for (int j = 0; j < 4; ++j) { const f32x4 x = xr[64 * j], g = gr[64 * j]; xn[j] = x + z[j] * rstd * g; s2 += (xn[j].x * xn[j].x + xn[j].y * xn[j].y) + (xn[j].z * xn[j].z + xn[j].w * xn[j].w); }
    f32x4* o = (f32x4*)orow + lane;
#pragma unroll
    for (int j = 0; j < 4; ++j) o[64 * j] = xn[j];
    if (xbrow) {
        const float r2 = 1.f / sqrtf(wave_sum(s2) * (1.f / DM) + EPS);
        v2u* o8 = (v2u*)xbrow + lane;
#pragma unroll
        for (int j = 0; j < 4; ++j) { v2u w; w.x = pk2(xn[j].x * r2, xn[j].y * r2); w.y = pk2(xn[j].z * r2, xn[j].w * r2); o8[64 * j] = w; }
    }
}
__device__ __forceinline__ void post_row(const float* xres, const bf16* zrow, const float* r0z  , const float* pg, float* orow, bf16* xbrow, int lane) {
    f32x4 z[4];
    if (r0z) {
#pragma unroll
        for (int j = 0; j < 4; ++j) { f32x4 a = (f32x4){0.f, 0.f, 0.f, 0.f};
            for (int kc = 0; kc < 8; ++kc) a += *((const f32x4*)(r0z + (size_t)kc * 8 * DM) + lane + 64 * j);
            z[j] = a; }
    } else {
        const v2u* zr = (const v2u*)zrow + lane;
#pragma unroll
        for (int j = 0; j < 4; ++j) { const v2u w = zr[64 * j]; z[j] = (f32x4){bf2f((unsigned short)(w.x & 0xffff)), bf2f((unsigned short)(w.x >> 16)), bf2f((unsigned short)(w.y & 0xffff)), bf2f((unsigned short)(w.y >> 16))}; }
    }
    post_row_z(xres, z, pg, orow, xbrow, lane);
}

__device__ __forceinline__ float rdl(float v, int l) { return __int_as_float(__builtin_amdgcn_readlane(__float_as_int(v), l)); }
__device__ __forceinline__ void r0_dot_task(const float* xin, size_t rs, int norm, const float* ks, const float* W, int N, float* part, int task, int nchunks, int lane, LAS float* hs) {
    const int ch = task % nchunks, kc = task / nchunks, n0 = ch * 64;
#pragma unroll 1
    for (int b = 0; b < 8; ++b) { const float* xr = xin + (size_t)b * rs; float sc = 1.f;
        if (norm) { float s = 0.f;
#pragma unroll
            for (int j = 0; j < 4; ++j) { const f32x4 v = *((const f32x4*)xr + lane + 64 * j); s += (v.x * v.x + v.y * v.y) + (v.z * v.z + v.w * v.w); }
            sc = 1.f / sqrtf(wave_sum(s) * (1.f / DM) + EPS); }
#pragma unroll
        for (int i = 0; i < 2; ++i) { const int k = kc * 128 + lane + 64 * i; hs[b * 128 + lane + 64 * i] = xr[k] * sc * (ks ? ks[k] : 1.f); } }
    LDS_WAIT(); asm volatile("" ::: "memory");
    float acc[8];
#pragma unroll
    for (int b = 0; b < 8; ++b) acc[b] = 0.f;
#pragma unroll 2
    for (int kk = 0; kk < 128; ++kk) { const float w = W[(size_t)(kc * 128 + kk) * N + n0 + lane];
#pragma unroll
        for (int b = 0; b < 8; ++b) acc[b] += hs[b * 128 + kk] * w; }
#pragma unroll
    for (int b = 0; b < 8; ++b) part[((size_t)kc * 8 + b) * N + n0 + lane] = acc[b];
    LDS_WAIT(); asm volatile("" ::: "memory");
}
__device__ __forceinline__ float r0p(const float* ppart, int b, int n) { float a = 0.f;
#pragma unroll
    for (int kc = 0; kc < 8; ++kc) a += ppart[((size_t)kc * 8 + b) * NIN + n];
    return a; }
using pg8::silu_f;
__device__ __forceinline__ void r0_mix(const float* ppart, float* y0, int b, const float* sgu_g, const float* sgu_w, const float* sgu_b, const float* ret_g, int lane) {
    float sm = 0.f;
#pragma unroll 1
    for (int i = 0; i < 4; ++i) sm += r0p(ppart, b, C_BV + lane + 64 * i);
    const float mean = wave_sum(sm) * (1.f / 256.f); float sq = 0.f;
#pragma unroll 1
    for (int i = 0; i < 4; ++i) { const float d = r0p(ppart, b, C_BV + lane + 64 * i) - mean; sq += d * d; }
    const float rstd = 1.f / sqrtf(wave_sum(sq) * (1.f / 256.f) + EPS);
#pragma unroll 1
    for (int i = 0; i < 4; ++i) { const int c = lane + 64 * i;
        const float av = r0p(ppart, b, C_AV + c), ag = r0p(ppart, b, C_AG + c);
        y0[b * DM + c] = av * silu_f(ag);
        const float bu = r0p(ppart, b, C_BU + c), bvv = r0p(ppart, b, C_BV + c) - mean, bg = r0p(ppart, b, C_BG + c);
        const float mixed = sgu_w[(size_t)i * 16384] * (bvv * rstd * sgu_g[c]) + sgu_b[i * 128];
        y0[b * DM + 256 + c] = bu * mixed * silu_f(bg);
        y0[b * DM + 512 + c] = 0.f;
        const float dq = r0p(ppart, b, C_DQ + c), dk = r0p(ppart, b, C_DK + c), dv = r0p(ppart, b, C_DV + c), dgt = r0p(ppart, b, C_DG + c);
        const float cc = wave_sum(dq * dk) * 0.125f; const float of = cc * dv;
        const float mu = wave_sum(of) * (1.f / 64.f); const float d0 = of - mu; const float var = wave_sum(d0 * d0) * (1.f / 64.f);
        y0[b * DM + 768 + c] = d0 / sqrtf(var + EPS) * ret_g[c] * silu_f(dgt); }
}

__device__ __forceinline__ void na_attn(const bf16* proj, bf16* y, int gw, int NGW, int lane) {
    for (int task = gw; task < M * 4; task += NGW) {
        const int m = task >> 2, h = task & 3, t = m & (SEQ - 1);
        const float q = bf2f(proj[(size_t)m * NIN + C_AQ + h * 64 + lane]);
        const float slope2 = exp2f(-2.0f * (h + 1)) * LOG2E;
        float mr = -INFINITY, l = 0.f, o = 0.f;
        for (int g = 0; g < 3; ++g) { const int dil = 1 << (2 * g);
            for (int j = 0; j <= 128; ++j) { const int tk = t - j * dil; if (tk < 0) break;
                const size_t row = (size_t)(m - j * dil) * NIN;
                const float kd = bf2f(proj[row + C_AK + h * 64 + lane]), vd = bf2f(proj[row + C_AV + h * 64 + lane]);
                const float s = wave_sum(q * kd) - slope2 * (float)(j * dil);
                const float mn = fmaxf(mr, s), corr = exp2f(mr - mn), pp = exp2f(s - mn);
                l = l * corr + pp; o = o * corr + pp * vd; mr = mn; } }
        const float gate = bf2f(proj[(size_t)m * NIN + C_AG + h * 64 + lane]);
        y[(size_t)m * DM + h * 64 + lane] = (bf16)f2bf(o / l * gate);
    }
}
__device__ __forceinline__ void na_sgu(const bf16* proj, bf16* y, const float* sgu_g, const float* sgu_w, const float* sgu_b, int gw, int NGW, int lane) {
    for (int m = gw; m < M; m += NGW) {
        const int t = m & 127; const size_t base = (size_t)(m - t);
        float acc[4] = {0.f, 0.f, 0.f, 0.f}; float gg[4];
#pragma unroll
        for (int i = 0; i < 4; ++i) gg[i] = sgu_g[lane + 64 * i];
        for (int s = 0; s <= t; ++s) { float v[4]; float sm = 0.f;
#pragma unroll
            for (int i = 0; i < 4; ++i) { v[i] = bf2f(proj[(base + s) * NIN + C_BV + lane + 64 * i]); sm += v[i]; }
            const float mean = wave_sum(sm) * (1.f / 256.f); float sq = 0.f;
#pragma unroll
            for (int i = 0; i < 4; ++i) { v[i] -= mean; sq += v[i] * v[i]; }
            const float rstd = 1.f / sqrtf(wave_sum(sq) * (1.f / 256.f) + EPS);
#pragma unroll
            for (int i = 0; i < 4; ++i) acc[i] += sgu_w[(size_t)i * 16384 + t * 128 + s] * (v[i] * rstd * gg[i]); }
#pragma unroll
        for (int i = 0; i < 4; ++i) { const float mixed = acc[i] + sgu_b[i * 128 + t];
            const float u = bf2f(proj[(size_t)m * NIN + C_BU + lane + 64 * i]), gate = bf2f(proj[(size_t)m * NIN + C_BG + lane + 64 * i]);
            y[(size_t)m * DM + 256 + lane + 64 * i] = (bf16)f2bf(u * mixed * gate); }
    }
}
__device__ __forceinline__ void na_pool(const bf16* proj, bf16* y, const float* pool_w, const float* pool_scale, int gw, int NGW, int lane) {
    for (int task = gw; task < M * 4; task += NGW) {
        const int m = task >> 2, g = task & 3, t = m & (SEQ - 1), p = 2 << g;
        const int cnt = (t + 1 < p) ? (t + 1) : p; float sum = 0.f;
        for (int j = 0; j < cnt; ++j) sum += bf2f(proj[(size_t)(m - j) * NIN + C_CX + g * 64 + lane]);
        const float pooled = sum / (float)cnt - bf2f(proj[(size_t)m * NIN + C_CX + g * 64 + lane]);
        float o = 0.f;
        for (int c = 0; c < 64; ++c) o += __shfl(pooled, c) * pool_w[(size_t)g * 4096 + c * 64 + lane];
        const float gate = bf2f(proj[(size_t)m * NIN + C_CG + g * 64 + lane]);
        y[(size_t)m * DM + 512 + g * 64 + lane] = (bf16)f2bf(o * pool_scale[g * 64 + lane] * gate);
    }
}
__device__ __forceinline__ void na_ret(const bf16* proj, bf16* y, const float* ret_g, LAS float* part, int bh, int tid) {
    const int b = bh >> 2, h = bh & 3, e = tid & 63, dg = tid >> 6;
    const float g = 1.0f - exp2f(-5.0f - (float)h);
    float S[8];
#pragma unroll
    for (int i = 0; i < 8; ++i) S[i] = 0.f;
    const float rg = ret_g[h * 64 + e];
    for (int t0 = 0; t0 < SEQ; t0 += 8) {
        for (int tt = 0; tt < 8; ++tt) { const size_t row = ((size_t)b * SEQ + t0 + tt) * NIN;
            const float ve = bf2f(proj[row + C_DV + h * 64 + e]); float pr = 0.f;
#pragma unroll
            for (int i = 0; i < 8; ++i) { const float kd = bf2f(proj[row + C_DK + h * 64 + dg * 8 + i]), qd = bf2f(proj[row + C_DQ + h * 64 + dg * 8 + i]);
                S[i] = g * S[i] + kd * ve; pr += qd * S[i]; }
            part[(tt * 8 + dg) * 64 + e] = pr; }
        __syncthreads();
        { const int tt = dg; float o = 0.f;
#pragma unroll
          for (int d8 = 0; d8 < 8; ++d8) o += part[(tt * 8 + d8) * 64 + e];
          const float mean = wave_sum(o) * (1.f / 64.f); const float dv = o - mean; const float var = wave_sum(dv * dv) * (1.f / 64.f);
          const float on = dv / sqrtf(var + EPS) * rg;
          const size_t m = (size_t)b * SEQ + t0 + tt;
          const float gate = bf2f(proj[m * NIN + C_DG + h * 64 + e]);
          y[m * DM + 768 + h * 64 + e] = (bf16)f2bf(on * gate); }
        __syncthreads();
    }
}

#define PHASE_IDS() int tid = threadIdx.x; asm volatile("" : "+v"(tid)); const int lane = tid & 63; const int wave = __builtin_amdgcn_readfirstlane(tid >> 6); const int gw = (int)blockIdx.x * 8 + wave; (void)lane; (void)gw
__global__ void __launch_bounds__(512, 2) fwd(Params p) {
    extern __shared__ __attribute__((aligned(16))) unsigned char lds[];
    cg::grid_group grid = cg::this_grid();
    LAS unsigned char* L = (LAS unsigned char*)lds;
    const int G = gridDim.x, NGW = G * 8;
    const float* x = p.in[0]; const float* w_in = p.in[2]; const float* w_out = p.in[9];
    unsigned char* ws = p.ws;
    const float* PRM = (const float*)(ws + WS_SMALL);
    bf16* WinT = (bf16*)(ws + WS_WIN); bf16* WoutT = (bf16*)(ws + WS_WOUT);
    bf16* XB = (bf16*)(ws + WS_XB); bf16* PROJ = (bf16*)(ws + WS_PROJ); bf16* Y = (bf16*)(ws + WS_Y); bf16* Z = (bf16*)(ws + WS_Z);
    float* R0P_ = (float*)(ws + WS_R0 + R0_PPART); float* R0Y_ = (float*)(ws + WS_R0 + R0_Y); float* R0Z_ = (float*)(ws + WS_R0 + R0_ZPART);

    {
        PHASE_IDS();
        { float* prm = (float*)(ws + WS_SMALL);
          for (int i = (int)blockIdx.x * 512 + tid; i < P_END; i += G * 512) { float v;
              if (i < P_SGUG) v = p.in[1][i]; else if (i < P_SGUW) v = p.in[3][i - P_SGUG]; else if (i < P_SGUB) v = p.in[4][i - P_SGUW]; else if (i < P_POOLW) v = p.in[5][i - P_SGUB];
              else if (i < P_POOLS) v = p.in[6][i - P_POOLW]; else if (i < P_RETG) v = p.in[7][i - P_POOLS]; else if (i < P_POSTG) v = p.in[8][i - P_RETG]; else v = p.in[10][i - P_POSTG];
              prm[i] = v; } }
        LAS float* scr = (LAS float*)(L + wave * 16384);
        constexpr int I_IN = (DM / 64) * (NIN / 32), I_OUT = (DM / 64) * (DM / 32), I_L = I_IN + I_OUT;
        for (int it = gw; it < DEPTH * I_L; it += NGW) { const int l = it / I_L; int r = it % I_L;
            if (r < I_IN) p0_transpose_item(w_in + (size_t)l * DM * NIN, DM, NIN, WinT + (size_t)l * NIN * DM, p.in[1] + l * DM, 1, scr, r, lane);
            else p0_transpose_item(w_out + (size_t)l * DM * DM, DM, DM, WoutT + (size_t)l * DM * DM, nullptr, 0, scr, r - I_IN, lane); }
        for (int m = gw; m < M; m += NGW) rms_row_to_bf16(x + (size_t)m * DM, XB + (size_t)m * DM, lane);
    }
    grid.sync();
#pragma unroll
    for (int l = 0; l < DEPTH; ++l) {
        { pg8::Gemm g{XB, WinT + (size_t)l * NIN * DM, M, NIN, DM}; pg8::StaticOrder S; S.init(M, NIN, G, (int)blockIdx.x);
          pg8::EpiOut E{PROJ, NIN, (1u << 3) | (1u << 6) | (1u << 8) | (1u << 12)};
          pg8::gemm_phase<pg8::EpiOut, pg8::StaticOrder, true, true>((PG8_LAS unsigned char*)L, g, S, E); }
        if ((int)blockIdx.x >= 128) {   PHASE_IDS();
            const float* xin = (l == 0) ? x : p.out;
            for (int task = ((int)blockIdx.x - 128) + 128 * wave; task < 52 * 8; task += 1024) r0_dot_task(xin, (size_t)SEQ * DM, 1, PRM + P_PREG + l * DM, w_in + (size_t)l * DM * NIN, NIN, R0P_, task, 52, lane, (LAS float*)(L + wave * 4096));
        }
        grid.sync();
        {
            PHASE_IDS();
            if ((int)blockIdx.x >= 248 && wave == 0) r0_mix(R0P_, R0Y_, (int)blockIdx.x - 248, PRM + P_SGUG + l * 256, PRM + P_SGUW + (size_t)l * 65536, PRM + P_SGUB + l * 512, PRM + P_RETG + l * 256, lane);
            if ((int)blockIdx.x < 32) na_ret(PROJ, Y, PRM + P_RETG + l * 256, (LAS float*)L, (int)blockIdx.x, tid);
            na_attn(PROJ, Y, gw, NGW, lane);
            na_sgu(PROJ, Y, PRM + P_SGUG + l * 256, PRM + P_SGUW + (size_t)l * 65536, PRM + P_SGUB + l * 512, gw, NGW, lane);
            na_pool(PROJ, Y, PRM + P_POOLW + (size_t)l * 16384, PRM + P_POOLS + l * 256, gw, NGW, lane);
        }
        grid.sync();
        { pg8::Gemm g{Y, WoutT + (size_t)l * DM * DM, M, DM, DM}; pg8::StaticOrder S; S.init(M, DM, G, (int)blockIdx.x);
          pg8::EpiOut E{Z, DM, 0u};
          pg8::gemm_phase<pg8::EpiOut, pg8::StaticOrder, true, true>((PG8_LAS unsigned char*)L, g, S, E); }
        if ((int)blockIdx.x < 128) { PHASE_IDS(); if (wave == 7) r0_dot_task(R0Y_, (size_t)DM, 0, nullptr, w_out + (size_t)l * DM * DM, DM, R0Z_, (int)blockIdx.x, 16, lane, (LAS float*)(L + wave * 4096)); }
        grid.sync();
        { PHASE_IDS(); const float* xres = (l == 0) ? x : p.out;
          for (int m = gw; m < M; m += NGW) post_row(xres + (size_t)m * DM, Z + (size_t)m * DM, ((m & (SEQ - 1)) == 0) ? R0Z_ + (size_t)(m >> 12) * DM : nullptr, PRM + P_POSTG + l * DM, p.out + (size_t)m * DM, (l + 1 < DEPTH) ? XB + (size_t)m * DM : nullptr, lane); }
        if (l + 1 < DEPTH) grid.sync();
    }
}

extern "C" void kernel_launch(void* const* d_in, const int* in_sizes, int n_in, void* d_out, int out_size, void* d_ws, size_t ws_size, hipStream_t stream) {
    static int grid = 0;
    if (grid == 0) {
        if (n_in != 11 || in_sizes[0] != M * DM || out_size != M * DM || ws_size < WS_END) { fprintf(stderr, "kernel_launch: unexpected shapes (n_in %d, in0 %d, out %d, ws %zu)\n", n_in, n_in > 0 ? in_sizes[0] : -1, out_size, ws_size); grid = -1; return; }
        int dev = 0, cus = 0, per_cu = 0;
        hipGetDevice(&dev); hipDeviceGetAttribute(&cus, hipDeviceAttributeMultiprocessorCount, dev);
        if (hipFuncSetAttribute((const void*)fwd, hipFuncAttributeMaxDynamicSharedMemorySize, LDS_BYTES) != hipSuccess) { fprintf(stderr, "kernel_launch: hipFuncSetAttribute failed\n"); grid = -1; return; }
        if (hipOccupancyMaxActiveBlocksPerMultiprocessor(&per_cu, (const void*)fwd, 512, LDS_BYTES) != hipSuccess || per_cu < 1) { fprintf(stderr, "kernel_launch: occupancy query says %d\n", per_cu); per_cu = 1; }
        (void)hipGetLastError();
        grid = cus * 1;
        fprintf(stderr, "kernel_launch: cus %d per_cu %d grid %d\n", cus, per_cu, grid);
    }
    if (grid < 0) return;
    Params p{};
    for (int i = 0; i < 11; ++i) p.in[i] = (const float*)d_in[i];
    p.out = (float*)d_out; p.ws = (unsigned char*)d_ws;
    void* args[] = {&p};
    hipError_t e = hipLaunchCooperativeKernel((const void*)fwd, dim3(grid), dim3(512), args, LDS_BYTES, stream);
    if (e != hipSuccess) fprintf(stderr, "kernel_launch: cooperative launch failed: %s (grid %d)\n", hipGetErrorString(e), grid);
}
```

```cpp
#include <hip/hip_runtime.h>
#include <hip/hip_cooperative_groups.h>
#include <cstdio>
#include <cstdint>
namespace cg = cooperative_groups;
namespace pg8 {
#define PG8_LAS __attribute__((address_space(3)))
typedef unsigned short bf16_t;
typedef short bf16x8 __attribute__((ext_vector_type(8)));
typedef float f32x4 __attribute__((ext_vector_type(4)));
typedef unsigned u32x4 __attribute__((ext_vector_type(4)));
constexpr int BM = 256, BK = 64, HALF = 128, HTB = HALF * BK * 2  , STAGE_BYTES = 8 * HTB, NXCD = 8, WGM = 8;

__host__ __device__ __forceinline__ int lds_byte(int r, int c) { const int st = (r >> 4) * 2 + (c >> 5), rr = r & 15, cc = c & 31, ob = rr * 64 + cc * 2; return st * 1024 + (ob ^ (((ob >> 9) & 1) << 5)); }
__host__ __device__ __forceinline__ void stage_rc(int b, int& R, int& C) { const int st = b / 1024, sb = b % 1024, swz = sb ^ (((sb >> 9) & 1) << 5); R = (st >> 1) * 16 + swz / 64; C = (st & 1) * 32 + (swz % 64) / 2; }
__host__ __device__ __forceinline__ int perm32(int rho) { const int n = rho >> 4, i = rho & 15; return 8 * (i >> 2) + 4 * n + (i & 3); }

struct Unit { int pm, pn; };
struct Gemm { const bf16_t* A; const bf16_t* Bt; int M, N, K; };

struct StaticOrder {
    int nM, nN, nwg, G, c;
    __host__ __device__ void init(int M, int N, int G_, int c_) { nM = M / BM; nN = N / BM; nwg = nM * nN; G = G_; c = c_; }
    __host__ __device__ bool next(int i, Unit& u) const {
        const long L = (long)i * G + c; if (L >= nwg) return false;
        int wgid = (int)L; { const int q = nwg / NXCD, r = nwg % NXCD, xcd = wgid % NXCD, off = wgid / NXCD; wgid = (xcd < r ? xcd * (q + 1) : r * (q + 1) + (xcd - r) * q) + off; }
        const int nig = WGM * nN, gid = wgid / nig, fm = gid * WGM, gsz = (nM - fm) < WGM ? (nM - fm) : WGM;
        u.pm = fm + ((wgid % nig) % gsz); u.pn = (wgid % nig) / gsz; return true;
    }
    __device__ __forceinline__ void a_ready(const Unit&) const {}
    __device__ __forceinline__ void done(const Unit&) const {}
};

__device__ __forceinline__ unsigned cvt_pk_bf16(float lo, float hi) { unsigned r; asm volatile("v_cvt_pk_bf16_f32 %0, %1, %2" : "=v"(r) : "v"(lo), "v"(hi)); return r; }
__device__ __forceinline__ float silu_f(float x) { return x / (1.0f + __expf(-x)); }
struct EpiOut {
    static constexpr bool PERM = true, AFTER_DRAIN = false;
    bf16_t* O; int ldc; unsigned gate_mask;
    __device__ __forceinline__ void operator()(const f32x4 (&acc)[2][2][4][2], const Unit& u, int wr, int wc, int fr, int fq) const {
        const int row0 = u.pm * BM + wr * 64 + fr; const int col0 = u.pn * BM + wc * 32 + 8 * fq;
        const bool gate = (gate_mask >> u.pn) & 1u;
#pragma unroll
        for (int ai = 0; ai < 2; ++ai)
#pragma unroll
            for (int m = 0; m < 4; ++m) { bf16_t* rowp = O + (size_t)(row0 + ai * HALF + m * 16) * ldc + col0;
#pragma unroll
                for (int bj = 0; bj < 2; ++bj) { f32x4 v0 = acc[ai][bj][m][0], v1 = acc[ai][bj][m][1];
                    if (gate) { v0 = (f32x4){silu_f(v0[0]), silu_f(v0[1]), silu_f(v0[2]), silu_f(v0[3])}; v1 = (f32x4){silu_f(v1[0]), silu_f(v1[1]), silu_f(v1[2]), silu_f(v1[3])}; }
                    u32x4 w; w.x = cvt_pk_bf16(v0[0], v0[1]); w.y = cvt_pk_bf16(v0[2], v0[3]); w.z = cvt_pk_bf16(v1[0], v1[1]); w.w = cvt_pk_bf16(v1[2], v1[3]);
                    *(u32x4*)(rowp + bj * HALF) = w; } }
    }
};
template <class Epi, class Sched, bool ALIGN_EPI = false, bool SP2 = false>
__device__ __forceinline__ void gemm_phase(PG8_LAS unsigned char* lds, const Gemm g, const Sched& S, const Epi& E) {
    const int tid = threadIdx.x, wid = __builtin_amdgcn_readfirstlane(tid >> 6), lane = tid & 63, wr = wid >> 2, wc = wid & 3, fr = lane & 15, fq = lane >> 4;
    const int K = g.K, nt = K / BK;
    unsigned voffA[2], voffB[2];
#pragma unroll
    for (int i = 0; i < 2; ++i) { int R, C; stage_rc(tid * 16 + i * 8192, R, C); const int Rb = Epi::PERM ? ((R & ~31) + perm32(R & 31)) : R;
        voffA[i] = (unsigned)(R * K + C) * 2u; voffB[i] = (unsigned)(Rb * K + C) * 2u; }
    const size_t kstep = (size_t)(BK * 2);
    const size_t hstep = (size_t)HALF * K * 2;
    const size_t tstep = 2 * hstep;
    const unsigned ldsw = (unsigned)wid * 1024u;
    const int aoff = lds_byte(wr * 64 + fr, fq * 8), boff = lds_byte(wc * 32 + fr, fq * 8);
#define PG8_SA(b, h) (((b) * 2 + (h)) * HTB)
#define PG8_SB(b, h) ((4 + (b) * 2 + (h)) * HTB)
#define PG8_STAGE(bufoff, gbase, voff) do { _Pragma("unroll") for (int _i = 0; _i < 2; ++_i) \
        __builtin_amdgcn_global_load_lds((const unsigned*)((const char*)(gbase) + (voff)[_i]), (PG8_LAS unsigned*)(lds + (bufoff) + ldsw + _i * 8192), 16, 0, 0); } while (0)
#define PG8_LDA(dst, b, h) do { _Pragma("unroll") for (int m = 0; m < 4; ++m) _Pragma("unroll") for (int k = 0; k < 2; ++k) dst[m][k] = *(const PG8_LAS bf16x8*)(lds + PG8_SA(b, h) + aoff + m * 2048 + k * 1024); } while (0)
#define PG8_LDB(dst, b, h) do { _Pragma("unroll") for (int n = 0; n < 2; ++n) _Pragma("unroll") for (int k = 0; k < 2; ++k) dst[n][k] = *(const PG8_LAS bf16x8*)(lds + PG8_SB(b, h) + boff + n * 2048 + k * 1024); } while (0)
#define PG8_MMA(ai, bj, At, Bt) do { __builtin_amdgcn_s_setprio(1); _Pragma("unroll") for (int m = 0; m < 4; ++m) _Pragma("unroll") for (int n = 0; n < 2; ++n) _Pragma("unroll") for (int k = 0; k < 2; ++k) \
        acc[ai][bj][m][n] = __builtin_amdgcn_mfma_f32_16x16x32_bf16(Bt[n][k], At[m][k], acc[ai][bj][m][n], 0, 0, 0); __builtin_amdgcn_s_setprio(0); } while (0)
#define PG8_WAIT_V(n) asm volatile("s_waitcnt vmcnt(" #n ")" ::: "memory")
#define PG8_WAIT_L(n) asm volatile("s_waitcnt lgkmcnt(" #n ")" ::: "memory")
#define PG8_BAR __builtin_amdgcn_s_barrier()
#define PG8_SCHED __builtin_amdgcn_sched_barrier(0)
    Unit cur, nxt; int ui = 0;
    if (!S.next(0, cur)) return;
    f32x4 acc[2][2][4][2];
#pragma unroll
    for (int a = 0; a < 2; ++a)
#pragma unroll
        for (int b = 0; b < 2; ++b)
#pragma unroll
            for (int m = 0; m < 4; ++m)
#pragma unroll
                for (int n = 0; n < 2; ++n) acc[a][b][m][n] = (f32x4){0.f, 0.f, 0.f, 0.f};
    bf16x8 At[4][2], B0[2][2], B1[2][2];
    const char* cA = (const char*)g.A + (size_t)cur.pm * tstep; const char* cB = (const char*)g.Bt + (size_t)cur.pn * tstep;
    S.a_ready(cur);
    if constexpr (SP2) {
        PG8_STAGE(PG8_SB(0, 0), cB, voffB); PG8_STAGE(PG8_SB(0, 1), cB + hstep, voffB); PG8_STAGE(PG8_SA(0, 0), cA, voffA); PG8_STAGE(PG8_SA(0, 1), cA + hstep, voffA);
        if (wr == 1) PG8_BAR;
        PG8_WAIT_V(2); PG8_BAR;
        PG8_STAGE(PG8_SB(1, 0), cB + kstep, voffB); PG8_STAGE(PG8_SA(1, 0), cA + kstep, voffA); PG8_STAGE(PG8_SB(1, 1), cB + hstep + kstep, voffB);
        PG8_WAIT_V(6); PG8_BAR;
    } else {
        PG8_STAGE(PG8_SB(0, 0), cB, voffB); PG8_STAGE(PG8_SA(0, 0), cA, voffA); PG8_STAGE(PG8_SB(0, 1), cB + hstep, voffB); PG8_STAGE(PG8_SA(0, 1), cA + hstep, voffA);
        if (wr == 1) PG8_BAR;
        PG8_WAIT_V(4); PG8_BAR;
        PG8_STAGE(PG8_SB(1, 0), cB + kstep, voffB); PG8_STAGE(PG8_SA(1, 0), cA + kstep, voffA); PG8_STAGE(PG8_SB(1, 1), cB + hstep + kstep, voffB);
        PG8_WAIT_V(6); PG8_BAR;
    }
    for (;;) {
        const bool has_next = S.next(ui + 1, nxt);
        const char* nA = has_next ? (const char*)g.A + (size_t)nxt.pm * tstep : cA; const char* nB = has_next ? (const char*)g.Bt + (size_t)nxt.pn * tstep : cB;
        for (int t = 0; t < nt; t += 2) {
            const bool last = (t == nt - 2);
            const char* a1 = cA + (size_t)(t + 1) * kstep;
            const char* a2 = last ? nA : cA + (size_t)(t + 2) * kstep; const char* b2 = last ? nB : cB + (size_t)(t + 2) * kstep;
            const char* a3 = a2 + kstep; const char* b3 = b2 + kstep;
            if (last && has_next) S.a_ready(nxt);
            if constexpr (SP2) {
            PG8_LDB(B0, 0, 0); PG8_LDB(B1, 0, 1); PG8_SCHED; PG8_LDA(At, 0, 0); PG8_STAGE(PG8_SA(1, 1), a1 + hstep, voffA);
            PG8_WAIT_V(8); PG8_WAIT_L(0); PG8_BAR; PG8_MMA(0, 0, At, B0); PG8_MMA(0, 1, At, B1); PG8_BAR; PG8_SCHED;
            PG8_LDA(At, 0, 1); PG8_STAGE(PG8_SB(0, 0), b2, voffB); PG8_STAGE(PG8_SB(0, 1), b2 + hstep, voffB); PG8_STAGE(PG8_SA(0, 0), a2, voffA);
            PG8_WAIT_V(8); PG8_WAIT_L(0); PG8_BAR; PG8_MMA(1, 0, At, B0); PG8_MMA(1, 1, At, B1); PG8_BAR; PG8_SCHED;
            PG8_LDB(B0, 1, 0); PG8_LDB(B1, 1, 1); PG8_SCHED; PG8_LDA(At, 1, 0); PG8_STAGE(PG8_SA(0, 1), a2 + hstep, voffA);
            PG8_WAIT_V(8); PG8_WAIT_L(0); PG8_BAR; PG8_MMA(0, 0, At, B0); PG8_MMA(0, 1, At, B1); PG8_BAR; PG8_SCHED;
            PG8_LDA(At, 1, 1); PG8_STAGE(PG8_SB(1, 0), b3, voffB); PG8_STAGE(PG8_SB(1, 1), b3 + hstep, voffB); PG8_STAGE(PG8_SA(1, 0), a3, voffA);
            PG8_WAIT_V(8); PG8_WAIT_L(0); PG8_BAR; PG8_MMA(1, 0, At, B0); PG8_MMA(1, 1, At, B1); PG8_BAR; PG8_SCHED;
            } else {
            PG8_LDB(B0, 0, 0); PG8_SCHED; PG8_LDA(At, 0, 0); PG8_STAGE(PG8_SA(1, 1), a1 + hstep, voffA);
            PG8_WAIT_L(8); PG8_BAR; PG8_WAIT_L(0); PG8_MMA(0, 0, At, B0); PG8_BAR; PG8_SCHED;
            PG8_LDB(B1, 0, 1); PG8_STAGE(PG8_SB(0, 0), b2, voffB);
            PG8_BAR; PG8_WAIT_L(0); PG8_MMA(0, 1, At, B1); PG8_BAR;
            PG8_LDA(At, 0, 1); PG8_STAGE(PG8_SA(0, 0), a2, voffA);
            PG8_BAR; PG8_WAIT_L(0); PG8_MMA(1, 0, At, B0); PG8_BAR; PG8_SCHED;
            PG8_STAGE(PG8_SB(0, 1), b2 + hstep, voffB);
            PG8_WAIT_V(6); PG8_BAR; PG8_MMA(1, 1, At, B1); PG8_BAR;
            PG8_LDB(B0, 1, 0); PG8_SCHED; PG8_LDA(At, 1, 0); PG8_STAGE(PG8_SA(0, 1), a2 + hstep, voffA);
            PG8_WAIT_L(8); PG8_BAR; PG8_WAIT_L(0); PG8_MMA(0, 0, At, B0); PG8_BAR; PG8_SCHED;
            PG8_LDB(B1, 1, 1); PG8_STAGE(PG8_SB(1, 0), b3, voffB);
            PG8_BAR; PG8_WAIT_L(0); PG8_MMA(0, 1, At, B1); PG8_BAR;
            PG8_LDA(At, 1, 1); PG8_STAGE(PG8_SA(1, 0), a3, voffA);
            PG8_BAR; PG8_WAIT_L(0); PG8_MMA(1, 0, At, B0); PG8_BAR; PG8_SCHED;
            PG8_STAGE(PG8_SB(1, 1), b3 + hstep, voffB);
            PG8_WAIT_V(6); PG8_BAR; PG8_MMA(1, 1, At, B1); PG8_BAR;
            }
        }
        if constexpr (ALIGN_EPI) { if (wr == 0) PG8_BAR; }
        if constexpr (!Epi::AFTER_DRAIN) { E(acc, cur, wr, wc, fr, fq); S.done(cur); }
        if (!has_next) break;
#pragma unroll
        for (int a = 0; a < 2; ++a)
#pragma unroll
            for (int b = 0; b < 2; ++b)
#pragma unroll
                for (int m = 0; m < 4; ++m)
#pragma unroll
                    for (int n = 0; n < 2; ++n) acc[a][b][m][n] = (f32x4){0.f, 0.f, 0.f, 0.f};
        cur = nxt; cA = nA; cB = nB; ++ui;
        if constexpr (ALIGN_EPI) { if (wr == 1) PG8_BAR; }
    }
    PG8_WAIT_V(0);
    if constexpr (!ALIGN_EPI) { if (wr == 0) PG8_BAR; }
    PG8_BAR;
    if constexpr (Epi::AFTER_DRAIN) { E.fused(acc, cur, wr, wc, fr, fq, lds, wid, lane); S.done(cur); }
#undef PG8_SA
#undef PG8_SB
#undef PG8_STAGE
#undef PG8_LDA
#undef PG8_LDB
#undef PG8_MMA
#undef PG8_WAIT_V
#undef PG8_WAIT_L
#undef PG8_BAR
#undef PG8_SCHED
}
}
#define LAS __attribute__((address_space(3)))
typedef unsigned short bf16;
typedef unsigned v4u __attribute__((ext_vector_type(4)));
typedef unsigned v2u __attribute__((ext_vector_type(2)));
typedef float f32x4 __attribute__((ext_vector_type(4)));
constexpr int SEQ = 4096, BATCH = 8, DM = 1024, M = BATCH * SEQ, NIN = 3328, DEPTH = 2;
constexpr float EPS = 1e-6f;
constexpr float LOG2E = 1.4426950408889634f;
constexpr float QSCALE = 0.125f * LOG2E;
constexpr int C_AQ = 0, C_AK = 256, C_AV = 512, C_AG = 768, C_BU = 1024, C_BV = 1280, C_BG = 1536, C_CX = 1792, C_CG = 2048, C_DQ = 2304, C_DK = 2560, C_DV = 2816, C_DG = 3072;
constexpr size_t MiB = 1u << 20;
constexpr size_t WS_WIN = 0, WS_WOUT = 13 * MiB, WS_SMALL = 17 * MiB, WS_XB = 18 * MiB, WS_PROJ = 82 * MiB, WS_Y = 290 * MiB, WS_Z = 354 * MiB, WS_OG = 418 * MiB, WS_LSE = 466 * MiB, WS_KV = 468 * MiB, WS_R0 = 484 * MiB, WS_END = 486 * MiB;
constexpr size_t R0_PPART = 0, R0_Y = 1 * MiB, R0_ZPART = R0_Y + 65536;
constexpr int LDS_BYTES = 147456;
constexpr size_t WS_SGUWB = WS_SMALL + 704 * 1024, WS_PWT = WS_SMALL + 960 * 1024;
constexpr int P_PREG = 0, P_SGUG = 2048, P_SGUW = 2560, P_SGUB = 133632, P_POOLW = 134656, P_POOLS = 167424, P_RETG = 167936, P_POSTG = 168448, P_END = 170496;

__device__ __forceinline__ float bf2f(unsigned short u) { return __uint_as_float(((unsigned)u) << 16); }
__device__ __forceinline__ unsigned f2bf(float f) { unsigned u = __float_as_uint(f); return (u + 0x7fffu + ((u >> 16) & 1u)) >> 16; }
__device__ __forceinline__ unsigned pk2(float lo, float hi) { return f2bf(lo) | (f2bf(hi) << 16); }
__device__ __forceinline__ float wave_sum(float v) {
#pragma unroll
    for (int o = 1; o < 64; o <<= 1) v += __shfl_xor(v, o);
    return v;
}
#define LDS_WAIT() asm volatile("s_waitcnt lgkmcnt(0)" ::: "memory")

struct Params { const float* in[11]; float* out; unsigned char* ws; };

__device__ __forceinline__ void p0_transpose_item(const float* W, int K, int N, bf16* WT, const float* rs, int col_mode, LAS float* scr, int item, int lane) {
    const int nblk = N / 32, kb = item / nblk, nb = item % nblk, k0 = 64 * kb, n0 = 32 * nb;
    float cs = 1.f;
    if (col_mode) { const int n = n0 + (lane & 31); if (n < 256) cs = QSCALE; else if (n >= C_DK && n < C_DK + 256) cs = 0.125f; }
#pragma unroll 8
    for (int i = 0; i < 32; ++i) { const int kk = 2 * i + (lane >> 5); float v = W[(size_t)(k0 + kk) * N + n0 + (lane & 31)] * cs; if (rs) v *= rs[k0 + kk]; scr[kk * 33 + (lane & 31)] = v; }
    LDS_WAIT(); asm volatile("" ::: "memory");
    const int c = lane & 7;
#pragma unroll
    for (int j = 0; j < 4; ++j) { const int n = (lane >> 3) + 8 * j; const LAS float* s = scr + (8 * c) * 33 + n;
        v4u o; o.x = pk2(s[0 * 33], s[1 * 33]); o.y = pk2(s[2 * 33], s[3 * 33]); o.z = pk2(s[4 * 33], s[5 * 33]); o.w = pk2(s[6 * 33], s[7 * 33]);
        *(v4u*)(WT + (size_t)(n0 + n) * K + k0 + 8 * c) = o; }
    LDS_WAIT(); asm volatile("" ::: "memory");
}

__device__ __forceinline__ void rms_row_to_bf16(const float* xrow, bf16* orow, int lane) {
    const f32x4* xr = (const f32x4*)xrow + lane;
    f32x4 v[4]; float s = 0.f;
#pragma unroll
    for (int j = 0; j < 4; ++j) { v[j] = xr[64 * j]; s += (v[j].x * v[j].x + v[j].y * v[j].y) + (v[j].z * v[j].z + v[j].w * v[j].w); }
    const float rstd = 1.f / sqrtf(wave_sum(s) * (1.f / DM) + EPS);
    v2u* o8 = (v2u*)orow + lane;
#pragma unroll
    for (int j = 0; j < 4; ++j) { v2u w; w.x = pk2(v[j].x * rstd, v[j].y * rstd); w.y = pk2(v[j].z * rstd, v[j].w * rstd); o8[64 * j] = w; }
}

__device__ __forceinline__ void post_row_z(const float* xres, const f32x4 (&z)[4], const float* pg, float* orow, bf16* xbrow, int lane) {
    const f32x4* xr = (const f32x4*)xres + lane; const f32x4* gr = (const f32x4*)pg + lane;
    float s = 0.f;
#pragma unroll
    for (int j = 0; j < 4; ++j) s += (z[j].x * z[j].x + z[j].y * z[j].y) + (z[j].z * z[j].z + z[j].w * z[j].w);
    const float rstd = 1.f / sqrtf(wave_sum(s) * (1.f / DM) + EPS);
    f32x4 xn[4]; float s2 = 0.f;
#pragma unroll
    for (int j = 0; j < 4; ++j) { const f32x4 x = xr[64 * j], g = gr[64 * j]; xn[j] = x + z[j] * rstd * g; s2 += (xn[j].x * xn[j].x + xn[j].y * xn[j].y) + (xn[j].z * xn[j].z + xn[j].w * xn[j].w); }
    f32x4* o = (f32x4*)orow + lane;
#pragma unroll
    for (int j = 0; j < 4; ++j) o[64 * j] = xn[j];
    if (xbrow) {
        const float r2 = 1.f / sqrtf(wave_sum(s2) * (1.f / DM) + EPS);
        v2u* o8 = (v2u*)xbrow + lane;
#pragma unroll
        for (int j = 0; j < 4; ++j) { v2u w; w.x = pk2(xn[j].x * r2, xn[j].y * r2); w.y = pk2(xn[j].z * r2, xn[j].w * r2); o8[64 * j] = w; }
    }
}
__device__ __forceinline__ void post_row(const float* xres, const bf16* zrow, const float* r0z  , const float* pg, float* orow, bf16* xbrow, int lane) {
    f32x4 z[4];
    if (r0z) {
#pragma unroll
        for (int j = 0; j < 4; ++j) { f32x4 a = (f32x4){0.f, 0.f, 0.f, 0.f};
            for (int kc = 0; kc < 8; ++kc) a += *((const f32x4*)(r0z + (size_t)kc * 8 * DM) + lane + 64 * j);
            z[j] = a; }
    } else {
        const v2u* zr = (const v2u*)zrow + lane;
#pragma unroll
        for (int j = 0; j < 4; ++j) { const v2u w = zr[64 * j]; z[j] = (f32x4){bf2f((unsigned short)(w.x & 0xffff)), bf2f((unsigned short)(w.x >> 16)), bf2f((unsigned short)(w.y & 0xffff)), bf2f((unsigned short)(w.y >> 16))}; }
    }
    post_row_z(xres, z, pg, orow, xbrow, lane);
}

__device__ __forceinline__ float rdl(float v, int l) { return __int_as_float(__builtin_amdgcn_readlane(__float_as_int(v), l)); }
__device__ __forceinline__ void r0_dot_task(const float* xin, size_t rs, int norm, const float* ks, const float* W, int N, float* part, int task, int nchunks, int lane, LAS float* hs) {
    const int ch = task % nchunks, kc = task / nchunks, n0 = ch * 64;
#pragma unroll 1
    for (int b = 0; b < 8; ++b) { const float* xr = xin + (size_t)b * rs; float sc = 1.f;
        if (norm) { float s = 0.f;
#pragma unroll
            for (int j = 0; j < 4; ++j) { const f32x4 v = *((const f32x4*)xr + lane + 64 * j); s += (v.x * v.x + v.y * v.y) + (v.z * v.z + v.w * v.w); }
            sc = 1.f / sqrtf(wave_sum(s) * (1.f / DM) + EPS); }
#pragma unroll
        for (int i = 0; i < 2; ++i) { const int k = kc * 128 + lane + 64 * i; hs[b * 128 + lane + 64 * i] = xr[k] * sc * (ks ? ks[k] : 1.f); } }
    LDS_WAIT(); asm volatile("" ::: "memory");
    float acc[8];
#pragma unroll
    for (int b = 0; b < 8; ++b) acc[b] = 0.f;
#pragma unroll 2
    for (int kk = 0; kk < 128; ++kk) { const float w = W[(size_t)(kc * 128 + kk) * N + n0 + lane];
#pragma unroll
        for (int b = 0; b < 8; ++b) acc[b] += hs[b * 128 + kk] * w; }
#pragma unroll
    for (int b = 0; b < 8; ++b) part[((size_t)kc * 8 + b) * N + n0 + lane] = acc[b];
    LDS_WAIT(); asm volatile("" ::: "memory");
}
__device__ __forceinline__ float r0p(const float* ppart, int b, int n) { float a = 0.f;
#pragma unroll
    for (int kc = 0; kc < 8; ++kc) a += ppart[((size_t)kc * 8 + b) * NIN + n];
    return a; }
using pg8::silu_f;
__device__ __forceinline__ void r0_mix(const float* ppart, float* y0, int b, const float* sgu_g, const float* sgu_w, const float* sgu_b, const float* ret_g, int lane) {
    float sm = 0.f;
#pragma unroll 1
    for (int i = 0; i < 4; ++i) sm += r0p(ppart, b, C_BV + lane + 64 * i);
    const float mean = wave_sum(sm) * (1.f / 256.f); float sq = 0.f;
#pragma unroll 1
    for (int i = 0; i < 4; ++i) { const float d = r0p(ppart, b, C_BV + lane + 64 * i) - mean; sq += d * d; }
    const float rstd = 1.f / sqrtf(wave_sum(sq) * (1.f / 256.f) + EPS);
#pragma unroll 1
    for (int i = 0; i < 4; ++i) { const int c = lane + 64 * i;
        const float av = r0p(ppart, b, C_AV + c), ag = r0p(ppart, b, C_AG + c);
        y0[b * DM + c] = av * silu_f(ag);
        const float bu = r0p(ppart, b, C_BU + c), bvv = r0p(ppart, b, C_BV + c) - mean, bg = r0p(ppart, b, C_BG + c);
        const float mixed = sgu_w[(size_t)i * 16384] * (bvv * rstd * sgu_g[c]) + sgu_b[i * 128];
        y0[b * DM + 256 + c] = bu * mixed * silu_f(bg);
        y0[b * DM + 512 + c] = 0.f;
        const float dq = r0p(ppart, b, C_DQ + c), dk = r0p(ppart, b, C_DK + c), dv = r0p(ppart, b, C_DV + c), dgt = r0p(ppart, b, C_DG + c);
        const float cc = wave_sum(dq * dk) * 0.125f; const float of = cc * dv;
        const float mu = wave_sum(of) * (1.f / 64.f); const float d0 = of - mu; const float var = wave_sum(d0 * d0) * (1.f / 64.f);
        y0[b * DM + 768 + c] = d0 / sqrtf(var + EPS) * ret_g[c] * silu_f(dgt); }
}

__device__ __forceinline__ void na_attn(const bf16* proj, bf16* y, int gw, int NGW, int lane) {
    for (int task = gw; task < M * 4; task += NGW) {
        const int m = task >> 2, h = task & 3, t = m & (SEQ - 1);
        const float q = bf2f(proj[(size_t)m * NIN + C_AQ + h * 64 + lane]);
        const float slope2 = exp2f(-2.0f * (h + 1)) * LOG2E;
        float mr = -INFINITY, l = 0.f, o = 0.f;
        for (int g = 0; g < 3; ++g) { const int dil = 1 << (2 * g);
            for (int j = 0; j <= 128; ++j) { const int tk = t - j * dil; if (tk < 0) break;
                const size_t row = (size_t)(m - j * dil) * NIN;
                const float kd = bf2f(proj[row + C_AK + h * 64 + lane]), vd = bf2f(proj[row + C_AV + h * 64 + lane]);
                const float s = wave_sum(q * kd) - slope2 * (float)(j * dil);
                const float mn = fmaxf(mr, s), corr = exp2f(mr - mn), pp = exp2f(s - mn);
                l = l * corr + pp; o = o * corr + pp * vd; mr = mn; } }
        const float gate = bf2f(proj[(size_t)m * NIN + C_AG + h * 64 + lane]);
        y[(size_t)m * DM + h * 64 + lane] = (bf16)f2bf(o / l * gate);
    }
}
__device__ __forceinline__ void na_sgu(const bf16* proj, bf16* y, const float* sgu_g, const float* sgu_w, const float* sgu_b, int gw, int NGW, int lane) {
    for (int m = gw; m < M; m += NGW) {
        const int t = m & 127; const size_t base = (size_t)(m - t);
        float acc[4] = {0.f, 0.f, 0.f, 0.f}; float gg[4];
#pragma unroll
        for (int i = 0; i < 4; ++i) gg[i] = sgu_g[lane + 64 * i];
        for (int s = 0; s <= t; ++s) { float v[4]; float sm = 0.f;
#pragma unroll
            for (int i = 0; i < 4; ++i) { v[i] = bf2f(proj[(base + s) * NIN + C_BV + lane + 64 * i]); sm += v[i]; }
            const float mean = wave_sum(sm) * (1.f / 256.f); float sq = 0.f;
#pragma unroll
            for (int i = 0; i < 4; ++i) { v[i] -= mean; sq += v[i] * v[i]; }
            const float rstd = 1.f / sqrtf(wave_sum(sq) * (1.f / 256.f) + EPS);
#pragma unroll
            for (int i = 0; i < 4; ++i) acc[i] += sgu_w[(size_t)i * 16384 + t * 128 + s] * (v[i] * rstd * gg[i]); }
#pragma unroll
        for (int i = 0; i < 4; ++i) { const float mixed = acc[i] + sgu_b[i * 128 + t];
            const float u = bf2f(proj[(size_t)m * NIN + C_BU + lane + 64 * i]), gate = bf2f(proj[(size_t)m * NIN + C_BG + lane + 64 * i]);
            y[(size_t)m * DM + 256 + lane + 64 * i] = (bf16)f2bf(u * mixed * gate); }
    }
}
__device__ __forceinline__ void na_pool(const bf16* proj, bf16* y, const float* pool_w, const float* pool_scale, int gw, int NGW, int lane) {
    for (int task = gw; task < M * 4; task += NGW) {
        const int m = task >> 2, g = task & 3, t = m & (SEQ - 1), p = 2 << g;
        const int cnt = (t + 1 < p) ? (t + 1) : p; float sum = 0.f;
        for (int j = 0; j < cnt; ++j) sum += bf2f(proj[(size_t)(m - j) * NIN + C_CX + g * 64 + lane]);
        const float pooled = sum / (float)cnt - bf2f(proj[(size_t)m * NIN + C_CX + g * 64 + lane]);
        float o = 0.f;
        for (int c = 0; c < 64; ++c) o += __shfl(pooled, c) * pool_w[(size_t)g * 4096 + c * 64 + lane];
        const float gate = bf2f(proj[(size_t)m * NIN + C_CG + g * 64 + lane]);
        y[(size_t)m * DM + 512 + g * 64 + lane] = (bf16)f2bf(o * pool_scale[g * 64 + lane] * gate);
    }
}
__device__ __forceinline__ void na_ret(const bf16* proj, bf16* y, const float* ret_g, LAS float* part, int bh, int tid) {
    const int b = bh >> 2, h = bh & 3, e = tid & 63, dg = tid >> 6;
    const float g = 1.0f - exp2f(-5.0f - (float)h);
    float S[8];
#pragma unroll
    for (int i = 0; i < 8; ++i) S[i] = 0.f;
    const float rg = ret_g[h * 64 + e];
    for (int t0 = 0; t0 < SEQ; t0 += 8) {
        for (int tt = 0; tt < 8; ++tt) { const size_t row = ((size_t)b * SEQ + t0 + tt) * NIN;
            const float ve = bf2f(proj[row + C_DV + h * 64 + e]); float pr = 0.f;
#pragma unroll
            for (int i = 0; i < 8; ++i) { const float kd = bf2f(proj[row + C_DK + h * 64 + dg * 8 + i]), qd = bf2f(proj[row + C_DQ + h * 64 + dg * 8 + i]);
                S[i] = g * S[i] + kd * ve; pr += qd * S[i]; }
            part[(tt * 8 + dg) * 64 + e] = pr; }
        __syncthreads();
        { const int tt = dg; float o = 0.f;
#pragma unroll
          for (int d8 = 0; d8 < 8; ++d8) o += part[(tt * 8 + d8) * 64 + e];
          const float mean = wave_sum(o) * (1.f / 64.f); const float dv = o - mean; const float var = wave_sum(dv * dv) * (1.f / 64.f);
          const float on = dv / sqrtf(var + EPS) * rg;
          const size_t m = (size_t)b * SEQ + t0 + tt;
          const float gate = bf2f(proj[m * NIN + C_DG + h * 64 + e]);
          y[m * DM + 768 + h * 64 + e] = (bf16)f2bf(on * gate); }
        __syncthreads();
    }
}

typedef short bf16x8 __attribute__((ext_vector_type(8)));
typedef float f32x16 __attribute__((ext_vector_type(16)));
typedef float f32x2 __attribute__((ext_vector_type(2)));
typedef __bf16 bf16x2_t __attribute__((ext_vector_type(2)));
__device__ __forceinline__ unsigned cvtpk(float lo, float hi) { f32x2 v = {lo, hi}; return __builtin_bit_cast(unsigned, __builtin_convertvector(v, bf16x2_t)); }
#define MFMA32(a, b, c) __builtin_amdgcn_mfma_f32_32x32x16_bf16((a), (b), (c), 0, 0, 0)
#define PACK8(x, s) __builtin_bit_cast(bf16x8, (v4u){cvtpk((x)[8 * (s)], (x)[8 * (s) + 1]), cvtpk((x)[8 * (s) + 2], (x)[8 * (s) + 3]), cvtpk((x)[8 * (s) + 4], (x)[8 * (s) + 5]), cvtpk((x)[8 * (s) + 6], (x)[8 * (s) + 7])})
__device__ __forceinline__ int crow(int reg, int h) { return (reg & 3) + 8 * (reg >> 2) + 4 * h; }
__device__ __forceinline__ int keyperm(int k) { return (k & ~12) | ((k & 4) << 1) | ((k & 8) >> 1); }
constexpr int KP = 144;
__device__ __forceinline__ int vt_off(int d, int kp, int VP) { return d * VP + ((((kp >> 3) ^ ((d >> 3) & 7))) << 4) + ((kp & 7) << 1); }
__device__ __forceinline__ void vt_write8(LAS unsigned char* Vt, int VP, int c  , int kp, v4u v) {
    LAS unsigned char* base = Vt + (((kp >> 3) ^ c) << 4) + ((kp & 7) << 1) + (8 * c) * VP;
    *(LAS unsigned short*)(base + 0 * VP) = (unsigned short)(v.x & 0xffff); *(LAS unsigned short*)(base + 1 * VP) = (unsigned short)(v.x >> 16);
    *(LAS unsigned short*)(base + 2 * VP) = (unsigned short)(v.y & 0xffff); *(LAS unsigned short*)(base + 3 * VP) = (unsigned short)(v.y >> 16);
    *(LAS unsigned short*)(base + 4 * VP) = (unsigned short)(v.z & 0xffff); *(LAS unsigned short*)(base + 5 * VP) = (unsigned short)(v.z >> 16);
    *(LAS unsigned short*)(base + 6 * VP) = (unsigned short)(v.w & 0xffff); *(LAS unsigned short*)(base + 7 * VP) = (unsigned short)(v.w >> 16);
}

__device__ __forceinline__ void attn_unit(const bf16* proj, bf16* og, float* lse, int u, LAS unsigned char* L, int tid) {
    const int lane = tid & 63, wave = tid >> 6;
    const int w16 = u & 15; int t = u >> 4; const int g = t % 3; t /= 3; const int h = t & 3, b = t >> 2;
    const int dil = 1 << (2 * g), res = w16 & (dil - 1), qb = w16 >> (2 * g), Q0 = qb * 256;
    constexpr int VP = 784;
    LAS unsigned char* Kimg = L; LAS unsigned char* Vt = L + 384 * KP;
    const size_t rowbase = (size_t)b * SEQ;
#pragma unroll
    for (int it = 0; it < 6; ++it) { const int idx = tid + it * 512; const int key = idx >> 3, c = idx & 7, i = Q0 - 128 + key;
        if (i >= 0) { const bf16* src = proj + (rowbase + (size_t)i * dil + res) * NIN + h * 64 + c * 8;
            const v4u kv = *(const v4u*)(src + C_AK), vv = *(const v4u*)(src + C_AV);
            *(LAS v4u*)(Kimg + key * KP + c * 16) = kv;
            vt_write8(Vt, VP, c, keyperm(key), vv); } }
    __syncthreads();
    {
        const int r = lane & 31, hh = lane >> 5, wave_u = __builtin_amdgcn_readfirstlane(tid >> 6);
        const size_t qrow = rowbase + (size_t)(Q0 + 32 * wave + r) * dil + res;
        bf16x8 qf[4];
#pragma unroll
        for (int s = 0; s < 4; ++s) qf[s] = *(const bf16x8*)(proj + qrow * NIN + C_AQ + h * 64 + 16 * s + 8 * hh);
        const float slope2 = exp2f(-2.0f * (float)(h + 1)) * LOG2E * (float)dil;
        const int jt0 = (Q0 == 0 && wave_u < 4) ? 4 - wave_u : 0;
        float mx = -INFINITY, l = 0.f;
        f32x16 O[2];
#pragma unroll
        for (int i = 0; i < 16; ++i) { O[0][i] = 0.f; O[1][i] = 0.f; }
        const LAS unsigned char* kb = Kimg + (32 * wave + r) * KP + 16 * hh;
#pragma unroll 1
        for (int jt = jt0; jt < 5; ++jt) {
            f32x16 acc;
#pragma unroll
            for (int i = 0; i < 16; ++i) acc[i] = 0.f;
#pragma unroll
            for (int s = 0; s < 4; ++s) { const bf16x8 kf = *(const LAS bf16x8*)(kb + jt * (32 * KP) + 32 * s); acc = MFMA32(kf, qf[s], acc); }
            const float bq = slope2 * (float)(128 + r - 32 * jt); float tmax = -INFINITY;
#pragma unroll
            for (int i = 0; i < 16; ++i) { const int kk = crow(i, hh); float v = acc[i] - bq + slope2 * (float)kk;
                if (jt == 0 && kk < r) v = -INFINITY; if (jt == 4 && kk > r) v = -INFINITY; acc[i] = v; tmax = fmaxf(tmax, v); }
            tmax = fmaxf(tmax, __shfl_xor(tmax, 32));
            const float mn = fmaxf(mx, tmax), corr = __builtin_amdgcn_exp2f(mx - mn);
            l *= corr;
#pragma unroll
            for (int i = 0; i < 16; ++i) { O[0][i] *= corr; O[1][i] *= corr; }
#pragma unroll
            for (int i = 0; i < 16; ++i) { const float pv = __builtin_amdgcn_exp2f(acc[i] - mn); acc[i] = pv; l += pv; }
            mx = mn;
            const int T = wave + jt;
#pragma unroll
            for (int s = 0; s < 2; ++s) { const bf16x8 pf = PACK8(acc, s);
#pragma unroll
                for (int dt = 0; dt < 2; ++dt) { const int d = 32 * dt + r, G = 4 * T + 2 * s + hh;
                    const bf16x8 vf = *(const LAS bf16x8*)(Vt + d * VP + ((G ^ ((d >> 3) & 7)) << 4)); O[dt] = MFMA32(vf, pf, O[dt]); } }
        }
        l += __shfl_xor(l, 32);
        const float inv = 1.0f / l;
        bf16* orow = og + ((size_t)g * M + qrow) * 256 + h * 64;
#pragma unroll
        for (int dt = 0; dt < 2; ++dt)
#pragma unroll
            for (int i4 = 0; i4 < 4; ++i4) { v2u w; w.x = cvtpk(O[dt][4 * i4] * inv, O[dt][4 * i4 + 1] * inv); w.y = cvtpk(O[dt][4 * i4 + 2] * inv, O[dt][4 * i4 + 3] * inv);
                *(v2u*)(orow + 32 * dt + 8 * i4 + 4 * hh) = w; }
        if (hh == 0) lse[((size_t)g * M + qrow) * 4 + h] = mx + __builtin_amdgcn_logf(l);
    }
    __syncthreads();
}
__device__ __forceinline__ void attn_combine(const bf16* proj, const bf16* og, const float* lse, bf16* y, int gtid, int gthreads) {
    for (int idx = gtid; idx < M * 32; idx += gthreads) { const int row = idx >> 5, hc = idx & 31, h = hc >> 3, c = hc & 7;
        const float l0 = lse[(size_t)row * 4 + h], l1 = lse[((size_t)M + row) * 4 + h], l2 = lse[((size_t)2 * M + row) * 4 + h];
        const float mx = fmaxf(l0, fmaxf(l1, l2)); float w0 = __builtin_amdgcn_exp2f(l0 - mx), w1 = __builtin_amdgcn_exp2f(l1 - mx), w2 = __builtin_amdgcn_exp2f(l2 - mx);
        const float inv = 1.0f / (w0 + w1 + w2); w0 *= inv; w1 *= inv; w2 *= inv;
        const size_t off = (size_t)row * 256 + h * 64 + c * 8;
        const v4u a0 = *(const v4u*)(og + off), a1 = *(const v4u*)(og + (size_t)M * 256 + off), a2 = *(const v4u*)(og + (size_t)2 * M * 256 + off);
        const v4u gt = *(const v4u*)(proj + (size_t)row * NIN + C_AG + h * 64 + c * 8);
        v4u o;
#define CMB(f) { const float e0 = (w0 * bf2f((unsigned short)(a0.f & 0xffff)) + w1 * bf2f((unsigned short)(a1.f & 0xffff)) + w2 * bf2f((unsigned short)(a2.f & 0xffff))) * bf2f((unsigned short)(gt.f & 0xffff)); \
                 const float e1 = (w0 * bf2f((unsigned short)(a0.f >> 16)) + w1 * bf2f((unsigned short)(a1.f >> 16)) + w2 * bf2f((unsigned short)(a2.f >> 16))) * bf2f((unsigned short)(gt.f >> 16)); o.f = cvtpk(e0, e1); }
        CMB(x) CMB(y) CMB(z) CMB(w)
#undef CMB
        *(v4u*)(y + (size_t)row * DM + h * 64 + c * 8) = o; }
}

__device__ __forceinline__ void retkv_pair(const bf16* proj, float* kvT, int pair, LAS unsigned char* L, int tid) {
    const int half = tid >> 8, t256 = tid & 255, lane = tid & 63, w4 = (tid >> 6) & 3;
    const int uu = pair * 2 + half, n = uu & 31, h = (uu >> 5) & 3, b = uu >> 7;
    constexpr int VP = 272;
    LAS unsigned char* Vt = L + half * (2 * 64 * VP); LAS unsigned char* Kz = Vt + 64 * VP;
    const float lg2 = __builtin_amdgcn_logf(1.0f - exp2f(-5.0f - (float)h));
    const size_t row0 = (size_t)b * SEQ + n * 128;
#pragma unroll
    for (int it = 0; it < 4; ++it) { const int idx = t256 + it * 256, j = idx >> 3, c = idx & 7;
        const bf16* src = proj + (row0 + j) * NIN + h * 64 + c * 8;
        const v4u kv = *(const v4u*)(src + C_DK), vv = *(const v4u*)(src + C_DV);
        const float z = __builtin_amdgcn_exp2f(lg2 * (float)(127 - j));
        v4u kz; kz.x = cvtpk(bf2f((unsigned short)(kv.x & 0xffff)) * z, bf2f((unsigned short)(kv.x >> 16)) * z); kz.y = cvtpk(bf2f((unsigned short)(kv.y & 0xffff)) * z, bf2f((unsigned short)(kv.y >> 16)) * z);
        kz.z = cvtpk(bf2f((unsigned short)(kv.z & 0xffff)) * z, bf2f((unsigned short)(kv.z >> 16)) * z); kz.w = cvtpk(bf2f((unsigned short)(kv.w & 0xffff)) * z, bf2f((unsigned short)(kv.w >> 16)) * z);
        vt_write8(Kz, VP, c, j, kz); vt_write8(Vt, VP, c, j, vv); }
    __syncthreads();
    { const int r = lane & 31, hh = lane >> 5, et = w4 >> 1, dt = w4 & 1;
      f32x16 acc;
#pragma unroll
      for (int i = 0; i < 16; ++i) acc[i] = 0.f;
      const int e = 32 * et + r, d = 32 * dt + r;
#pragma unroll
      for (int ks = 0; ks < 8; ++ks) { const int G = 2 * ks + hh;
          const bf16x8 af = *(const LAS bf16x8*)(Vt + e * VP + ((G ^ ((e >> 3) & 7)) << 4));
          const bf16x8 bfr = *(const LAS bf16x8*)(Kz + d * VP + ((G ^ ((d >> 3) & 7)) << 4));
          acc = MFMA32(af, bfr, acc); }
      float* o = kvT + (size_t)uu * 4096;
#pragma unroll
      for (int i = 0; i < 16; ++i) o[(32 * et + crow(i, hh)) * 64 + d] = acc[i]; }
    __syncthreads();
}
__device__ __forceinline__ void ret_pair(const bf16* proj, const float* kvT, const float* ret_g, bf16* y, int pair, LAS unsigned char* L, int tid) {
    const int half = tid >> 8, t256 = tid & 255, lane = tid & 63, w4 = (tid >> 6) & 3, w4u = __builtin_amdgcn_readfirstlane((tid >> 6) & 3);
    const int uu = pair * 2 + half, n = uu & 31, h = (uu >> 5) & 3, b = uu >> 7;
    constexpr int VP = 272;
    LAS unsigned char* Kimg = L + half * 45056; LAS unsigned char* Vt = Kimg + 128 * KP; LAS unsigned char* Pv = Vt + 64 * VP;
    const float lg2 = __builtin_amdgcn_logf(1.0f - exp2f(-5.0f - (float)h));
    const size_t row0 = (size_t)b * SEQ + n * 128;
#pragma unroll
    for (int it = 0; it < 4; ++it) { const int idx = t256 + it * 256, j = idx >> 3, c = idx & 7;
        const bf16* src = proj + (row0 + j) * NIN + h * 64 + c * 8;
        const v4u kv = *(const v4u*)(src + C_DK), vv = *(const v4u*)(src + C_DV);
        *(LAS v4u*)(Kimg + j * KP + c * 16) = kv;
        vt_write8(Vt, VP, c, keyperm(j), vv); }
    {
      const int e = t256 >> 2, d0 = (t256 & 3) * 16; const float cd = __builtin_amdgcn_exp2f(lg2 * 128.0f);
      f32x4 a0 = (f32x4){0.f, 0.f, 0.f, 0.f}, a1 = a0, a2 = a0, a3 = a0;
      const float* kp = kvT + (size_t)(uu - n) * 4096 + e * 64 + d0;
#pragma unroll 2
      for (int m = 0; m < n; ++m) { const f32x4* q4 = (const f32x4*)(kp + (size_t)m * 4096);
          a0 = a0 * cd + q4[0]; a1 = a1 * cd + q4[1]; a2 = a2 * cd + q4[2]; a3 = a3 * cd + q4[3]; }
      v4u w0, w1; w0.x = cvtpk(a0.x, a0.y); w0.y = cvtpk(a0.z, a0.w); w0.z = cvtpk(a1.x, a1.y); w0.w = cvtpk(a1.z, a1.w);
      w1.x = cvtpk(a2.x, a2.y); w1.y = cvtpk(a2.z, a2.w); w1.z = cvtpk(a3.x, a3.y); w1.w = cvtpk(a3.z, a3.w);
      *(LAS v4u*)(Pv + e * KP + d0 * 2) = w0; *(LAS v4u*)(Pv + e * KP + d0 * 2 + 16) = w1; }
    __syncthreads();
    {
        const int r = lane & 31, hh = lane >> 5, il = 32 * w4 + r;
        const size_t qrow = row0 + il;
        bf16x8 qf[4];
#pragma unroll
        for (int s = 0; s < 4; ++s) qf[s] = *(const bf16x8*)(proj + qrow * NIN + C_DQ + h * 64 + 16 * s + 8 * hh);
        f32x16 O[2], C[2];
#pragma unroll
        for (int i = 0; i < 16; ++i) { O[0][i] = 0.f; O[1][i] = 0.f; C[0][i] = 0.f; C[1][i] = 0.f; }
#pragma unroll 1
        for (int T = 0; T <= w4u; ++T) {
            f32x16 acc;
#pragma unroll
            for (int i = 0; i < 16; ++i) acc[i] = 0.f;
#pragma unroll
            for (int s = 0; s < 4; ++s) { const bf16x8 kf = *(const LAS bf16x8*)(Kimg + (32 * T + r) * KP + 32 * s + 16 * hh); acc = MFMA32(kf, qf[s], acc); }
#pragma unroll
            for (int i = 0; i < 16; ++i) { const int diff = il - 32 * T - crow(i, hh); acc[i] = (diff >= 0) ? acc[i] * __builtin_amdgcn_exp2f(lg2 * (float)diff) : 0.f; }
#pragma unroll
            for (int s = 0; s < 2; ++s) { const bf16x8 pf = PACK8(acc, s);
#pragma unroll
                for (int dt = 0; dt < 2; ++dt) { const int d = 32 * dt + r, G = 4 * T + 2 * s + hh;
                    const bf16x8 vf = *(const LAS bf16x8*)(Vt + d * VP + ((G ^ ((d >> 3) & 7)) << 4)); O[dt] = MFMA32(vf, pf, O[dt]); } }
        }
#pragma unroll
        for (int dt = 0; dt < 2; ++dt)
#pragma unroll
            for (int s = 0; s < 4; ++s) { const bf16x8 pf = *(const LAS bf16x8*)(Pv + (32 * dt + r) * KP + 32 * s + 16 * hh); C[dt] = MFMA32(pf, qf[s], C[dt]); }
        const float xi = __builtin_amdgcn_exp2f(lg2 * (float)(il + 1));
        float sm = 0.f;
#pragma unroll
        for (int dt = 0; dt < 2; ++dt)
#pragma unroll
            for (int i = 0; i < 16; ++i) { O[dt][i] += xi * C[dt][i]; sm += O[dt][i]; }
        sm += __shfl_xor(sm, 32); const float mu = sm * (1.f / 64.f); float sq = 0.f;
#pragma unroll
        for (int dt = 0; dt < 2; ++dt)
#pragma unroll
            for (int i = 0; i < 16; ++i) { O[dt][i] -= mu; sq += O[dt][i] * O[dt][i]; }
        sq += __shfl_xor(sq, 32); const float rstd = 1.f / sqrtf(sq * (1.f / 64.f) + EPS);
#pragma unroll
        for (int dt = 0; dt < 2; ++dt)
#pragma unroll
            for (int i4 = 0; i4 < 4; ++i4) { const int e = 32 * dt + 8 * i4 + 4 * hh;
                const f32x4 rg = *(const f32x4*)(ret_g + h * 64 + e); const v2u gt = *(const v2u*)(proj + qrow * NIN + C_DG + h * 64 + e);
                v2u w; w.x = cvtpk(O[dt][4 * i4] * rstd * rg.x * bf2f((unsigned short)(gt.x & 0xffff)), O[dt][4 * i4 + 1] * rstd * rg.y * bf2f((unsigned short)(gt.x >> 16)));
                w.y = cvtpk(O[dt][4 * i4 + 2] * rstd * rg.z * bf2f((unsigned short)(gt.y & 0xffff)), O[dt][4 * i4 + 3] * rstd * rg.w * bf2f((unsigned short)(gt.y >> 16)));
                *(v2u*)(y + qrow * DM + 768 + h * 64 + e) = w; }
    }
    __syncthreads();
}

__device__ __forceinline__ void sgu_unit(const bf16* proj, bf16* y, const float* sgu_g, const bf16* wb  , const float* sgu_b, int u, LAS unsigned char* L, int tid) {
    const int lane = tid & 63, wave = tid >> 6;
    constexpr int VP = 272;
    LAS unsigned char* Vt = L; LAS float* stats = (LAS float*)(L + 256 * VP);
    const size_t row0 = (size_t)u * 128;
#pragma unroll 1
    for (int i = 0; i < 16; ++i) { const int s = wave * 16 + i; const v2u w = *(const v2u*)(proj + (row0 + s) * NIN + C_BV + 4 * lane);
        const float v0 = bf2f((unsigned short)(w.x & 0xffff)), v1 = bf2f((unsigned short)(w.x >> 16)), v2 = bf2f((unsigned short)(w.y & 0xffff)), v3 = bf2f((unsigned short)(w.y >> 16));
        const float mean = wave_sum((v0 + v1) + (v2 + v3)) * (1.f / 256.f); const float d0 = v0 - mean, d1 = v1 - mean, d2 = v2 - mean, d3 = v3 - mean;
        const float rstd = 1.f / sqrtf(wave_sum((d0 * d0 + d1 * d1) + (d2 * d2 + d3 * d3)) * (1.f / 256.f) + EPS);
        if (lane == 0) { stats[2 * s] = mean; stats[2 * s + 1] = rstd; } }
    __syncthreads();
#pragma unroll 2
    for (int it = 0; it < 8; ++it) { const int idx = tid + it * 512, s = idx >> 5, c32 = idx & 31;
        const v4u w = *(const v4u*)(proj + (row0 + s) * NIN + C_BV + 8 * c32);
        const f32x4 g0 = *(const f32x4*)(sgu_g + 8 * c32), g1 = *(const f32x4*)(sgu_g + 8 * c32 + 4);
        const float mean = stats[2 * s], rstd = stats[2 * s + 1];
        v4u o; o.x = cvtpk((bf2f((unsigned short)(w.x & 0xffff)) - mean) * rstd * g0.x, (bf2f((unsigned short)(w.x >> 16)) - mean) * rstd * g0.y);
        o.y = cvtpk((bf2f((unsigned short)(w.y & 0xffff)) - mean) * rstd * g0.z, (bf2f((unsigned short)(w.y >> 16)) - mean) * rstd * g0.w);
        o.z = cvtpk((bf2f((unsigned short)(w.z & 0xffff)) - mean) * rstd * g1.x, (bf2f((unsigned short)(w.z >> 16)) - mean) * rstd * g1.y);
        o.w = cvtpk((bf2f((unsigned short)(w.w & 0xffff)) - mean) * rstd * g1.z, (bf2f((unsigned short)(w.w >> 16)) - mean) * rstd * g1.w);
        vt_write8(Vt + (c32 >> 3) * (64 * VP), VP, c32 & 7, s, o); }
    __syncthreads();
    { const int r = lane & 31, hh = lane >> 5, g = wave >> 1, dt = wave & 1, d = 32 * dt + r;
      const LAS unsigned char* vg = Vt + g * (64 * VP) + d * VP; const int sw = (d >> 3) & 7;
#pragma unroll 1
      for (int tt = 0; tt < 4; ++tt) { f32x16 acc;
#pragma unroll
          for (int i = 0; i < 16; ++i) acc[i] = 0.f;
          const bf16* wrow = wb + ((size_t)g * 128 + 32 * tt + r) * 128 + 8 * hh;
#pragma unroll 2
          for (int ks = 0; ks < 2 * (tt + 1); ++ks) { const bf16x8 af = *(const LAS bf16x8*)(vg + (((2 * ks + hh) ^ sw) << 4)); const bf16x8 bfr = *(const bf16x8*)(wrow + 16 * ks); acc = MFMA32(af, bfr, acc); }
          const int t = 32 * tt + r; const size_t row = row0 + t; const float bias = sgu_b[g * 128 + t];
#pragma unroll
          for (int i4 = 0; i4 < 4; ++i4) { const int d0 = 32 * dt + 8 * i4 + 4 * hh;
              const v2u uu = *(const v2u*)(proj + row * NIN + C_BU + g * 64 + d0), gt = *(const v2u*)(proj + row * NIN + C_BG + g * 64 + d0);
              v2u w; w.x = cvtpk((acc[4 * i4] + bias) * bf2f((unsigned short)(uu.x & 0xffff)) * bf2f((unsigned short)(gt.x & 0xffff)), (acc[4 * i4 + 1] + bias) * bf2f((unsigned short)(uu.x >> 16)) * bf2f((unsigned short)(gt.x >> 16)));
              w.y = cvtpk((acc[4 * i4 + 2] + bias) * bf2f((unsigned short)(uu.y & 0xffff)) * bf2f((unsigned short)(gt.y & 0xffff)), (acc[4 * i4 + 3] + bias) * bf2f((unsigned short)(uu.y >> 16)) * bf2f((unsigned short)(gt.y >> 16)));
              *(v2u*)(y + row * DM + 256 + g * 64 + d0) = w; } } }
    __syncthreads();
}
__device__ __forceinline__ void pool_unit(const bf16* proj, bf16* y, const bf16* pwt  , const float* pool_scale, int u, LAS unsigned char* L, int tid) {
    const int lane = tid & 63, wave = tid >> 6;
    constexpr int AP = 528;
    const size_t row0 = (size_t)u * 128; const int tok0 = (u & 31) * 128;
#pragma unroll 1
    for (int it = 0; it < 8; ++it) { const int idx = tid + it * 512, t = idx >> 5, c32 = idx & 31, g = c32 >> 3, pw = 2 << g;
        const int tok = tok0 + t, cnt = (tok + 1 < pw) ? tok + 1 : pw;
        const bf16* src = proj + (row0 + t) * NIN + C_CX + 8 * c32;
        float s[8];
#pragma unroll
        for (int q = 0; q < 8; ++q) s[q] = 0.f;
        v4u w0 = (v4u){0u, 0u, 0u, 0u};
        for (int j = 0; j < cnt; ++j) { const v4u w = *(const v4u*)(src - (size_t)j * NIN); if (j == 0) w0 = w;
            s[0] += bf2f((unsigned short)(w.x & 0xffff)); s[1] += bf2f((unsigned short)(w.x >> 16)); s[2] += bf2f((unsigned short)(w.y & 0xffff)); s[3] += bf2f((unsigned short)(w.y >> 16));
            s[4] += bf2f((unsigned short)(w.z & 0xffff)); s[5] += bf2f((unsigned short)(w.z >> 16)); s[6] += bf2f((unsigned short)(w.w & 0xffff)); s[7] += bf2f((unsigned short)(w.w >> 16)); }
        const float ic = 1.0f / (float)cnt;
        v4u o; o.x = cvtpk(s[0] * ic - bf2f((unsigned short)(w0.x & 0xffff)), s[1] * ic - bf2f((unsigned short)(w0.x >> 16))); o.y = cvtpk(s[2] * ic - bf2f((unsigned short)(w0.y & 0xffff)), s[3] * ic - bf2f((unsigned short)(w0.y >> 16)));
        o.z = cvtpk(s[4] * ic - bf2f((unsigned short)(w0.z & 0xffff)), s[5] * ic - bf2f((unsigned short)(w0.z >> 16))); o.w = cvtpk(s[6] * ic - bf2f((unsigned short)(w0.w & 0xffff)), s[7] * ic - bf2f((unsigned short)(w0.w >> 16)));
        *(LAS v4u*)(L + t * AP + c32 * 16) = o; }
    __syncthreads();
    { const int r = lane & 31, hh = lane >> 5, g = wave >> 1, dt = wave & 1;
      bf16x8 af[4];
#pragma unroll
      for (int ks = 0; ks < 4; ++ks) af[ks] = *(const bf16x8*)(pwt + ((size_t)g * 64 + 32 * dt + r) * 64 + 16 * ks + 8 * hh);
#pragma unroll 1
      for (int tt = 0; tt < 4; ++tt) { f32x16 acc;
#pragma unroll
          for (int i = 0; i < 16; ++i) acc[i] = 0.f;
#pragma unroll
          for (int ks = 0; ks < 4; ++ks) { const bf16x8 bfr = *(const LAS bf16x8*)(L + (32 * tt + r) * AP + (g * 64 + 16 * ks + 8 * hh) * 2); acc = MFMA32(af[ks], bfr, acc); }
          const size_t row = row0 + 32 * tt + r;
#pragma unroll
          for (int i4 = 0; i4 < 4; ++i4) { const int d0 = 32 * dt + 8 * i4 + 4 * hh;
              const f32x4 sc = *(const f32x4*)(pool_scale + g * 64 + d0); const v2u gt = *(const v2u*)(proj + row * NIN + C_CG + g * 64 + d0);
              v2u w; w.x = cvtpk(acc[4 * i4] * sc.x * bf2f((unsigned short)(gt.x & 0xffff)), acc[4 * i4 + 1] * sc.y * bf2f((unsigned short)(gt.x >> 16)));
              w.y = cvtpk(acc[4 * i4 + 2] * sc.z * bf2f((unsigned short)(gt.y & 0xffff)), acc[4 * i4 + 3] * sc.w * bf2f((unsigned short)(gt.y >> 16)));
              *(v2u*)(y + row * DM + 512 + g * 64 + d0) = w; } } }
    __syncthreads();
}

#define PHASE_IDS() int tid = threadIdx.x; asm volatile("" : "+v"(tid)); const int lane = tid & 63; const int wave = __builtin_amdgcn_readfirstlane(tid >> 6); const int gw = (int)blockIdx.x * 8 + wave; (void)lane; (void)gw
#define PHASE_PTRS() unsigned char* ws = p.ws; asm volatile("" : "+s"(ws)); const float* x = p.in[0]; const float* w_in = p.in[2]; const float* w_out = p.in[9]; \
    const float* PRM = (const float*)(ws + WS_SMALL); bf16* WinT = (bf16*)(ws + WS_WIN); bf16* WoutT = (bf16*)(ws + WS_WOUT); bf16* XB = (bf16*)(ws + WS_XB); bf16* PROJ = (bf16*)(ws + WS_PROJ); \
    bf16* Y = (bf16*)(ws + WS_Y); bf16* Z = (bf16*)(ws + WS_Z); float* KVT = (float*)(ws + WS_KV); bf16* OG = (bf16*)(ws + WS_OG); float* LSE = (float*)(ws + WS_LSE); \
    float* R0P_ = (float*)(ws + WS_R0 + R0_PPART); float* R0Y_ = (float*)(ws + WS_R0 + R0_Y); float* R0Z_ = (float*)(ws + WS_R0 + R0_ZPART); \
    (void)x; (void)w_in; (void)w_out; (void)PRM; (void)WinT; (void)WoutT; (void)XB; (void)PROJ; (void)Y; (void)Z; (void)KVT; (void)OG; (void)LSE; (void)R0P_; (void)R0Y_; (void)R0Z_
__global__ void __launch_bounds__(512, 2) fwd(Params p) {
    extern __shared__ __attribute__((aligned(16))) unsigned char lds[];
    cg::grid_group grid = cg::this_grid();
    LAS unsigned char* L = (LAS unsigned char*)lds;
    const int G = gridDim.x, NGW = G * 8;
    {
        PHASE_IDS(); PHASE_PTRS();
        { float* prm = (float*)(ws + WS_SMALL);
          for (int i = (int)blockIdx.x * 512 + tid; i < P_END; i += G * 512) { float v;
              if (i < P_SGUG) v = p.in[1][i]; else if (i < P_SGUW) v = p.in[3][i - P_SGUG]; else if (i < P_SGUB) v = p.in[4][i - P_SGUW]; else if (i < P_POOLW) v = p.in[5][i - P_SGUB];
              else if (i < P_POOLS) v = p.in[6][i - P_POOLW]; else if (i < P_RETG) v = p.in[7][i - P_POOLS]; else if (i < P_POSTG) v = p.in[8][i - P_RETG]; else v = p.in[10][i - P_POSTG];
              prm[i] = v; } }
        { bf16* sw = (bf16*)(ws + WS_SGUWB); bf16* pw = (bf16*)(ws + WS_PWT);
          for (int i = (int)blockIdx.x * 512 + tid; i < 2 * 65536; i += G * 512) { const int s = i & 127, t = (i >> 7) & 127; sw[i] = (s <= t) ? (bf16)f2bf(p.in[4][i]) : (bf16)0; }
          for (int i = (int)blockIdx.x * 512 + tid; i < 2 * 16384; i += G * 512) { const int c = i & 63, d = (i >> 6) & 63, lg = i >> 12; pw[i] = (bf16)f2bf(p.in[6][(size_t)lg * 4096 + c * 64 + d]); } }
        LAS float* scr = (LAS float*)(L + wave * 16384);
        constexpr int I_IN = (DM / 64) * (NIN / 32), I_OUT = (DM / 64) * (DM / 32), I_L = I_IN + I_OUT;
        for (int it = gw; it < DEPTH * I_L; it += NGW) { const int l = it / I_L; int r = it % I_L;
            if (r < I_IN) p0_transpose_item(w_in + (size_t)l * DM * NIN, DM, NIN, WinT + (size_t)l * NIN * DM, p.in[1] + l * DM, 1, scr, r, lane);
            else p0_transpose_item(w_out + (size_t)l * DM * DM, DM, DM, WoutT + (size_t)l * DM * DM, nullptr, 0, scr, r - I_IN, lane); }
        for (int m = gw; m < M; m += NGW) rms_row_to_bf16(x + (size_t)m * DM, XB + (size_t)m * DM, lane);
    }
    grid.sync();
#pragma unroll
    for (int l = 0; l < DEPTH; ++l) {
        { PHASE_PTRS(); pg8::Gemm g{XB, WinT + (size_t)l * NIN * DM, M, NIN, DM}; pg8::StaticOrder S; S.init(M, NIN, G, (int)blockIdx.x);
          pg8::EpiOut E{PROJ, NIN, (1u << 3) | (1u << 6) | (1u << 8) | (1u << 12)};
          pg8::gemm_phase<pg8::EpiOut, pg8::StaticOrder, true, true>((PG8_LAS unsigned char*)L, g, S, E); }
        if ((int)blockIdx.x >= 128) {   PHASE_IDS(); PHASE_PTRS();
            const float* xin = (l == 0) ? x : p.out;
            for (int task = ((int)blockIdx.x - 128) + 128 * wave; task < 52 * 8; task += 1024) r0_dot_task(xin, (size_t)SEQ * DM, 1, PRM + P_PREG + l * DM, w_in + (size_t)l * DM * NIN, NIN, R0P_, task, 52, lane, (LAS float*)(L + wave * 4096));
        }
        grid.sync();
        {
            PHASE_IDS(); PHASE_PTRS();
            if ((int)blockIdx.x >= 248 && wave == 0) r0_mix(R0P_, R0Y_, (int)blockIdx.x - 248, PRM + P_SGUG + l * 256, PRM + P_SGUW + (size_t)l * 65536, PRM + P_SGUB + l * 512, PRM + P_RETG + l * 256, lane);
            for (int pr = (int)blockIdx.x; pr < 512; pr += G) retkv_pair(PROJ, KVT, pr, L, tid);
            for (int u = (int)blockIdx.x; u < 1536; u += G) attn_unit(PROJ, OG, LSE, u, L, tid);
            for (int u = (int)blockIdx.x; u < 256; u += G) sgu_unit(PROJ, Y, PRM + P_SGUG + l * 256, (const bf16*)(ws + WS_SGUWB) + (size_t)l * 65536, PRM + P_SGUB + l * 512, u, L, tid);
            for (int u = (int)blockIdx.x; u < 256; u += G) pool_unit(PROJ, Y, (const bf16*)(ws + WS_PWT) + (size_t)l * 16384, PRM + P_POOLS + l * 256, u, L, tid);
        }
        grid.sync();
        { PHASE_IDS(); PHASE_PTRS(); for (int pr = (int)blockIdx.x; pr < 512; pr += G) ret_pair(PROJ, KVT, PRM + P_RETG + l * 256, Y, pr, L, tid);
          attn_combine(PROJ, OG, LSE, Y, (int)blockIdx.x * 512 + tid, G * 512); }
        grid.sync();
        { PHASE_PTRS(); pg8::Gemm g{Y, WoutT + (size_t)l * DM * DM, M, DM, DM}; pg8::StaticOrder S; S.init(M, DM, G, (int)blockIdx.x);
          pg8::EpiOut E{Z, DM, 0u};
          pg8::gemm_phase<pg8::EpiOut, pg8::StaticOrder, true, true>((PG8_LAS unsigned char*)L, g, S, E); }
        if ((int)blockIdx.x < 128) { PHASE_IDS(); PHASE_PTRS(); if (wave == 7) r0_dot_task(R0Y_, (size_t)DM, 0, nullptr, w_out + (size_t)l * DM * DM, DM, R0Z_, (int)blockIdx.x, 16, lane, (LAS float*)(L + wave * 4096)); }
        grid.sync();
        { PHASE_IDS(); PHASE_PTRS(); const float* xres = (l == 0) ? x : p.out;
          for (int m = gw; m < M; m += NGW) post_row(xres + (size_t)m * DM, Z + (size_t)m * DM, ((m & (SEQ - 1)) == 0) ? R0Z_ + (size_t)(m >> 12) * DM : nullptr, PRM + P_POSTG + l * DM, p.out + (size_t)m * DM, (l + 1 < DEPTH) ? XB + (size_t)m * DM : nullptr, lane); }
        if (l + 1 < DEPTH) grid.sync();
    }
}

extern "C" void kernel_launch(void* const* d_in, const int* in_sizes, int n_in, void* d_out, int out_size, void* d_ws, size_t ws_size, hipStream_t stream) {
    static int grid = 0;
    if (grid == 0) {
        if (n_in != 11 || in_sizes[0] != M * DM || out_size != M * DM || ws_size < WS_END) { fprintf(stderr, "kernel_launch: unexpected shapes (n_in %d, in0 %d, out %d, ws %zu)\n", n_in, n_in > 0 ? in_sizes[0] : -1, out_size, ws_size); grid = -1; return; }
        int dev = 0, cus = 0, per_cu = 0;
        hipGetDevice(&dev); hipDeviceGetAttribute(&cus, hipDeviceAttributeMultiprocessorCount, dev);
        if (hipFuncSetAttribute((const void*)fwd, hipFuncAttributeMaxDynamicSharedMemorySize, LDS_BYTES) != hipSuccess) { fprintf(stderr, "kernel_launch: hipFuncSetAttribute failed\n"); grid = -1; return; }
        if (hipOccupancyMaxActiveBlocksPerMultiprocessor(&per_cu, (const void*)fwd, 512, LDS_BYTES) != hipSuccess || per_cu < 1) { fprintf(stderr, "kernel_launch: occupancy query says %d\n", per_cu); per_cu = 1; }
        (void)hipGetLastError();
        grid = cus * 1;
        fprintf(stderr, "kernel_launch: cus %d per_cu %d grid %d\n", cus, per_cu, grid);
    }
    if (grid < 0) return;
    Params p{};
    for (int i = 0; i < 11; ++i) p.in[i] = (const float*)d_in[i];
    p.out = (float*)d_out; p.ws = (unsigned char*)d_ws;
    void* args[] = {&p};
    hipError_t e = hipLaunchCooperativeKernel((const void*)fwd, dim3(grid), dim3(512), args, LDS_BYTES, stream);
    if (e != hipSuccess) fprintf(stderr, "kernel_launch: cooperative launch failed: %s (grid %d)\n", hipGetErrorString(e), grid);
}
```

```cpp
#include <hip/hip_runtime.h>
#include <hip/hip_cooperative_groups.h>
#include <cstdio>
#include <cstdint>
namespace cg = cooperative_groups;
namespace pg8 {
#define PG8_LAS __attribute__((address_space(3)))
typedef unsigned short bf16_t;
typedef short bf16x8 __attribute__((ext_vector_type(8)));
typedef float f32x4 __attribute__((ext_vector_type(4)));
typedef unsigned u32x4 __attribute__((ext_vector_type(4)));
constexpr int BM = 256, BK = 64, HALF = 128, HTB = HALF * BK * 2  , STAGE_BYTES = 8 * HTB, NXCD = 8, WGM = 8;

__host__ __device__ __forceinline__ int lds_byte(int r, int c) { const int st = (r >> 4) * 2 + (c >> 5), rr = r & 15, cc = c & 31, ob = rr * 64 + cc * 2; return st * 1024 + (ob ^ (((ob >> 9) & 1) << 5)); }
__host__ __device__ __forceinline__ void stage_rc(int b, int& R, int& C) { const int st = b / 1024, sb = b % 1024, swz = sb ^ (((sb >> 9) & 1) << 5); R = (st >> 1) * 16 + swz / 64; C = (st & 1) * 32 + (swz % 64) / 2; }
__host__ __device__ __forceinline__ int perm32(int rho) { const int n = rho >> 4, i = rho & 15; return 8 * (i >> 2) + 4 * n + (i & 3); }

struct Unit { int pm, pn; };
struct Gemm { const bf16_t* A; const bf16_t* Bt; int M, N, K; };

struct StaticOrder {
    int nM, nN, nwg, G, c;
    __host__ __device__ void init(int M, int N, int G_, int c_) { nM = M / BM; nN = N / BM; nwg = nM * nN; G = G_; c = c_; }
    __host__ __device__ bool next(int i, Unit& u) const {
        const long L = (long)i * G + c; if (L >= nwg) return false;
        int wgid = (int)L; { const int q = nwg / NXCD, r = nwg % NXCD, xcd = wgid % NXCD, off = wgid / NXCD; wgid = (xcd < r ? xcd * (q + 1) : r * (q + 1) + (xcd - r) * q) + off; }
        const int nig = WGM * nN, gid = wgid / nig, fm = gid * WGM, gsz = (nM - fm) < WGM ? (nM - fm) : WGM;
        u.pm = fm + ((wgid % nig) % gsz); u.pn = (wgid % nig) / gsz; return true;
    }
    __device__ __forceinline__ void a_ready(const Unit&) const {}
    __device__ __forceinline__ void done(const Unit&) const {}
};

__device__ __forceinline__ unsigned cvt_pk_bf16(float lo, float hi) { unsigned r; asm volatile("v_cvt_pk_bf16_f32 %0, %1, %2" : "=v"(r) : "v"(lo), "v"(hi)); return r; }
__device__ __forceinline__ float silu_f(float x) { return x / (1.0f + __expf(-x)); }
struct EpiOut {
    static constexpr bool PERM = true, AFTER_DRAIN = false;
    bf16_t* O; int ldc; unsigned gate_mask;
    __device__ __forceinline__ void operator()(const f32x4 (&acc)[2][2][4][2], const Unit& u, int wr, int wc, int fr, int fq) const {
        const int row0 = u.pm * BM + wr * 64 + fr; const int col0 = u.pn * BM + wc * 32 + 8 * fq;
        const bool gate = (gate_mask >> u.pn) & 1u;
#pragma unroll
        for (int ai = 0; ai < 2; ++ai)
#pragma unroll
            for (int m = 0; m < 4; ++m) { bf16_t* rowp = O + (size_t)(row0 + ai * HALF + m * 16) * ldc + col0;
#pragma unroll
                for (int bj = 0; bj < 2; ++bj) { f32x4 v0 = acc[ai][bj][m][0], v1 = acc[ai][bj][m][1];
                    if (gate) { v0 = (f32x4){silu_f(v0[0]), silu_f(v0[1]), silu_f(v0[2]), silu_f(v0[3])}; v1 = (f32x4){silu_f(v1[0]), silu_f(v1[1]), silu_f(v1[2]), silu_f(v1[3])}; }
                    u32x4 w; w.x = cvt_pk_bf16(v0[0], v0[1]); w.y = cvt_pk_bf16(v0[2], v0[3]); w.z = cvt_pk_bf16(v1[0], v1[1]); w.w = cvt_pk_bf16(v1[2], v1[3]);
                    *(u32x4*)(rowp + bj * HALF) = w; } }
    }
};
template <class Epi, class Sched, bool ALIGN_EPI = false, bool SP2 = false>
__device__ __forceinline__ void gemm_phase(PG8_LAS unsigned char* lds, const Gemm g, const Sched& S, const Epi& E) {
    const int tid = threadIdx.x, wid = __builtin_amdgcn_readfirstlane(tid >> 6), lane = tid & 63, wr = wid >> 2, wc = wid & 3, fr = lane & 15, fq = lane >> 4;
    const int K = g.K, nt = K / BK;
    unsigned voffA[2], voffB[2];
#pragma unroll
    for (int i = 0; i < 2; ++i) { int R, C; stage_rc(tid * 16 + i * 8192, R, C); const int Rb = Epi::PERM ? ((R & ~31) + perm32(R & 31)) : R;
        voffA[i] = (unsigned)(R * K + C) * 2u; voffB[i] = (unsigned)(Rb * K + C) * 2u; }
    const size_t kstep = (size_t)(BK * 2);
    const size_t hstep = (size_t)HALF * K * 2;
    const size_t tstep = 2 * hstep;
    const unsigned ldsw = (unsigned)wid * 1024u;
    const int aoff = lds_byte(wr * 64 + fr, fq * 8), boff = lds_byte(wc * 32 + fr, fq * 8);
#define PG8_SA(b, h) (((b) * 2 + (h)) * HTB)
#define PG8_SB(b, h) ((4 + (b) * 2 + (h)) * HTB)
#define PG8_STAGE(bufoff, gbase, voff) do { _Pragma("unroll") for (int _i = 0; _i < 2; ++_i) \
        __builtin_amdgcn_global_load_lds((const unsigned*)((const char*)(gbase) + (voff)[_i]), (PG8_LAS unsigned*)(lds + (bufoff) + ldsw + _i * 8192), 16, 0, 0); } while (0)
#define PG8_LDA(dst, b, h) do { _Pragma("unroll") for (int m = 0; m < 4; ++m) _Pragma("unroll") for (int k = 0; k < 2; ++k) dst[m][k] = *(const PG8_LAS bf16x8*)(lds + PG8_SA(b, h) + aoff + m * 2048 + k * 1024); } while (0)
#define PG8_LDB(dst, b, h) do { _Pragma("unroll") for (int n = 0; n < 2; ++n) _Pragma("unroll") for (int k = 0; k < 2; ++k) dst[n][k] = *(const PG8_LAS bf16x8*)(lds + PG8_SB(b, h) + boff + n * 2048 + k * 1024); } while (0)
#define PG8_MMA(ai, bj, At, Bt) do { __builtin_amdgcn_s_setprio(1); _Pragma("unroll") for (int m = 0; m < 4; ++m) _Pragma("unroll") for (int n = 0; n < 2; ++n) _Pragma("unroll") for (int k = 0; k < 2; ++k) \
        acc[ai][bj][m][n] = __builtin_amdgcn_mfma_f32_16x16x32_bf16(Bt[n][k], At[m][k], acc[ai][bj][m][n], 0, 0, 0); __builtin_amdgcn_s_setprio(0); } while (0)
#define PG8_WAIT_V(n) asm volatile("s_waitcnt vmcnt(" #n ")" ::: "memory")
#define PG8_WAIT_L(n) asm volatile("s_waitcnt lgkmcnt(" #n ")" ::: "memory")
#define PG8_BAR __builtin_amdgcn_s_barrier()
#define PG8_SCHED __builtin_amdgcn_sched_barrier(0)
    Unit cur, nxt; int ui = 0;
    if (!S.next(0, cur)) return;
    f32x4 acc[2][2][4][2];
#pragma unroll
    for (int a = 0; a < 2; ++a)
#pragma unroll
        for (int b = 0; b < 2; ++b)
#pragma unroll
            for (int m = 0; m < 4; ++m)
#pragma unroll
                for (int n = 0; n < 2; ++n) acc[a][b][m][n] = (f32x4){0.f, 0.f, 0.f, 0.f};
    bf16x8 At[4][2], B0[2][2], B1[2][2];
    const char* cA = (const char*)g.A + (size_t)cur.pm * tstep; const char* cB = (const char*)g.Bt + (size_t)cur.pn * tstep;
    S.a_ready(cur);
    if constexpr (SP2) {
        PG8_STAGE(PG8_SB(0, 0), cB, voffB); PG8_STAGE(PG8_SB(0, 1), cB + hstep, voffB); PG8_STAGE(PG8_SA(0, 0), cA, voffA); PG8_STAGE(PG8_SA(0, 1), cA + hstep, voffA);
        if (wr == 1) PG8_BAR;
        PG8_WAIT_V(2); PG8_BAR;
        PG8_STAGE(PG8_SB(1, 0), cB + kstep, voffB); PG8_STAGE(PG8_SA(1, 0), cA + kstep, voffA); PG8_STAGE(PG8_SB(1, 1), cB + hstep + kstep, voffB);
        PG8_WAIT_V(6); PG8_BAR;
    } else {
        PG8_STAGE(PG8_SB(0, 0), cB, voffB); PG8_STAGE(PG8_SA(0, 0), cA, voffA); PG8_STAGE(PG8_SB(0, 1), cB + hstep, voffB); PG8_STAGE(PG8_SA(0, 1), cA + hstep, voffA);
        if (wr == 1) PG8_BAR;
        PG8_WAIT_V(4); PG8_BAR;
        PG8_STAGE(PG8_SB(1, 0), cB + kstep, voffB); PG8_STAGE(PG8_SA(1, 0), cA + kstep, voffA); PG8_STAGE(PG8_SB(1, 1), cB + hstep + kstep, voffB);
        PG8_WAIT_V(6); PG8_BAR;
    }
    for (;;) {
        const bool has_next = S.next(ui + 1, nxt);
        const char* nA = has_next ? (const char*)g.A + (size_t)nxt.pm * tstep : cA; const char* nB = has_next ? (const char*)g.Bt + (size_t)nxt.pn * tstep : cB;
        for (int t = 0; t < nt; t += 2) {
            const bool last = (t == nt - 2);
            const char* a1 = cA + (size_t)(t + 1) * kstep;
            const char* a2 = last ? nA : cA + (size_t)(t + 2) * kstep; const char* b2 = last ? nB : cB + (size_t)(t + 2) * kstep;
            const char* a3 = a2 + kstep; const char* b3 = b2 + kstep;
            if (last && has_next) S.a_ready(nxt);
            if constexpr (SP2) {
            PG8_LDB(B0, 0, 0); PG8_LDB(B1, 0, 1); PG8_SCHED; PG8_LDA(At, 0, 0); PG8_STAGE(PG8_SA(1, 1), a1 + hstep, voffA);
            PG8_WAIT_V(8); PG8_WAIT_L(0); PG8_BAR; PG8_MMA(0, 0, At, B0); PG8_MMA(0, 1, At, B1); PG8_BAR; PG8_SCHED;
            PG8_LDA(At, 0, 1); PG8_STAGE(PG8_SB(0, 0), b2, voffB); PG8_STAGE(PG8_SB(0, 1), b2 + hstep, voffB); PG8_STAGE(PG8_SA(0, 0), a2, voffA);
            PG8_WAIT_V(8); PG8_WAIT_L(0); PG8_BAR; PG8_MMA(1, 0, At, B0); PG8_MMA(1, 1, At, B1); PG8_BAR; PG8_SCHED;
            PG8_LDB(B0, 1, 0); PG8_LDB(B1, 1, 1); PG8_SCHED; PG8_LDA(At, 1, 0); PG8_STAGE(PG8_SA(0, 1), a2 + hstep, voffA);
            PG8_WAIT_V(8); PG8_WAIT_L(0); PG8_BAR; PG8_MMA(0, 0, At, B0); PG8_MMA(0, 1, At, B1); PG8_BAR; PG8_SCHED;
            PG8_LDA(At, 1, 1); PG8_STAGE(PG8_SB(1, 0), b3, voffB); PG8_STAGE(PG8_SB(1, 1), b3 + hstep, voffB); PG8_STAGE(PG8_SA(1, 0), a3, voffA);
            PG8_WAIT_V(8); PG8_WAIT_L(0); PG8_BAR; PG8_MMA(1, 0, At, B0); PG8_MMA(1, 1, At, B1); PG8_BAR; PG8_SCHED;
            } else {
            PG8_LDB(B0, 0, 0); PG8_SCHED; PG8_LDA(At, 0, 0); PG8_STAGE(PG8_SA(1, 1), a1 + hstep, voffA);
            PG8_WAIT_L(8); PG8_BAR; PG8_WAIT_L(0); PG8_MMA(0, 0, At, B0); PG8_BAR; PG8_SCHED;
            PG8_LDB(B1, 0, 1); PG8_STAGE(PG8_SB(0, 0), b2, voffB);
            PG8_BAR; PG8_WAIT_L(0); PG8_MMA(0, 1, At, B1); PG8_BAR;
            PG8_LDA(At, 0, 1); PG8_STAGE(PG8_SA(0, 0), a2, voffA);
            PG8_BAR; PG8_WAIT_L(0); PG8_MMA(1, 0, At, B0); PG8_BAR; PG8_SCHED;
            PG8_STAGE(PG8_SB(0, 1), b2 + hstep, voffB);
            PG8_WAIT_V(6); PG8_BAR; PG8_MMA(1, 1, At, B1); PG8_BAR;
            PG8_LDB(B0, 1, 0); PG8_SCHED; PG8_LDA(At, 1, 0); PG8_STAGE(PG8_SA(0, 1), a2 + hstep, voffA);
            PG8_WAIT_L(8); PG8_BAR; PG8_WAIT_L(0); PG8_MMA(0, 0, At, B0); PG8_BAR; PG8_SCHED;
            PG8_LDB(B1, 1, 1); PG8_STAGE(PG8_SB(1, 0), b3, voffB);
            PG8_BAR; PG8_WAIT_L(0); PG8_MMA(0, 1, At, B1); PG8_BAR;
            PG8_LDA(At, 1, 1); PG8_STAGE(PG8_SA(1, 0), a3, voffA);
            PG8_BAR; PG8_WAIT_L(0); PG8_MMA(1, 0, At, B0); PG8_BAR; PG8_SCHED;
            PG8_STAGE(PG8_SB(1, 1), b3 + hstep, voffB);
            PG8_WAIT_V(6); PG8_BAR; PG8_MMA(1, 1, At, B1); PG8_BAR;
            }
        }
        if constexpr (ALIGN_EPI) { if (wr == 0) PG8_BAR; }
        if constexpr (!Epi::AFTER_DRAIN) { E(acc, cur, wr, wc, fr, fq); S.done(cur); }
        if (!has_next) break;
#pragma unroll
        for (int a = 0; a < 2; ++a)
#pragma unroll
            for (int b = 0; b < 2; ++b)
#pragma unroll
                for (int m = 0; m < 4; ++m)
#pragma unroll
                    for (int n = 0; n < 2; ++n) acc[a][b][m][n] = (f32x4){0.f, 0.f, 0.f, 0.f};
        cur = nxt; cA = nA; cB = nB; ++ui;
        if constexpr (ALIGN_EPI) { if (wr == 1) PG8_BAR; }
    }
    PG8_WAIT_V(0);
    if constexpr (!ALIGN_EPI) { if (wr == 0) PG8_BAR; }
    PG8_BAR;
    if constexpr (Epi::AFTER_DRAIN) { E.fused(acc, cur, wr, wc, fr, fq, lds, wid, lane); S.done(cur); }
#undef PG8_SA
#undef PG8_SB
#undef PG8_STAGE
#undef PG8_LDA
#undef PG8_LDB
#undef PG8_MMA
#undef PG8_WAIT_V
#undef PG8_WAIT_L
#undef PG8_BAR
#undef PG8_SCHED
}
}
#define LAS __attribute__((address_space(3)))
typedef unsigned short bf16;
typedef unsigned v4u __attribute__((ext_vector_type(4)));
typedef unsigned v2u __attribute__((ext_vector_type(2)));
typedef float f32x4 __attribute__((ext_vector_type(4)));
constexpr int SEQ = 4096, BATCH = 8, DM = 1024, M = BATCH * SEQ, NIN = 3328, DEPTH = 2;
constexpr float EPS = 1e-6f;
constexpr float LOG2E = 1.4426950408889634f;
constexpr float QSCALE = 0.125f * LOG2E;
constexpr int C_AQ = 0, C_AK = 256, C_AV = 512, C_AG = 768, C_BU = 1024, C_BV = 1280, C_BG = 1536, C_CX = 1792, C_CG = 2048, C_DQ = 2304, C_DK = 2560, C_DV = 2816, C_DG = 3072;
constexpr size_t MiB = 1u << 20;
constexpr size_t WS_WIN = 0, WS_WOUT = 13 * MiB, WS_SMALL = 17 * MiB, WS_XB = 18 * MiB, WS_PROJ = 82 * MiB, WS_Y = 290 * MiB, WS_Z = 354 * MiB, WS_OG = 418 * MiB, WS_LSE = 466 * MiB, WS_KV = 468 * MiB, WS_R0 = 484 * MiB, WS_CTL = 490 * MiB, WS_END = 491 * MiB;
constexpr size_t R0_PPART = 0, R0_Y = 4 * MiB, R0_H = R0_Y + 65536, R0_ZPART = 5 * MiB;
constexpr int R0_KC = 32, R0_KCZ = 8;
constexpr int LDS_BYTES = 147456;
constexpr size_t WS_SGUWB = WS_SMALL + 704 * 1024, WS_PWT = WS_SMALL + 960 * 1024;
constexpr int P_PREG = 0, P_SGUG = 2048, P_SGUW = 2560, P_SGUB = 133632, P_POOLW = 134656, P_POOLS = 167424, P_RETG = 167936, P_POSTG = 168448, P_END = 170496;

__device__ __forceinline__ float bf2f(unsigned short u) { return __uint_as_float(((unsigned)u) << 16); }
__device__ __forceinline__ unsigned f2bf(float f) { unsigned u = __float_as_uint(f); return (u + 0x7fffu + ((u >> 16) & 1u)) >> 16; }
__device__ __forceinline__ unsigned pk2(float lo, float hi) { return f2bf(lo) | (f2bf(hi) << 16); }
__device__ __forceinline__ float wave_sum(float v) {
#pragma unroll
    for (int o = 1; o < 64; o <<= 1) v += __shfl_xor(v, o);
    return v;
}
#define LDS_WAIT() asm volatile("s_waitcnt lgkmcnt(0)" ::: "memory")

struct Params { const float* in[11]; float* out; unsigned char* ws; };

__device__ __forceinline__ void p0_transpose_item(const float* W, int K, int N, bf16* WT, const float* rs, int col_mode, LAS float* scr, int item, int lane) {
    const int nblk = N / 32, kb = item / nblk, nb = item % nblk, k0 = 64 * kb, n0 = 32 * nb;
    float cs = 1.f;
    if (col_mode) { const int n = n0 + (lane & 31); if (n < 256) cs = QSCALE; else if (n >= C_DK && n < C_DK + 256) cs = 0.125f; }
#pragma unroll 8
    for (int i = 0; i < 32; ++i) { const int kk = 2 * i + (lane >> 5); float v = W[(size_t)(k0 + kk) * N + n0 + (lane & 31)] * cs; if (rs) v *= rs[k0 + kk]; scr[kk * 33 + (lane & 31)] = v; }
    LDS_WAIT(); asm volatile("" ::: "memory");
    const int c = lane & 7;
#pragma unroll
    for (int j = 0; j < 4; ++j) { const int n = (lane >> 3) + 8 * j; const LAS float* s = scr + (8 * c) * 33 + n;
        v4u o; o.x = pk2(s[0 * 33], s[1 * 33]); o.y = pk2(s[2 * 33], s[3 * 33]); o.z = pk2(s[4 * 33], s[5 * 33]); o.w = pk2(s[6 * 33], s[7 * 33]);
        *(v4u*)(WT + (size_t)(n0 + n) * K + k0 + 8 * c) = o; }
    LDS_WAIT(); asm volatile("" ::: "memory");
}

__device__ __forceinline__ void rms_row_to_bf16(const float* xrow, bf16* orow, int lane, float* h0row = nullptr, const float* pgn = nullptr) {
    const f32x4* xr = (const f32x4*)xrow + lane;
    f32x4 v[4]; float s = 0.f;
#pragma unroll
    for (int j = 0; j < 4; ++j) { v[j] = xr[64 * j]; s += (v[j].x * v[j].x + v[j].y * v[j].y) + (v[j].z * v[j].z + v[j].w * v[j].w); }
    const float rstd = 1.f / sqrtf(wave_sum(s) * (1.f / DM) + EPS);
    v2u* o8 = (v2u*)orow + lane;
#pragma unroll
    for (int j = 0; j < 4; ++j) { v2u w; w.x = pk2(v[j].x * rstd, v[j].y * rstd); w.y = pk2(v[j].z * rstd, v[j].w * rstd); o8[64 * j] = w; }
    if (h0row) {
#pragma unroll
        for (int j = 0; j < 4; ++j) *((f32x4*)h0row + lane + 64 * j) = v[j] * rstd * *((const f32x4*)pgn + lane + 64 * j); }
}

__device__ __forceinline__ void post_row_z(const float* xres, const f32x4 (&z)[4], const float* pg, float* orow, bf16* xbrow, int lane, float* h0row, const float* pgn) {
    const f32x4* xr = (const f32x4*)xres + lane; const f32x4* gr = (const f32x4*)pg + lane;
    float s = 0.f;
#pragma unroll
    for (int j = 0; j < 4; ++j) s += (z[j].x * z[j].x + z[j].y * z[j].y) + (z[j].z * z[j].z + z[j].w * z[j].w);
    const float rstd = 1.f / sqrtf(wave_sum(s) * (1.f / DM) + EPS);
    f32x4 xn[4]; float s2 = 0.f;
#pragma unroll
    for (int j = 0; j < 4; ++j) { const f32x4 x = xr[64 * j], g = gr[64 * j]; xn[j] = x + z[j] * rstd * g; s2 += (xn[j].x * xn[j].x + xn[j].y * xn[j].y) + (xn[j].z * xn[j].z + xn[j].w * xn[j].w); }
    f32x4* o = (f32x4*)orow + lane;
#pragma unroll
    for (int j = 0; j < 4; ++j) o[64 * j] = xn[j];
    if (xbrow) {
        const float r2 = 1.f / sqrtf(wave_sum(s2) * (1.f / DM) + EPS);
        v2u* o8 = (v2u*)xbrow + lane;
#pragma unroll
        for (int j = 0; j < 4; ++j) { v2u w; w.x = pk2(xn[j].x * r2, xn[j].y * r2); w.y = pk2(xn[j].z * r2, xn[j].w * r2); o8[64 * j] = w; }
        if (h0row) {
#pragma unroll
            for (int j = 0; j < 4; ++j) *((f32x4*)h0row + lane + 64 * j) = xn[j] * r2 * *((const f32x4*)pgn + lane + 64 * j); }
    }
}
__device__ __forceinline__ void post_row(const float* xres, const bf16* zrow, const float* r0z  , const float* pg, float* orow, bf16* xbrow, int lane, float* h0row, const float* pgn) {
    f32x4 z[4];
    if (r0z) {
#pragma unroll
        for (int j = 0; j < 4; ++j) { f32x4 a = (f32x4){0.f, 0.f, 0.f, 0.f};
#pragma unroll
            for (int kc = 0; kc < R0_KCZ; ++kc) a += *((const f32x4*)(r0z + (size_t)kc * 8 * DM) + lane + 64 * j);
            z[j] = a; }
    } else {
        const v2u* zr = (const v2u*)zrow + lane;
#pragma unroll
        for (int j = 0; j < 4; ++j) { const v2u w = zr[64 * j]; z[j] = (f32x4){bf2f((unsigned short)(w.x & 0xffff)), bf2f((unsigned short)(w.x >> 16)), bf2f((unsigned short)(w.y & 0xffff)), bf2f((unsigned short)(w.y >> 16))}; }
    }
    post_row_z(xres, z, pg, orow, xbrow, lane, h0row, pgn);
}

__device__ __forceinline__ float rdl(float v, int l) { return __int_as_float(__builtin_amdgcn_readlane(__float_as_int(v), l)); }
template <int NB  >
__device__ __forceinline__ void r0_dot_task(const float* h, const float* W, int N, float* part, int task, int nchunks, int lane) {
    const int ch = task % nchunks, kc = task / nchunks, n0 = ch * 64;
    float acc[8];
#pragma unroll
    for (int b = 0; b < 8; ++b) acc[b] = 0.f;
#pragma unroll 1
    for (int sb = 0; sb < NB; ++sb) { const int k0 = (kc * NB + sb) * 32;
        float hv[4], w[32];
#pragma unroll
        for (int i = 0; i < 4; ++i) { const int idx = lane + 64 * i; hv[i] = h[(idx >> 5) * DM + k0 + (idx & 31)]; }
#pragma unroll
        for (int kk = 0; kk < 32; ++kk) w[kk] = W[(size_t)(k0 + kk) * N + n0 + lane];
#pragma unroll
        for (int kk = 0; kk < 32; ++kk)
#pragma unroll
            for (int b = 0; b < 8; ++b) acc[b] += rdl(hv[b >> 1], (b & 1) * 32 + kk) * w[kk]; }
#pragma unroll
    for (int b = 0; b < 8; ++b) part[((size_t)kc * 8 + b) * N + n0 + lane] = acc[b];
}
using pg8::silu_f;
__device__ __forceinline__ void r0_mix(const float* ppart, float* y0, int b, const float* sgu_g, const float* sgu_w, const float* sgu_b, const float* ret_g, LAS float* P, int tid) {
#pragma unroll 2
    for (int n = tid; n < NIN; n += 512) { float a = 0.f;
#pragma unroll
        for (int kc = 0; kc < R0_KC; ++kc) a += ppart[((size_t)kc * 8 + b) * NIN + n];
        P[n] = a; }
    __syncthreads();
    if (tid < 64) { const int lane = tid;
        float sm = 0.f;
#pragma unroll
        for (int i = 0; i < 4; ++i) sm += P[C_BV + lane + 64 * i];
        const float mean = wave_sum(sm) * (1.f / 256.f); float sq = 0.f;
#pragma unroll
        for (int i = 0; i < 4; ++i) { const float d = P[C_BV + lane + 64 * i] - mean; sq += d * d; }
        const float rstd = 1.f / sqrtf(wave_sum(sq) * (1.f / 256.f) + EPS);
#pragma unroll 1
        for (int i = 0; i < 4; ++i) { const int c = lane + 64 * i;
            y0[b * DM + c] = P[C_AV + c] * silu_f(P[C_AG + c]);
            const float mixed = sgu_w[(size_t)i * 16384] * ((P[C_BV + c] - mean) * rstd * sgu_g[c]) + sgu_b[i * 128];
            y0[b * DM + 256 + c] = P[C_BU + c] * mixed * silu_f(P[C_BG + c]);
            y0[b * DM + 512 + c] = 0.f;
            const float cc = wave_sum(P[C_DQ + c] * P[C_DK + c]) * 0.125f; const float of = cc * P[C_DV + c];
            const float mu = wave_sum(of) * (1.f / 64.f); const float d0 = of - mu; const float var = wave_sum(d0 * d0) * (1.f / 64.f);
            y0[b * DM + 768 + c] = d0 / sqrtf(var + EPS) * ret_g[c] * silu_f(P[C_DG + c]); } }
    __syncthreads();
}

__device__ __forceinline__ void na_attn(const bf16* proj, bf16* y, int gw, int NGW, int lane) {
    for (int task = gw; task < M * 4; task += NGW) {
        const int m = task >> 2, h = task & 3, t = m & (SEQ - 1);
        const float q = bf2f(proj[(size_t)m * NIN + C_AQ + h * 64 + lane]);
        const float slope2 = exp2f(-2.0f * (h + 1)) * LOG2E;
        float mr = -INFINITY, l = 0.f, o = 0.f;
        for (int g = 0; g < 3; ++g) { const int dil = 1 << (2 * g);
            for (int j = 0; j <= 128; ++j) { const int tk = t - j * dil; if (tk < 0) break;
                const size_t row = (size_t)(m - j * dil) * NIN;
                const float kd = bf2f(proj[row + C_AK + h * 64 + lane]), vd = bf2f(proj[row + C_AV + h * 64 + lane]);
                const float s = wave_sum(q * kd) - slope2 * (float)(j * dil);
                const float mn = fmaxf(mr, s), corr = exp2f(mr - mn), pp = exp2f(s - mn);
                l = l * corr + pp; o = o * corr + pp * vd; mr = mn; } }
        const float gate = bf2f(proj[(size_t)m * NIN + C_AG + h * 64 + lane]);
        y[(size_t)m * DM + h * 64 + lane] = (bf16)f2bf(o / l * gate);
    }
}
__device__ __forceinline__ void na_sgu(const bf16* proj, bf16* y, const float* sgu_g, const float* sgu_w, const float* sgu_b, int gw, int NGW, int lane) {
    for (int m = gw; m < M; m += NGW) {
        const int t = m & 127; const size_t base = (size_t)(m - t);
        float acc[4] = {0.f, 0.f, 0.f, 0.f}; float gg[4];
#pragma unroll
        for (int i = 0; i < 4; ++i) gg[i] = sgu_g[lane + 64 * i];
        for (int s = 0; s <= t; ++s) { float v[4]; float sm = 0.f;
#pragma unroll
            for (int i = 0; i < 4; ++i) { v[i] = bf2f(proj[(base + s) * NIN + C_BV + lane + 64 * i]); sm += v[i]; }
            const float mean = wave_sum(sm) * (1.f / 256.f); float sq = 0.f;
#pragma unroll
            for (int i = 0; i < 4; ++i) { v[i] -= mean; sq += v[i] * v[i]; }
            const float rstd = 1.f / sqrtf(wave_sum(sq) * (1.f / 256.f) + EPS);
#pragma unroll
            for (int i = 0; i < 4; ++i) acc[i] += sgu_w[(size_t)i * 16384 + t * 128 + s] * (v[i] * rstd * gg[i]); }
#pragma unroll
        for (int i = 0; i < 4; ++i) { const float mixed = acc[i] + sgu_b[i * 128 + t];
            const float u = bf2f(proj[(size_t)m * NIN + C_BU + lane + 64 * i]), gate = bf2f(proj[(size_t)m * NIN + C_BG + lane + 64 * i]);
            y[(size_t)m * DM + 256 + lane + 64 * i] = (bf16)f2bf(u * mixed * gate); }
    }
}
__device__ __forceinline__ void na_pool(const bf16* proj, bf16* y, const float* pool_w, const float* pool_scale, int gw, int NGW, int lane) {
    for (int task = gw; task < M * 4; task += NGW) {
        const int m = task >> 2, g = task & 3, t = m & (SEQ - 1), p = 2 << g;
        const int cnt = (t + 1 < p) ? (t + 1) : p; float sum = 0.f;
        for (int j = 0; j < cnt; ++j) sum += bf2f(proj[(size_t)(m - j) * NIN + C_CX + g * 64 + lane]);
        const float pooled = sum / (float)cnt - bf2f(proj[(size_t)m * NIN + C_CX + g * 64 + lane]);
        float o = 0.f;
        for (int c = 0; c < 64; ++c) o += __shfl(pooled, c) * pool_w[(size_t)g * 4096 + c * 64 + lane];
        const float gate = bf2f(proj[(size_t)m * NIN + C_CG + g * 64 + lane]);
        y[(size_t)m * DM + 512 + g * 64 + lane] = (bf16)f2bf(o * pool_scale[g * 64 + lane] * gate);
    }
}
__device__ __forceinline__ void na_ret(const bf16* proj, bf16* y, const float* ret_g, LAS float* part, int bh, int tid) {
    const int b = bh >> 2, h = bh & 3, e = tid & 63, dg = tid >> 6;
    const float g = 1.0f - exp2f(-5.0f - (float)h);
    float S[8];
#pragma unroll
    for (int i = 0; i < 8; ++i) S[i] = 0.f;
    const float rg = ret_g[h * 64 + e];
    for (int t0 = 0; t0 < SEQ; t0 += 8) {
        for (int tt = 0; tt < 8; ++tt) { const size_t row = ((size_t)b * SEQ + t0 + tt) * NIN;
            const float ve = bf2f(proj[row + C_DV + h * 64 + e]); float pr = 0.f;
#pragma unroll
            for (int i = 0; i < 8; ++i) { const float kd = bf2f(proj[row + C_DK + h * 64 + dg * 8 + i]), qd = bf2f(proj[row + C_DQ + h * 64 + dg * 8 + i]);
                S[i] = g * S[i] + kd * ve; pr += qd * S[i]; }
            part[(tt * 8 + dg) * 64 + e] = pr; }
        __syncthreads();
        { const int tt = dg; float o = 0.f;
#pragma unroll
          for (int d8 = 0; d8 < 8; ++d8) o += part[(tt * 8 + d8) * 64 + e];
          const float mean = wave_sum(o) * (1.f / 64.f); const float dv = o - mean; const float var = wave_sum(dv * dv) * (1.f / 64.f);
          const float on = dv / sqrtf(var + EPS) * rg;
          const size_t m = (size_t)b * SEQ + t0 + tt;
          const float gate = bf2f(proj[m * NIN + C_DG + h * 64 + e]);
          y[m * DM + 768 + h * 64 + e] = (bf16)f2bf(on * gate); }
        __syncthreads();
    }
}

#define XB_TMO      128
#define XB_XCNT(j)  (256  + 64 * (j))
#define XB_XSUB(j)  (1280 + 64 * (j))
#define XB_XGEN(j)  (2304 + 64 * (j))
#define XB_TOP      3328
#define XB_TOPGEN   3392
#define XCD_BAR_WORDS 3456
#define XB_SPIN_CAP (1u << 18)

__device__ __forceinline__ unsigned xb_ld(unsigned* p)              { return __hip_atomic_load(p, __ATOMIC_RELAXED, __HIP_MEMORY_SCOPE_AGENT); }
__device__ __forceinline__ unsigned xb_add(unsigned* p, unsigned v) { return __hip_atomic_fetch_add(p, v, __ATOMIC_RELAXED, __HIP_MEMORY_SCOPE_AGENT); }
__device__ __forceinline__ unsigned xb_xcc_id() { return (unsigned)__builtin_amdgcn_s_getreg((3 << 11) | 20) & 0xFu; }
#define XB_SPIN(cond, bar) do { unsigned _sp = 0; while (cond) { __builtin_amdgcn_s_sleep(1); \
    if ((++_sp & 255u) == 0u) { if (xb_ld(&(bar)[XB_TMO])) break; if (_sp > XB_SPIN_CAP) { atomicAdd(&(bar)[XB_TMO], 1u); break; } } } } while (0)

struct XcdBarrier {
    unsigned* bar; unsigned x;
    volatile LAS unsigned* st;
};

__device__ __forceinline__ XcdBarrier xcd_barrier_post(unsigned* bar, volatile LAS unsigned* st) {
    XcdBarrier b; b.bar = bar; b.x = xb_xcc_id(); b.st = st;
    if (threadIdx.x == 0) (void)xb_add(&bar[XB_XCNT(b.x)], 1u);
    return b;
}
__device__ __forceinline__ void xcd_barrier_complete(unsigned* bar, unsigned x, unsigned& nloc, unsigned& nx) {
    const unsigned G = gridDim.x * gridDim.y * gridDim.z;
    unsigned sum, cnt, mine, sp = 0u;
    for (;;) {
        sum = 0u; cnt = 0u; mine = 0u;
#pragma unroll
        for (unsigned j = 0; j < 16; ++j) { const unsigned c = xb_ld(&bar[XB_XCNT(j)]); sum += c; cnt += (c > 0u) ? 1u : 0u; mine = (j == x) ? c : mine; }
        if (sum == G) break;
        __builtin_amdgcn_s_sleep(1);
        if ((++sp & 255u) == 0u) { if (xb_ld(&bar[XB_TMO])) break; if (sp > XB_SPIN_CAP) { atomicAdd(&bar[XB_TMO], 1u); break; } }
    }
    nloc = mine > 0u ? mine : 1u; nx = cnt > 0u ? cnt : 1u;
}

__device__ __forceinline__ void xcd_barrier(const XcdBarrier& b) {
    asm volatile("s_waitcnt vmcnt(0)" ::: "memory");
    __syncthreads();
    if (threadIdx.x == 0) {
        unsigned* bar = b.bar;
        __builtin_amdgcn_s_waitcnt(0);
        unsigned nloc = b.st[0], nx = b.st[1];
        if (nloc == 0u) { xcd_barrier_complete(bar, b.x, nloc, nx); b.st[0] = nloc; b.st[1] = nx; }
        const unsigned old = xb_add(&bar[XB_XSUB(b.x)], 1u);
        const unsigned gen = old / nloc;
        if (old + 1u == (gen + 1u) * nloc) {
            __builtin_amdgcn_fence(__ATOMIC_RELEASE, "agent");
            asm volatile("s_waitcnt vmcnt(0)" ::: "memory");
            const unsigned og = xb_add(&bar[XB_TOP], 1u);
            const unsigned tg = og / nx;
            if (og + 1u == (tg + 1u) * nx) xb_add(&bar[XB_TOPGEN], 1u);
            else XB_SPIN(xb_ld(&bar[XB_TOPGEN]) == tg, bar);
            __builtin_amdgcn_fence(__ATOMIC_ACQUIRE, "agent");
            xb_add(&bar[XB_XGEN(b.x)], 1u);
            asm volatile("s_waitcnt vmcnt(0)" ::: "memory");
        } else {
            XB_SPIN(xb_ld(&bar[XB_XGEN(b.x)]) == gen, bar);
            __builtin_amdgcn_fence(__ATOMIC_ACQUIRE, "agent");
            asm volatile("s_waitcnt vmcnt(0)" ::: "memory");
        }
    }
    __syncthreads();
}


typedef short bf16x8 __attribute__((ext_vector_type(8)));
typedef float f32x16 __attribute__((ext_vector_type(16)));
typedef float f32x2 __attribute__((ext_vector_type(2)));
typedef __bf16 bf16x2_t __attribute__((ext_vector_type(2)));
__device__ __forceinline__ unsigned cvtpk(float lo, float hi) { f32x2 v = {lo, hi}; return __builtin_bit_cast(unsigned, __builtin_convertvector(v, bf16x2_t)); }
#define MFMA32(a, b, c) __builtin_amdgcn_mfma_f32_32x32x16_bf16((a), (b), (c), 0, 0, 0)
#define PACK8(x, s) __builtin_bit_cast(bf16x8, (v4u){cvtpk((x)[8 * (s)], (x)[8 * (s) + 1]), cvtpk((x)[8 * (s) + 2], (x)[8 * (s) + 3]), cvtpk((x)[8 * (s) + 4], (x)[8 * (s) + 5]), cvtpk((x)[8 * (s) + 6], (x)[8 * (s) + 7])})
__device__ __forceinline__ int crow(int reg, int h) { return (reg & 3) + 8 * (reg >> 2) + 4 * h; }
__device__ __forceinline__ int keyperm(int k) { return (k & ~12) | ((k & 4) << 1) | ((k & 8) >> 1); }
constexpr int KP = 144;
__device__ __forceinline__ int vt_off(int d, int kp, int VP) { return d * VP + ((((kp >> 3) ^ ((d >> 3) & 7))) << 4) + ((kp & 7) << 1); }
__device__ __forceinline__ void vt_write8(LAS unsigned char* Vt, int VP, int c  , int kp, v4u v) {
    LAS unsigned char* base = Vt + (((kp >> 3) ^ c) << 4) + ((kp & 7) << 1) + (8 * c) * VP;
    *(LAS unsigned short*)(base + 0 * VP) = (unsigned short)(v.x & 0xffff); *(LAS unsigned short*)(base + 1 * VP) = (unsigned short)(v.x >> 16);
    *(LAS unsigned short*)(base + 2 * VP) = (unsigned short)(v.y & 0xffff); *(LAS unsigned short*)(base + 3 * VP) = (unsigned short)(v.y >> 16);
    *(LAS unsigned short*)(base + 4 * VP) = (unsigned short)(v.z & 0xffff); *(LAS unsigned short*)(base + 5 * VP) = (unsigned short)(v.z >> 16);
    *(LAS unsigned short*)(base + 6 * VP) = (unsigned short)(v.w & 0xffff); *(LAS unsigned short*)(base + 7 * VP) = (unsigned short)(v.w >> 16);
}

__device__ __forceinline__ void attn_unit(const bf16* proj, bf16* og, float* lse, int u, LAS unsigned char* L, int tid) {
    const int lane = tid & 63, wave = tid >> 6;
    const int w16 = u & 15; int t = u >> 4; const int g = t % 3; t /= 3; const int h = t & 3, b = t >> 2;
    const int dil = 1 << (2 * g), res = w16 & (dil - 1), qb = w16 >> (2 * g), Q0 = qb * 256;
    constexpr int VP = 784;
    LAS unsigned char* Kimg = L; LAS unsigned char* Vt = L + 384 * KP;
    const size_t rowbase = (size_t)b * SEQ;
#pragma unroll
    for (int it = 0; it < 6; ++it) { const int idx = tid + it * 512; const int key = idx >> 3, c = idx & 7, i = Q0 - 128 + key;
        if (i >= 0) { const bf16* src = proj + (rowbase + (size_t)i * dil + res) * NIN + h * 64 + c * 8;
            const v4u kv = *(const v4u*)(src + C_AK), vv = *(const v4u*)(src + C_AV);
            *(LAS v4u*)(Kimg + key * KP + c * 16) = kv;
            vt_write8(Vt, VP, c, keyperm(key), vv); } }
    __syncthreads();
    {
        const int r = lane & 31, hh = lane >> 5, wave_u = __builtin_amdgcn_readfirstlane(tid >> 6);
        const size_t qrow = rowbase + (size_t)(Q0 + 32 * wave + r) * dil + res;
        bf16x8 qf[4];
#pragma unroll
        for (int s = 0; s < 4; ++s) qf[s] = *(const bf16x8*)(proj + qrow * NIN + C_AQ + h * 64 + 16 * s + 8 * hh);
        const float slope2 = exp2f(-2.0f * (float)(h + 1)) * LOG2E * (float)dil;
        const int jt0 = (Q0 == 0 && wave_u < 4) ? 4 - wave_u : 0;
        float mx = -INFINITY, l = 0.f;
        f32x16 O[2];
#pragma unroll
        for (int i = 0; i < 16; ++i) { O[0][i] = 0.f; O[1][i] = 0.f; }
        const LAS unsigned char* kb = Kimg + (32 * wave + r) * KP + 16 * hh;
#pragma unroll 1
        for (int jt = jt0; jt < 5; ++jt) {
            f32x16 acc;
#pragma unroll
            for (int i = 0; i < 16; ++i) acc[i] = 0.f;
#pragma unroll
            for (int s = 0; s < 4; ++s) { const bf16x8 kf = *(const LAS bf16x8*)(kb + jt * (32 * KP) + 32 * s); acc = MFMA32(kf, qf[s], acc); }
            const float bq = slope2 * (float)(128 + r - 32 * jt); float tmax = -INFINITY;
#pragma unroll
            for (int i = 0; i < 16; ++i) { const int kk = crow(i, hh); float v = acc[i] - bq + slope2 * (float)kk;
                if (jt == 0 && kk < r) v = -INFINITY; if (jt == 4 && kk > r) v = -INFINITY; acc[i] = v; tmax = fmaxf(tmax, v); }
            tmax = fmaxf(tmax, __shfl_xor(tmax, 32));
            const float mn = fmaxf(mx, tmax), corr = __builtin_amdgcn_exp2f(mx - mn);
            l *= corr;
#pragma unroll
            for (int i = 0; i < 16; ++i) { O[0][i] *= corr; O[1][i] *= corr; }
#pragma unroll
            for (int i = 0; i < 16; ++i) { const float pv = __builtin_amdgcn_exp2f(acc[i] - mn); acc[i] = pv; l += pv; }
            mx = mn;
            const int T = wave + jt;
#pragma unroll
            for (int s = 0; s < 2; ++s) { const bf16x8 pf = PACK8(acc, s);
#pragma unroll
                for (int dt = 0; dt < 2; ++dt) { const int d = 32 * dt + r, G = 4 * T + 2 * s + hh;
                    const bf16x8 vf = *(const LAS bf16x8*)(Vt + d * VP + ((G ^ ((d >> 3) & 7)) << 4)); O[dt] = MFMA32(vf, pf, O[dt]); } }
        }
        l += __shfl_xor(l, 32);
        const float inv = 1.0f / l;
        bf16* orow = og + ((size_t)g * M + qrow) * 256 + h * 64;
#pragma unroll
        for (int dt = 0; dt < 2; ++dt)
#pragma unroll
            for (int i4 = 0; i4 < 4; ++i4) { v2u w; w.x = cvtpk(O[dt][4 * i4] * inv, O[dt][4 * i4 + 1] * inv); w.y = cvtpk(O[dt][4 * i4 + 2] * inv, O[dt][4 * i4 + 3] * inv);
                *(v2u*)(orow + 32 * dt + 8 * i4 + 4 * hh) = w; }
        if (hh == 0) lse[((size_t)g * M + qrow) * 4 + h] = mx + __builtin_amdgcn_logf(l);
    }
    __syncthreads();
}
__device__ __forceinline__ void attn_combine(const bf16* proj, const bf16* og, const float* lse, bf16* y, int gtid, int gthreads) {
    for (int idx = gtid; idx < M * 32; idx += gthreads) { const int row = idx >> 5, hc = idx & 31, h = hc >> 3, c = hc & 7;
        const float l0 = lse[(size_t)row * 4 + h], l1 = lse[((size_t)M + row) * 4 + h], l2 = lse[((size_t)2 * M + row) * 4 + h];
        const float mx = fmaxf(l0, fmaxf(l1, l2)); float w0 = __builtin_amdgcn_exp2f(l0 - mx), w1 = __builtin_amdgcn_exp2f(l1 - mx), w2 = __builtin_amdgcn_exp2f(l2 - mx);
        const float inv = 1.0f / (w0 + w1 + w2); w0 *= inv; w1 *= inv; w2 *= inv;
        const size_t off = (size_t)row * 256 + h * 64 + c * 8;
        const v4u a0 = *(const v4u*)(og + off), a1 = *(const v4u*)(og + (size_t)M * 256 + off), a2 = *(const v4u*)(og + (size_t)2 * M * 256 + off);
        const v4u gt = *(const v4u*)(proj + (size_t)row * NIN + C_AG + h * 64 + c * 8);
        v4u o;
#define CMB(f) { const float e0 = (w0 * bf2f((unsigned short)(a0.f & 0xffff)) + w1 * bf2f((unsigned short)(a1.f & 0xffff)) + w2 * bf2f((unsigned short)(a2.f & 0xffff))) * bf2f((unsigned short)(gt.f & 0xffff)); \
                 const float e1 = (w0 * bf2f((unsigned short)(a0.f >> 16)) + w1 * bf2f((unsigned short)(a1.f >> 16)) + w2 * bf2f((unsigned short)(a2.f >> 16))) * bf2f((unsigned short)(gt.f >> 16)); o.f = cvtpk(e0, e1); }
        CMB(x) CMB(y) CMB(z) CMB(w)
#undef CMB
        *(v4u*)(y + (size_t)row * DM + h * 64 + c * 8) = o; }
}

__device__ __forceinline__ void retkv_pair(const bf16* proj, float* kvT, int pair, LAS unsigned char* L, int tid) {
    const int half = tid >> 8, t256 = tid & 255, lane = tid & 63, w4 = (tid >> 6) & 3;
    const int uu = pair * 2 + half, n = uu & 31, h = (uu >> 5) & 3, b = uu >> 7;
    constexpr int VP = 272;
    LAS unsigned char* Vt = L + half * (2 * 64 * VP); LAS unsigned char* Kz = Vt + 64 * VP;
    const float lg2 = __builtin_amdgcn_logf(1.0f - exp2f(-5.0f - (float)h));
    const size_t row0 = (size_t)b * SEQ + n * 128;
#pragma unroll
    for (int it = 0; it < 4; ++it) { const int idx = t256 + it * 256, j = idx >> 3, c = idx & 7;
        const bf16* src = proj + (row0 + j) * NIN + h * 64 + c * 8;
        const v4u kv = *(const v4u*)(src + C_DK), vv = *(const v4u*)(src + C_DV);
        const float z = __builtin_amdgcn_exp2f(lg2 * (float)(127 - j));
        v4u kz; kz.x = cvtpk(bf2f((unsigned short)(kv.x & 0xffff)) * z, bf2f((unsigned short)(kv.x >> 16)) * z); kz.y = cvtpk(bf2f((unsigned short)(kv.y & 0xffff)) * z, bf2f((unsigned short)(kv.y >> 16)) * z);
        kz.z = cvtpk(bf2f((unsigned short)(kv.z & 0xffff)) * z, bf2f((unsigned short)(kv.z >> 16)) * z); kz.w = cvtpk(bf2f((unsigned short)(kv.w & 0xffff)) * z, bf2f((unsigned short)(kv.w >> 16)) * z);
        vt_write8(Kz, VP, c, j, kz); vt_write8(Vt, VP, c, j, vv); }
    __syncthreads();
    { const int r = lane & 31, hh = lane >> 5, et = w4 >> 1, dt = w4 & 1;
      f32x16 acc;
#pragma unroll
      for (int i = 0; i < 16; ++i) acc[i] = 0.f;
      const int e = 32 * et + r, d = 32 * dt + r;
#pragma unroll
      for (int ks = 0; ks < 8; ++ks) { const int G = 2 * ks + hh;
          const bf16x8 af = *(const LAS bf16x8*)(Vt + e * VP + ((G ^ ((e >> 3) & 7)) << 4));
          const bf16x8 bfr = *(const LAS bf16x8*)(Kz + d * VP + ((G ^ ((d >> 3) & 7)) << 4));
          acc = MFMA32(af, bfr, acc); }
      float* o = kvT + (size_t)uu * 4096;
#pragma unroll
      for (int i = 0; i < 16; ++i) o[(32 * et + crow(i, hh)) * 64 + d] = acc[i]; }
    __syncthreads();
}
__device__ __forceinline__ void ret_pair(const bf16* proj, const float* kvT, const float* ret_g, bf16* y, int pair, LAS unsigned char* L, int tid) {
    const int half = tid >> 8, t256 = tid & 255, lane = tid & 63, w4 = (tid >> 6) & 3, w4u = __builtin_amdgcn_readfirstlane((tid >> 6) & 3);
    const int uu = pair * 2 + half, n = uu & 31, h = (uu >> 5) & 3, b = uu >> 7;
    constexpr int VP = 272;
    LAS unsigned char* Kimg = L + half * 45056; LAS unsigned char* Vt = Kimg + 128 * KP; LAS unsigned char* Pv = Vt + 64 * VP;
    const float lg2 = __builtin_amdgcn_logf(1.0f - exp2f(-5.0f - (float)h));
    const size_t row0 = (size_t)b * SEQ + n * 128;
#pragma unroll
    for (int it = 0; it < 4; ++it) { const int idx = t256 + it * 256, j = idx >> 3, c = idx & 7;
        const bf16* src = proj + (row0 + j) * NIN + h * 64 + c * 8;
        const v4u kv = *(const v4u*)(src + C_DK), vv = *(const v4u*)(src + C_DV);
        *(LAS v4u*)(Kimg + j * KP + c * 16) = kv;
        vt_write8(Vt, VP, c, keyperm(j), vv); }
    {
      const int e = t256 >> 2, d0 = (t256 & 3) * 16; const float cd = __builtin_amdgcn_exp2f(lg2 * 128.0f);
      f32x4 a0 = (f32x4){0.f, 0.f, 0.f, 0.f}, a1 = a0, a2 = a0, a3 = a0;
      const float* kp = kvT + (size_t)(uu - n) * 4096 + e * 64 + d0;
#pragma unroll 2
      for (int m = 0; m < n; ++m) { const f32x4* q4 = (const f32x4*)(kp + (size_t)m * 4096);
          a0 = a0 * cd + q4[0]; a1 = a1 * cd + q4[1]; a2 = a2 * cd + q4[2]; a3 = a3 * cd + q4[3]; }
      v4u w0, w1; w0.x = cvtpk(a0.x, a0.y); w0.y = cvtpk(a0.z, a0.w); w0.z = cvtpk(a1.x, a1.y); w0.w = cvtpk(a1.z, a1.w);
      w1.x = cvtpk(a2.x, a2.y); w1.y = cvtpk(a2.z, a2.w); w1.z = cvtpk(a3.x, a3.y); w1.w = cvtpk(a3.z, a3.w);
      *(LAS v4u*)(Pv + e * KP + d0 * 2) = w0; *(LAS v4u*)(Pv + e * KP + d0 * 2 + 16) = w1; }
    __syncthreads();
    {
        const int r = lane & 31, hh = lane >> 5, il = 32 * w4 + r;
        const size_t qrow = row0 + il;
        bf16x8 qf[4];
#pragma unroll
        for (int s = 0; s < 4; ++s) qf[s] = *(const bf16x8*)(proj + qrow * NIN + C_DQ + h * 64 + 16 * s + 8 * hh);
        f32x16 O[2], C[2];
#pragma unroll
        for (int i = 0; i < 16; ++i) { O[0][i] = 0.f; O[1][i] = 0.f; C[0][i] = 0.f; C[1][i] = 0.f; }
#pragma unroll 1
        for (int T = 0; T <= w4u; ++T) {
            f32x16 acc;
#pragma unroll
            for (int i = 0; i < 16; ++i) acc[i] = 0.f;
#pragma unroll
            for (int s = 0; s < 4; ++s) { const bf16x8 kf = *(const LAS bf16x8*)(Kimg + (32 * T + r) * KP + 32 * s + 16 * hh); acc = MFMA32(kf, qf[s], acc); }
#pragma unroll
            for (int i = 0; i < 16; ++i) { const int diff = il - 32 * T - crow(i, hh); acc[i] = (diff >= 0) ? acc[i] * __builtin_amdgcn_exp2f(lg2 * (float)diff) : 0.f; }
#pragma unroll
            for (int s = 0; s < 2; ++s) { const bf16x8 pf = PACK8(acc, s);
#pragma unroll
                for (int dt = 0; dt < 2; ++dt) { const int d = 32 * dt + r, G = 4 * T + 2 * s + hh;
                    const bf16x8 vf = *(const LAS bf16x8*)(Vt + d * VP + ((G ^ ((d >> 3) & 7)) << 4)); O[dt] = MFMA32(vf, pf, O[dt]); } }
        }
#pragma unroll
        for (int dt = 0; dt < 2; ++dt)
#pragma unroll
            for (int s = 0; s < 4; ++s) { const bf16x8 pf = *(const LAS bf16x8*)(Pv + (32 * dt + r) * KP + 32 * s + 16 * hh); C[dt] = MFMA32(pf, qf[s], C[dt]); }
        const float xi = __builtin_amdgcn_exp2f(lg2 * (float)(il + 1));
        float sm = 0.f;
#pragma unroll
        for (int dt = 0; dt < 2; ++dt)
#pragma unroll
            for (int i = 0; i < 16; ++i) { O[dt][i] += xi * C[dt][i]; sm += O[dt][i]; }
        sm += __shfl_xor(sm, 32); const float mu = sm * (1.f / 64.f); float sq = 0.f;
#pragma unroll
        for (int dt = 0; dt < 2; ++dt)
#pragma unroll
            for (int i = 0; i < 16; ++i) { O[dt][i] -= mu; sq += O[dt][i] * O[dt][i]; }
        sq += __shfl_xor(sq, 32); const float rstd = 1.f / sqrtf(sq * (1.f / 64.f) + EPS);
#pragma unroll
        for (int dt = 0; dt < 2; ++dt)
#pragma unroll
            for (int i4 = 0; i4 < 4; ++i4) { const int e = 32 * dt + 8 * i4 + 4 * hh;
                const f32x4 rg = *(const f32x4*)(ret_g + h * 64 + e); const v2u gt = *(const v2u*)(proj + qrow * NIN + C_DG + h * 64 + e);
                v2u w; w.x = cvtpk(O[dt][4 * i4] * rstd * rg.x * bf2f((unsigned short)(gt.x & 0xffff)), O[dt][4 * i4 + 1] * rstd * rg.y * bf2f((unsigned short)(gt.x >> 16)));
                w.y = cvtpk(O[dt][4 * i4 + 2] * rstd * rg.z * bf2f((unsigned short)(gt.y & 0xffff)), O[dt][4 * i4 + 3] * rstd * rg.w * bf2f((unsigned short)(gt.y >> 16)));
                *(v2u*)(y + qrow * DM + 768 + h * 64 + e) = w; }
    }
    __syncthreads();
}

__device__ __forceinline__ void sgu_unit(const bf16* proj, bf16* y, const float* sgu_g, const bf16* wb  , const float* sgu_b, int u, LAS unsigned char* L, int tid) {
    const int lane = tid & 63, wave = tid >> 6;
    constexpr int VP = 272;
    LAS unsigned char* Vt = L; LAS float* stats = (LAS float*)(L + 256 * VP);
    const size_t row0 = (size_t)u * 128;
#pragma unroll 1
    for (int i = 0; i < 16; ++i) { const int s = wave * 16 + i; const v2u w = *(const v2u*)(proj + (row0 + s) * NIN + C_BV + 4 * lane);
        const float v0 = bf2f((unsigned short)(w.x & 0xffff)), v1 = bf2f((unsigned short)(w.x >> 16)), v2 = bf2f((unsigned short)(w.y & 0xffff)), v3 = bf2f((unsigned short)(w.y >> 16));
        const float mean = wave_sum((v0 + v1) + (v2 + v3)) * (1.f / 256.f); const float d0 = v0 - mean, d1 = v1 - mean, d2 = v2 - mean, d3 = v3 - mean;
        const float rstd = 1.f / sqrtf(wave_sum((d0 * d0 + d1 * d1) + (d2 * d2 + d3 * d3)) * (1.f / 256.f) + EPS);
        if (lane == 0) { stats[2 * s] = mean; stats[2 * s + 1] = rstd; } }
    __syncthreads();
#pragma unroll 2
    for (int it = 0; it < 8; ++it) { const int idx = tid + it * 512, s = idx >> 5, c32 = idx & 31;
        const v4u w = *(const v4u*)(proj + (row0 + s) * NIN + C_BV + 8 * c32);
        const f32x4 g0 = *(const f32x4*)(sgu_g + 8 * c32), g1 = *(const f32x4*)(sgu_g + 8 * c32 + 4);
        const float mean = stats[2 * s], rstd = stats[2 * s + 1];
        v4u o; o.x = cvtpk((bf2f((unsigned short)(w.x & 0xffff)) - mean) * rstd * g0.x, (bf2f((unsigned short)(w.x >> 16)) - mean) * rstd * g0.y);
        o.y = cvtpk((bf2f((unsigned short)(w.y & 0xffff)) - mean) * rstd * g0.z, (bf2f((unsigned short)(w.y >> 16)) - mean) * rstd * g0.w);
        o.z = cvtpk((bf2f((unsigned short)(w.z & 0xffff)) - mean) * rstd * g1.x, (bf2f((unsigned short)(w.z >> 16)) - mean) * rstd * g1.y);
        o.w = cvtpk((bf2f((unsigned short)(w.w & 0xffff)) - mean) * rstd * g1.z, (bf2f((unsigned short)(w.w >> 16)) - mean) * rstd * g1.w);
        vt_write8(Vt + (c32 >> 3) * (64 * VP), VP, c32 & 7, s, o); }
    __syncthreads();
    { const int r = lane & 31, hh = lane >> 5, g = wave >> 1, dt = wave & 1, d = 32 * dt + r;
      const LAS unsigned char* vg = Vt + g * (64 * VP) + d * VP; const int sw = (d >> 3) & 7;
#pragma unroll 1
      for (int tt = 0; tt < 4; ++tt) { f32x16 acc;
#pragma unroll
          for (int i = 0; i < 16; ++i) acc[i] = 0.f;
          const bf16* wrow = wb + ((size_t)g * 128 + 32 * tt + r) * 128 + 8 * hh;
#pragma unroll 2
          for (int ks = 0; ks < 2 * (tt + 1); ++ks) { const bf16x8 af = *(const LAS bf16x8*)(vg + (((2 * ks + hh) ^ sw) << 4)); const bf16x8 bfr = *(const bf16x8*)(wrow + 16 * ks); acc = MFMA32(af, bfr, acc); }
          const int t = 32 * tt + r; const size_t row = row0 + t; const float bias = sgu_b[g * 128 + t];
#pragma unroll
          for (int i4 = 0; i4 < 4; ++i4) { const int d0 = 32 * dt + 8 * i4 + 4 * hh;
              const v2u uu = *(const v2u*)(proj + row * NIN + C_BU + g * 64 + d0), gt = *(const v2u*)(proj + row * NIN + C_BG + g * 64 + d0);
              v2u w; w.x = cvtpk((acc[4 * i4] + bias) * bf2f((unsigned short)(uu.x & 0xffff)) * bf2f((unsigned short)(gt.x & 0xffff)), (acc[4 * i4 + 1] + bias) * bf2f((unsigned short)(uu.x >> 16)) * bf2f((unsigned short)(gt.x >> 16)));
              w.y = cvtpk((acc[4 * i4 + 2] + bias) * bf2f((unsigned short)(uu.y & 0xffff)) * bf2f((unsigned short)(gt.y & 0xffff)), (acc[4 * i4 + 3] + bias) * bf2f((unsigned short)(uu.y >> 16)) * bf2f((unsigned short)(gt.y >> 16)));
              *(v2u*)(y + row * DM + 256 + g * 64 + d0) = w; } } }
    __syncthreads();
}
__device__ __forceinline__ void pool_unit(const bf16* proj, bf16* y, const bf16* pwt  , const float* pool_scale, int u, LAS unsigned char* L, int tid) {
    const int lane = tid & 63, wave = tid >> 6;
    constexpr int AP = 528;
    const size_t row0 = (size_t)u * 128; const int tok0 = (u & 31) * 128;
#pragma unroll 1
    for (int it = 0; it < 8; ++it) { const int idx = tid + it * 512, t = idx >> 5, c32 = idx & 31, g = c32 >> 3, pw = 2 << g;
        const int tok = tok0 + t, cnt = (tok + 1 < pw) ? tok + 1 : pw;
        const bf16* src = proj + (row0 + t) * NIN + C_CX + 8 * c32;
        float s[8];
#pragma unroll
        for (int q = 0; q < 8; ++q) s[q] = 0.f;
        v4u w0 = (v4u){0u, 0u, 0u, 0u};
        for (int j = 0; j < cnt; ++j) { const v4u w = *(const v4u*)(src - (size_t)j * NIN); if (j == 0) w0 = w;
            s[0] += bf2f((unsigned short)(w.x & 0xffff)); s[1] += bf2f((unsigned short)(w.x >> 16)); s[2] += bf2f((unsigned short)(w.y & 0xffff)); s[3] += bf2f((unsigned short)(w.y >> 16));
            s[4] += bf2f((unsigned short)(w.z & 0xffff)); s[5] += bf2f((unsigned short)(w.z >> 16)); s[6] += bf2f((unsigned short)(w.w & 0xffff)); s[7] += bf2f((unsigned short)(w.w >> 16)); }
        const float ic = 1.0f / (float)cnt;
        v4u o; o.x = cvtpk(s[0] * ic - bf2f((unsigned short)(w0.x & 0xffff)), s[1] * ic - bf2f((unsigned short)(w0.x >> 16))); o.y = cvtpk(s[2] * ic - bf2f((unsigned short)(w0.y & 0xffff)), s[3] * ic - bf2f((unsigned short)(w0.y >> 16)));
        o.z = cvtpk(s[4] * ic - bf2f((unsigned short)(w0.z & 0xffff)), s[5] * ic - bf2f((unsigned short)(w0.z >> 16))); o.w = cvtpk(s[6] * ic - bf2f((unsigned short)(w0.w & 0xffff)), s[7] * ic - bf2f((unsigned short)(w0.w >> 16)));
        *(LAS v4u*)(L + t * AP + c32 * 16) = o; }
    __syncthreads();
    { const int r = lane & 31, hh = lane >> 5, g = wave >> 1, dt = wave & 1;
      bf16x8 af[4];
#pragma unroll
      for (int ks = 0; ks < 4; ++ks) af[ks] = *(const bf16x8*)(pwt + ((size_t)g * 64 + 32 * dt + r) * 64 + 16 * ks + 8 * hh);
#pragma unroll 1
      for (int tt = 0; tt < 4; ++tt) { f32x16 acc;
#pragma unroll
          for (int i = 0; i < 16; ++i) acc[i] = 0.f;
#pragma unroll
          for (int ks = 0; ks < 4; ++ks) { const bf16x8 bfr = *(const LAS bf16x8*)(L + (32 * tt + r) * AP + (g * 64 + 16 * ks + 8 * hh) * 2); acc = MFMA32(af[ks], bfr, acc); }
          const size_t row = row0 + 32 * tt + r;
#pragma unroll
          for (int i4 = 0; i4 < 4; ++i4) { const int d0 = 32 * dt + 8 * i4 + 4 * hh;
              const f32x4 sc = *(const f32x4*)(pool_scale + g * 64 + d0); const v2u gt = *(const v2u*)(proj + row * NIN + C_CG + g * 64 + d0);
              v2u w; w.x = cvtpk(acc[4 * i4] * sc.x * bf2f((unsigned short)(gt.x & 0xffff)), acc[4 * i4 + 1] * sc.y * bf2f((unsigned short)(gt.x >> 16)));
              w.y = cvtpk(acc[4 * i4 + 2] * sc.z * bf2f((unsigned short)(gt.y & 0xffff)), acc[4 * i4 + 3] * sc.w * bf2f((unsigned short)(gt.y >> 16)));
              *(v2u*)(y + row * DM + 512 + g * 64 + d0) = w; } } }
    __syncthreads();
}

#define PHASE_IDS() int tid = threadIdx.x; asm volatile("" : "+v"(tid)); const int lane = tid & 63; const int wave = __builtin_amdgcn_readfirstlane(tid >> 6); const int gw = (int)blockIdx.x * 8 + wave; (void)lane; (void)gw
#define PHASE_PTRS() unsigned char* ws = p.ws; asm volatile("" : "+s"(ws)); const float* x = p.in[0]; const float* w_in = p.in[2]; const float* w_out = p.in[9]; \
    const float* PRM = (const float*)(ws + WS_SMALL); bf16* WinT = (bf16*)(ws + WS_WIN); bf16* WoutT = (bf16*)(ws + WS_WOUT); bf16* XB = (bf16*)(ws + WS_XB); bf16* PROJ = (bf16*)(ws + WS_PROJ); \
    bf16* Y = (bf16*)(ws + WS_Y); bf16* Z = (bf16*)(ws + WS_Z); float* KVT = (float*)(ws + WS_KV); bf16* OG = (bf16*)(ws + WS_OG); float* LSE = (float*)(ws + WS_LSE); \
    float* R0P_ = (float*)(ws + WS_R0 + R0_PPART); float* R0Y_ = (float*)(ws + WS_R0 + R0_Y); float* R0Z_ = (float*)(ws + WS_R0 + R0_ZPART); float* R0H_ = (float*)(ws + WS_R0 + R0_H); (void)R0H_; \
    (void)x; (void)w_in; (void)w_out; (void)PRM; (void)WinT; (void)WoutT; (void)XB; (void)PROJ; (void)Y; (void)Z; (void)KVT; (void)OG; (void)LSE; (void)R0P_; (void)R0Y_; (void)R0Z_
__global__ void __launch_bounds__(512, 2) fwd(Params p) {
    extern __shared__ __attribute__((aligned(16))) unsigned char lds[];
    cg::grid_group grid = cg::this_grid();
    LAS unsigned char* L = (LAS unsigned char*)lds;
    const int G = gridDim.x, NGW = G * 8;
    { volatile LAS unsigned* st = (volatile LAS unsigned*)(L + 139264); if (threadIdx.x < 2) st[threadIdx.x] = 0u; }
    __syncthreads();
    const XcdBarrier bar = xcd_barrier_post((unsigned*)(p.ws + WS_CTL), (volatile LAS unsigned*)(L + 139264));
    {
        PHASE_IDS(); PHASE_PTRS();
        { float* prm = (float*)(ws + WS_SMALL);
          for (int i = (int)blockIdx.x * 512 + tid; i < P_END; i += G * 512) { float v;
              if (i < P_SGUG) v = p.in[1][i]; else if (i < P_SGUW) v = p.in[3][i - P_SGUG]; else if (i < P_SGUB) v = p.in[4][i - P_SGUW]; else if (i < P_POOLW) v = p.in[5][i - P_SGUB];
              else if (i < P_POOLS) v = p.in[6][i - P_POOLW]; else if (i < P_RETG) v = p.in[7][i - P_POOLS]; else if (i < P_POSTG) v = p.in[8][i - P_RETG]; else v = p.in[10][i - P_POSTG];
              prm[i] = v; } }
        { bf16* sw = (bf16*)(ws + WS_SGUWB); bf16* pw = (bf16*)(ws + WS_PWT);
          for (int i = (int)blockIdx.x * 512 + tid; i < 2 * 65536; i += G * 512) { const int s = i & 127, t = (i >> 7) & 127; sw[i] = (s <= t) ? (bf16)f2bf(p.in[4][i]) : (bf16)0; }
          for (int i = (int)blockIdx.x * 512 + tid; i < 2 * 16384; i += G * 512) { const int c = i & 63, d = (i >> 6) & 63, lg = i >> 12; pw[i] = (bf16)f2bf(p.in[6][(size_t)lg * 4096 + c * 64 + d]); } }
        LAS float* scr = (LAS float*)(L + wave * 16384);
        constexpr int I_IN = (DM / 64) * (NIN / 32), I_OUT = (DM / 64) * (DM / 32), I_L = I_IN + I_OUT;
        for (int it = gw; it < DEPTH * I_L; it += NGW) { const int l = it / I_L; int r = it % I_L;
            if (r < I_IN) p0_transpose_item(w_in + (size_t)l * DM * NIN, DM, NIN, WinT + (size_t)l * NIN * DM, p.in[1] + l * DM, 1, scr, r, lane);
            else p0_transpose_item(w_out + (size_t)l * DM * DM, DM, DM, WoutT + (size_t)l * DM * DM, nullptr, 0, scr, r - I_IN, lane); }
        for (int i = 0; i < M / NGW; ++i) { const int m = i * NGW + (gw + i * 257) % NGW; const bool r0 = (m & (SEQ - 1)) == 0; rms_row_to_bf16(x + (size_t)m * DM, XB + (size_t)m * DM, lane, r0 ? R0H_ + (size_t)(m >> 12) * DM : nullptr, p.in[1]); }
    }
    grid.sync();
#pragma unroll
    for (int l = 0; l < DEPTH; ++l) {
        { PHASE_PTRS(); pg8::Gemm g{XB, WinT + (size_t)l * NIN * DM, M, NIN, DM}; pg8::StaticOrder S; S.init(M, NIN, G, (int)blockIdx.x);
          pg8::EpiOut E{PROJ, NIN, (1u << 3) | (1u << 6) | (1u << 8) | (1u << 12)};
          pg8::gemm_phase<pg8::EpiOut, pg8::StaticOrder, true, true>((PG8_LAS unsigned char*)L, g, S, E); }
        { PHASE_IDS(); PHASE_PTRS();
          for (int task = gw; task < 52 * R0_KC; task += NGW) r0_dot_task<1>(R0H_, w_in + (size_t)l * DM * NIN, NIN, R0P_, task, 52, lane); }
        xcd_barrier(bar);
        {
            PHASE_IDS(); PHASE_PTRS();
            if ((int)blockIdx.x >= 248) r0_mix(R0P_, R0Y_, (int)blockIdx.x - 248, PRM + P_SGUG + l * 256, PRM + P_SGUW + (size_t)l * 65536, PRM + P_SGUB + l * 512, PRM + P_RETG + l * 256, (LAS float*)L, tid);
            for (int pr = (int)blockIdx.x; pr < 512; pr += G) retkv_pair(PROJ, KVT, pr, L, tid);
            for (int u = (int)blockIdx.x; u < 1536; u += G) attn_unit(PROJ, OG, LSE, u, L, tid);
            for (int u = (int)blockIdx.x; u < 256; u += G) sgu_unit(PROJ, Y, PRM + P_SGUG + l * 256, (const bf16*)(ws + WS_SGUWB) + (size_t)l * 65536, PRM + P_SGUB + l * 512, u, L, tid);
            for (int u = (int)blockIdx.x; u < 256; u += G) pool_unit(PROJ, Y, (const bf16*)(ws + WS_PWT) + (size_t)l * 16384, PRM + P_POOLS + l * 256, u, L, tid);
        }
        xcd_barrier(bar);
        { PHASE_IDS(); PHASE_PTRS(); for (int pr = (int)blockIdx.x; pr < 512; pr += G) ret_pair(PROJ, KVT, PRM + P_RETG + l * 256, Y, pr, L, tid);
          attn_combine(PROJ, OG, LSE, Y, (int)blockIdx.x * 512 + tid, G * 512); }
        xcd_barrier(bar);
        { PHASE_PTRS(); pg8::Gemm g{Y, WoutT + (size_t)l * DM * DM, M, DM, DM}; pg8::StaticOrder S; S.init(M, DM, G, (int)blockIdx.x);
          pg8::EpiOut E{Z, DM, 0u};
          pg8::gemm_phase<pg8::EpiOut, pg8::StaticOrder, true, true>((PG8_LAS unsigned char*)L, g, S, E); }
        { PHASE_IDS(); PHASE_PTRS(); for (int task = gw; task < 16 * R0_KCZ; task += NGW) r0_dot_task<4>(R0Y_, w_out + (size_t)l * DM * DM, DM, R0Z_, task, 16, lane); }
        xcd_barrier(bar);
        { PHASE_IDS(); PHASE_PTRS(); const float* xres = (l == 0) ? x : p.out;
          for (int i = 0; i < M / NGW; ++i) { const int m = i * NGW + (gw + i * 257) % NGW; const bool r0 = (m & (SEQ - 1)) == 0;
              post_row(xres + (size_t)m * DM, Z + (size_t)m * DM, r0 ? R0Z_ + (size_t)(m >> 12) * DM : nullptr, PRM + P_POSTG + l * DM, p.out + (size_t)m * DM, (l + 1 < DEPTH) ? XB + (size_t)m * DM : nullptr, lane,
                       (r0 && l + 1 < DEPTH) ? R0H_ + (size_t)(m >> 12) * DM : nullptr, PRM + P_PREG + (l + 1 < DEPTH ? (l + 1) * DM : 0)); } }
        if (l + 1 < DEPTH) xcd_barrier(bar);
    }
}

extern "C" void kernel_launch(void* const* d_in, const int* in_sizes, int n_in, void* d_out, int out_size, void* d_ws, size_t ws_size, hipStream_t stream) {
    static int grid = 0;
    if (grid == 0) {
        if (n_in != 11 || in_sizes[0] != M * DM || out_size != M * DM || ws_size < WS_END) { fprintf(stderr, "kernel_launch: unexpected shapes (n_in %d, in0 %d, out %d, ws %zu)\n", n_in, n_in > 0 ? in_sizes[0] : -1, out_size, ws_size); grid = -1; return; }
        int dev = 0, cus = 0, per_cu = 0;
        hipGetDevice(&dev); hipDeviceGetAttribute(&cus, hipDeviceAttributeMultiprocessorCount, dev);
        if (hipFuncSetAttribute((const void*)fwd, hipFuncAttributeMaxDynamicSharedMemorySize, LDS_BYTES) != hipSuccess) { fprintf(stderr, "kernel_launch: hipFuncSetAttribute failed\n"); grid = -1; return; }
        if (hipOccupancyMaxActiveBlocksPerMultiprocessor(&per_cu, (const void*)fwd, 512, LDS_BYTES) != hipSuccess || per_cu < 1) { fprintf(stderr, "kernel_launch: occupancy query says %d\n", per_cu); per_cu = 1; }
        (void)hipGetLastError();
        grid = cus * 1;
        fprintf(stderr, "kernel_launch: cus %d per_cu %d grid %d\n", cus, per_cu, grid);
    }
    if (grid < 0) return;
    if (hipMemsetAsync((char*)d_ws + WS_CTL, 0, 65536, stream) != hipSuccess) { fprintf(stderr, "kernel_launch: memset failed\n"); return; }
    Params p{};
    for (int i = 0; i < 11; ++i) p.in[i] = (const float*)d_in[i];
    p.out = (float*)d_out; p.ws = (unsigned char*)d_ws;
    void* args[] = {&p};
    hipError_t e = hipLaunchCooperativeKernel((const void*)fwd, dim3(grid), dim3(512), args, LDS_BYTES, stream);
    if (e != hipSuccess) fprintf(stderr, "kernel_launch: cooperative launch failed: %s (grid %d)\n", hipGetErrorString(e), grid);
}
```

```cpp
#include <hip/hip_runtime.h>
#include <hip/hip_cooperative_groups.h>
#include <cstdio>
#include <cstdint>
namespace cg = cooperative_groups;
namespace pg8 {
#define PG8_LAS __attribute__((address_space(3)))
typedef unsigned short bf16_t;
typedef short bf16x8 __attribute__((ext_vector_type(8)));
typedef float f32x4 __attribute__((ext_vector_type(4)));
typedef unsigned u32x4 __attribute__((ext_vector_type(4)));
constexpr int BM = 256, BK = 64, HALF = 128, HTB = HALF * BK * 2  , STAGE_BYTES = 8 * HTB, NXCD = 8, WGM = 8;

__host__ __device__ __forceinline__ int lds_byte(int r, int c) { const int st = (r >> 4) * 2 + (c >> 5), rr = r & 15, cc = c & 31, ob = rr * 64 + cc * 2; return st * 1024 + (ob ^ (((ob >> 9) & 1) << 5)); }
__host__ __device__ __forceinline__ void stage_rc(int b, int& R, int& C) { const int st = b / 1024, sb = b % 1024, swz = sb ^ (((sb >> 9) & 1) << 5); R = (st >> 1) * 16 + swz / 64; C = (st & 1) * 32 + (swz % 64) / 2; }
__host__ __device__ __forceinline__ int perm32(int rho) { const int n = rho >> 4, i = rho & 15; return 8 * (i >> 2) + 4 * n + (i & 3); }

struct Unit { int pm, pn; };
struct Gemm { const bf16_t* A; const bf16_t* Bt; int M, N, K; };

struct StaticOrder {
    int nM, nN, nwg, G, c;
    __host__ __device__ void init(int M, int N, int G_, int c_) { nM = M / BM; nN = N / BM; nwg = nM * nN; G = G_; c = c_; }
    __host__ __device__ bool next(int i, Unit& u) const {
        const long L = (long)i * G + c; if (L >= nwg) return false;
        int wgid = (int)L; { const int q = nwg / NXCD, r = nwg % NXCD, xcd = wgid % NXCD, off = wgid / NXCD; wgid = (xcd < r ? xcd * (q + 1) : r * (q + 1) + (xcd - r) * q) + off; }
        const int nig = WGM * nN, gid = wgid / nig, fm = gid * WGM, gsz = (nM - fm) < WGM ? (nM - fm) : WGM;
        u.pm = fm + ((wgid % nig) % gsz); u.pn = (wgid % nig) / gsz; return true;
    }
    __device__ __forceinline__ void a_ready(const Unit&) const {}
    __device__ __forceinline__ void done(const Unit&) const {}
};

__device__ __forceinline__ unsigned cvt_pk_bf16(float lo, float hi) { unsigned r; asm volatile("v_cvt_pk_bf16_f32 %0, %1, %2" : "=v"(r) : "v"(lo), "v"(hi)); return r; }
__device__ __forceinline__ float silu_f(float x) { return x / (1.0f + __expf(-x)); }
struct EpiOut {
    static constexpr bool PERM = true, AFTER_DRAIN = false;
    bf16_t* O; int ldc; unsigned gate_mask;
    __device__ __forceinline__ void operator()(const f32x4 (&acc)[2][2][4][2], const Unit& u, int wr, int wc, int fr, int fq) const {
        const int row0 = u.pm * BM + wr * 64 + fr; const int col0 = u.pn * BM + wc * 32 + 8 * fq;
        const bool gate = (gate_mask >> u.pn) & 1u;
#pragma unroll
        for (int ai = 0; ai < 2; ++ai)
#pragma unroll
            for (int m = 0; m < 4; ++m) { bf16_t* rowp = O + (size_t)(row0 + ai * HALF + m * 16) * ldc + col0;
#pragma unroll
                for (int bj = 0; bj < 2; ++bj) { f32x4 v0 = acc[ai][bj][m][0], v1 = acc[ai][bj][m][1];
                    if (gate) { v0 = (f32x4){silu_f(v0[0]), silu_f(v0[1]), silu_f(v0[2]), silu_f(v0[3])}; v1 = (f32x4){silu_f(v1[0]), silu_f(v1[1]), silu_f(v1[2]), silu_f(v1[3])}; }
                    u32x4 w; w.x = cvt_pk_bf16(v0[0], v0[1]); w.y = cvt_pk_bf16(v0[2], v0[3]); w.z = cvt_pk_bf16(v1[0], v1[1]); w.w = cvt_pk_bf16(v1[2], v1[3]);
                    *(u32x4*)(rowp + bj * HALF) = w; } }
    }
};
template <class Epi, class Sched, bool ALIGN_EPI = false, bool SP2 = false>
__device__ __forceinline__ void gemm_phase(PG8_LAS unsigned char* lds, const Gemm g, const Sched& S, const Epi& E) {
    const int tid = threadIdx.x, wid = __builtin_amdgcn_readfirstlane(tid >> 6), lane = tid & 63, wr = wid >> 2, wc = wid & 3, fr = lane & 15, fq = lane >> 4;
    const int K = g.K, nt = K / BK;
    unsigned voffA[2], voffB[2];
#pragma unroll
    for (int i = 0; i < 2; ++i) { int R, C; stage_rc(tid * 16 + i * 8192, R, C); const int Rb = Epi::PERM ? ((R & ~31) + perm32(R & 31)) : R;
        voffA[i] = (unsigned)(R * K + C) * 2u; voffB[i] = (unsigned)(Rb * K + C) * 2u; }
    const size_t kstep = (size_t)(BK * 2);
    const size_t hstep = (size_t)HALF * K * 2;
    const size_t tstep = 2 * hstep;
    const unsigned ldsw = (unsigned)wid * 1024u;
    const int aoff = lds_byte(wr * 64 + fr, fq * 8), boff = lds_byte(wc * 32 + fr, fq * 8);
#define PG8_SA(b, h) (((b) * 2 + (h)) * HTB)
#define PG8_SB(b, h) ((4 + (b) * 2 + (h)) * HTB)
#define PG8_STAGE(bufoff, gbase, voff) do { _Pragma("unroll") for (int _i = 0; _i < 2; ++_i) \
        __builtin_amdgcn_global_load_lds((const unsigned*)((const char*)(gbase) + (voff)[_i]), (PG8_LAS unsigned*)(lds + (bufoff) + ldsw + _i * 8192), 16, 0, 0); } while (0)
#define PG8_LDA(dst, b, h) do { _Pragma("unroll") for (int m = 0; m < 4; ++m) _Pragma("unroll") for (int k = 0; k < 2; ++k) dst[m][k] = *(const PG8_LAS bf16x8*)(lds + PG8_SA(b, h) + aoff + m * 2048 + k * 1024); } while (0)
#define PG8_LDB(dst, b, h) do { _Pragma("unroll") for (int n = 0; n < 2; ++n) _Pragma("unroll") for (int k = 0; k < 2; ++k) dst[n][k] = *(const PG8_LAS bf16x8*)(lds + PG8_SB(b, h) + boff + n * 2048 + k * 1024); } while (0)
#define PG8_MMA(ai, bj, At, Bt) do { __builtin_amdgcn_s_setprio(1); _Pragma("unroll") for (int m = 0; m < 4; ++m) _Pragma("unroll") for (int n = 0; n < 2; ++n) _Pragma("unroll") for (int k = 0; k < 2; ++k) \
        acc[ai][bj][m][n] = __builtin_amdgcn_mfma_f32_16x16x32_bf16(Bt[n][k], At[m][k], acc[ai][bj][m][n], 0, 0, 0); __builtin_amdgcn_s_setprio(0); } while (0)
#define PG8_WAIT_V(n) asm volatile("s_waitcnt vmcnt(" #n ")" ::: "memory")
#define PG8_WAIT_L(n) asm volatile("s_waitcnt lgkmcnt(" #n ")" ::: "memory")
#define PG8_BAR __builtin_amdgcn_s_barrier()
#define PG8_SCHED __builtin_amdgcn_sched_barrier(0)
    Unit cur, nxt; int ui = 0;
    if (!S.next(0, cur)) return;
    f32x4 acc[2][2][4][2];
#pragma unroll
    for (int a = 0; a < 2; ++a)
#pragma unroll
        for (int b = 0; b < 2; ++b)
#pragma unroll
            for (int m = 0; m < 4; ++m)
#pragma unroll
                for (int n = 0; n < 2; ++n) acc[a][b][m][n] = (f32x4){0.f, 0.f, 0.f, 0.f};
    bf16x8 At[4][2], B0[2][2], B1[2][2];
    const char* cA = (const char*)g.A + (size_t)cur.pm * tstep; const char* cB = (const char*)g.Bt + (size_t)cur.pn * tstep;
    S.a_ready(cur);
    if constexpr (SP2) {
        PG8_STAGE(PG8_SB(0, 0), cB, voffB); PG8_STAGE(PG8_SB(0, 1), cB + hstep, voffB); PG8_STAGE(PG8_SA(0, 0), cA, voffA); PG8_STAGE(PG8_SA(0, 1), cA + hstep, voffA);
        if (wr == 1) PG8_BAR;
        PG8_WAIT_V(2); PG8_BAR;
        PG8_STAGE(PG8_SB(1, 0), cB + kstep, voffB); PG8_STAGE(PG8_SA(1, 0), cA + kstep, voffA); PG8_STAGE(PG8_SB(1, 1), cB + hstep + kstep, voffB);
        PG8_WAIT_V(6); PG8_BAR;
    } else {
        PG8_STAGE(PG8_SB(0, 0), cB, voffB); PG8_STAGE(PG8_SA(0, 0), cA, voffA); PG8_STAGE(PG8_SB(0, 1), cB + hstep, voffB); PG8_STAGE(PG8_SA(0, 1), cA + hstep, voffA);
        if (wr == 1) PG8_BAR;
        PG8_WAIT_V(4); PG8_BAR;
        PG8_STAGE(PG8_SB(1, 0), cB + kstep, voffB); PG8_STAGE(PG8_SA(1, 0), cA + kstep, voffA); PG8_STAGE(PG8_SB(1, 1), cB + hstep + kstep, voffB);
        PG8_WAIT_V(6); PG8_BAR;
    }
    for (;;) {
        const bool has_next = S.next(ui + 1, nxt);
        const char* nA = has_next ? (const char*)g.A + (size_t)nxt.pm * tstep : cA; const char* nB = has_next ? (const char*)g.Bt + (size_t)nxt.pn * tstep : cB;
        for (int t = 0; t < nt; t += 2) {
            const bool last = (t == nt - 2);
            const char* a1 = cA + (size_t)(t + 1) * kstep;
            const char* a2 = last ? nA : cA + (size_t)(t + 2) * kstep; const char* b2 = last ? nB : cB + (size_t)(t + 2) * kstep;
            const char* a3 = a2 + kstep; const char* b3 = b2 + kstep;
            if (last && has_next) S.a_ready(nxt);
            if constexpr (SP2) {
            PG8_LDB(B0, 0, 0); PG8_LDB(B1, 0, 1); PG8_SCHED; PG8_LDA(At, 0, 0); PG8_STAGE(PG8_SA(1, 1), a1 + hstep, voffA);
            PG8_WAIT_V(8); PG8_WAIT_L(0); PG8_BAR; PG8_MMA(0, 0, At, B0); PG8_MMA(0, 1, At, B1); PG8_BAR; PG8_SCHED;
            PG8_LDA(At, 0, 1); PG8_STAGE(PG8_SB(0, 0), b2, voffB); PG8_STAGE(PG8_SB(0, 1), b2 + hstep, voffB); PG8_STAGE(PG8_SA(0, 0), a2, voffA);
            PG8_WAIT_V(8); PG8_WAIT_L(0); PG8_BAR; PG8_MMA(1, 0, At, B0); PG8_MMA(1, 1, At, B1); PG8_BAR; PG8_SCHED;
            PG8_LDB(B0, 1, 0); PG8_LDB(B1, 1, 1); PG8_SCHED; PG8_LDA(At, 1, 0); PG8_STAGE(PG8_SA(0, 1), a2 + hstep, voffA);
            PG8_WAIT_V(8); PG8_WAIT_L(0); PG8_BAR; PG8_MMA(0, 0, At, B0); PG8_MMA(0, 1, At, B1); PG8_BAR; PG8_SCHED;
            PG8_LDA(At, 1, 1); PG8_STAGE(PG8_SB(1, 0), b3, voffB); PG8_STAGE(PG8_SB(1, 1), b3 + hstep, voffB); PG8_STAGE(PG8_SA(1, 0), a3, voffA);
            PG8_WAIT_V(8); PG8_WAIT_L(0); PG8_BAR; PG8_MMA(1, 0, At, B0); PG8_MMA(1, 1, At, B1); PG8_BAR; PG8_SCHED;
            } else {
            PG8_LDB(B0, 0, 0); PG8_SCHED; PG8_LDA(At, 0, 0); PG8_STAGE(PG8_SA(1, 1), a1 + hstep, voffA);
            PG8_WAIT_L(8); PG8_BAR; PG8_WAIT_L(0); PG8_MMA(0, 0, At, B0); PG8_BAR; PG8_SCHED;
            PG8_LDB(B1, 0, 1); PG8_STAGE(PG8_SB(0, 0), b2, voffB);
            PG8_BAR; PG8_WAIT_L(0); PG8_MMA(0, 1, At, B1); PG8_BAR;
            PG8_LDA(At, 0, 1); PG8_STAGE(PG8_SA(0, 0), a2, voffA);
            PG8_BAR; PG8_WAIT_L(0); PG8_MMA(1, 0, At, B0); PG8_BAR; PG8_SCHED;
            PG8_STAGE(PG8_SB(0, 1), b2 + hstep, voffB);
            PG8_WAIT_V(6); PG8_BAR; PG8_MMA(1, 1, At, B1); PG8_BAR;
            PG8_LDB(B0, 1, 0); PG8_SCHED; PG8_LDA(At, 1, 0); PG8_STAGE(PG8_SA(0, 1), a2 + hstep, voffA);
            PG8_WAIT_L(8); PG8_BAR; PG8_WAIT_L(0); PG8_MMA(0, 0, At, B0); PG8_BAR; PG8_SCHED;
            PG8_LDB(B1, 1, 1); PG8_STAGE(PG8_SB(1, 0), b3, voffB);
            PG8_BAR; PG8_WAIT_L(0); PG8_MMA(0, 1, At, B1); PG8_BAR;
            PG8_LDA(At, 1, 1); PG8_STAGE(PG8_SA(1, 0), a3, voffA);
            PG8_BAR; PG8_WAIT_L(0); PG8_MMA(1, 0, At, B0); PG8_BAR; PG8_SCHED;
            PG8_STAGE(PG8_SB(1, 1), b3 + hstep, voffB);
            PG8_WAIT_V(6); PG8_BAR; PG8_MMA(1, 1, At, B1); PG8_BAR;
            }
        }
        if constexpr (ALIGN_EPI) { if (wr == 0) PG8_BAR; }
        if constexpr (!Epi::AFTER_DRAIN) { E(acc, cur, wr, wc, fr, fq); S.done(cur); }
        if (!has_next) break;
#pragma unroll
        for (int a = 0; a < 2; ++a)
#pragma unroll
            for (int b = 0; b < 2; ++b)
#pragma unroll
                for (int m = 0; m < 4; ++m)
#pragma unroll
                    for (int n = 0; n < 2; ++n) acc[a][b][m][n] = (f32x4){0.f, 0.f, 0.f, 0.f};
        cur = nxt; cA = nA; cB = nB; ++ui;
        if constexpr (ALIGN_EPI) { if (wr == 1) PG8_BAR; }
    }
    PG8_WAIT_V(0);
    if constexpr (!ALIGN_EPI) { if (wr == 0) PG8_BAR; }
    PG8_BAR;
    if constexpr (Epi::AFTER_DRAIN) { E.fused(acc, cur, wr, wc, fr, fq, lds, wid, lane); S.done(cur); }
#undef PG8_SA
#undef PG8_SB
#undef PG8_STAGE
#undef PG8_LDA
#undef PG8_LDB
#undef PG8_MMA
#undef PG8_WAIT_V
#undef PG8_WAIT_L
#undef PG8_BAR
#undef PG8_SCHED
}
}
#define LAS __attribute__((address_space(3)))
typedef unsigned short bf16;
typedef unsigned v4u __attribute__((ext_vector_type(4)));
typedef unsigned v2u __attribute__((ext_vector_type(2)));
typedef float f32x4 __attribute__((ext_vector_type(4)));
constexpr int SEQ = 4096, BATCH = 8, DM = 1024, M = BATCH * SEQ, NIN = 3328, DEPTH = 2;
constexpr float EPS = 1e-6f;
constexpr float LOG2E = 1.4426950408889634f;
constexpr float QSCALE = 0.125f * LOG2E;
constexpr int C_AQ = 0, C_AK = 256, C_AV = 512, C_AG = 768, C_BU = 1024, C_BV = 1280, C_BG = 1536, C_CX = 1792, C_CG = 2048, C_DQ = 2304, C_DK = 2560, C_DV = 2816, C_DG = 3072;
constexpr size_t MiB = 1u << 20;
constexpr size_t WS_WIN = 0, WS_WOUT = 13 * MiB, WS_SMALL = 17 * MiB, WS_XB = 18 * MiB, WS_PROJ = 82 * MiB, WS_Y = 290 * MiB, WS_Z = 354 * MiB, WS_OG = 418 * MiB, WS_LSE = 466 * MiB, WS_KV = 468 * MiB, WS_R0 = 484 * MiB, WS_CTL = 490 * MiB, WS_PREV = 491 * MiB, WS_END = 499 * MiB;
constexpr size_t R0_PPART = 0, R0_Y = 4 * MiB, R0_H = R0_Y + 65536, R0_ZPART = 5 * MiB;
constexpr int R0_KC = 32, R0_KCZ = 8;
constexpr int LDS_BYTES = 147456;
constexpr size_t WS_SGUWB = WS_SMALL + 704 * 1024, WS_PWT = WS_SMALL + 960 * 1024;
constexpr int P_PREG = 0, P_SGUG = 2048, P_SGUW = 2560, P_SGUB = 133632, P_POOLW = 134656, P_POOLS = 167424, P_RETG = 167936, P_POSTG = 168448, P_END = 170496;

__device__ __forceinline__ float bf2f(unsigned short u) { return __uint_as_float(((unsigned)u) << 16); }
__device__ __forceinline__ unsigned f2bf(float f) { unsigned u = __float_as_uint(f); return (u + 0x7fffu + ((u >> 16) & 1u)) >> 16; }
__device__ __forceinline__ unsigned pk2(float lo, float hi) { return f2bf(lo) | (f2bf(hi) << 16); }
__device__ __forceinline__ float wave_sum(float v) {
#pragma unroll
    for (int o = 1; o < 64; o <<= 1) v += __shfl_xor(v, o);
    return v;
}
#define LDS_WAIT() asm volatile("s_waitcnt lgkmcnt(0)" ::: "memory")

struct Params { const float* in[11]; float* out; unsigned char* ws; };

__device__ __forceinline__ void p0_transpose_item(const float* W, int K, int N, bf16* WT, const float* rs, int col_mode, LAS float* scr, int item, int lane) {
    const int nblk = N / 32, kb = item / nblk, nb = item % nblk, k0 = 64 * kb, n0 = 32 * nb;
    float cs = 1.f;
    if (col_mode) { const int n = n0 + (lane & 31); if (n < 256) cs = QSCALE; else if (n >= C_DK && n < C_DK + 256) cs = 0.125f; }
#pragma unroll 8
    for (int i = 0; i < 32; ++i) { const int kk = 2 * i + (lane >> 5); float v = W[(size_t)(k0 + kk) * N + n0 + (lane & 31)] * cs; if (rs) v *= rs[k0 + kk]; scr[kk * 33 + (lane & 31)] = v; }
    LDS_WAIT(); asm volatile("" ::: "memory");
    const int c = lane & 7;
#pragma unroll
    for (int j = 0; j < 4; ++j) { const int n = (lane >> 3) + 8 * j; const LAS float* s = scr + (8 * c) * 33 + n;
        v4u o; o.x = pk2(s[0 * 33], s[1 * 33]); o.y = pk2(s[2 * 33], s[3 * 33]); o.z = pk2(s[4 * 33], s[5 * 33]); o.w = pk2(s[6 * 33], s[7 * 33]);
        *(v4u*)(WT + (size_t)(n0 + n) * K + k0 + 8 * c) = o; }
    LDS_WAIT(); asm volatile("" ::: "memory");
}

__device__ __forceinline__ void rms_row_to_bf16(const float* xrow, bf16* orow, int lane, float* h0row = nullptr, const float* pgn = nullptr) {
    const f32x4* xr = (const f32x4*)xrow + lane;
    f32x4 v[4]; float s = 0.f;
#pragma unroll
    for (int j = 0; j < 4; ++j) { v[j] = xr[64 * j]; s += (v[j].x * v[j].x + v[j].y * v[j].y) + (v[j].z * v[j].z + v[j].w * v[j].w); }
    const float rstd = 1.f / sqrtf(wave_sum(s) * (1.f / DM) + EPS);
    v2u* o8 = (v2u*)orow + lane;
#pragma unroll
    for (int j = 0; j < 4; ++j) { v2u w; w.x = pk2(v[j].x * rstd, v[j].y * rstd); w.y = pk2(v[j].z * rstd, v[j].w * rstd); o8[64 * j] = w; }
    if (h0row) {
#pragma unroll
        for (int j = 0; j < 4; ++j) *((f32x4*)h0row + lane + 64 * j) = v[j] * rstd * *((const f32x4*)pgn + lane + 64 * j); }
}

__device__ __forceinline__ void post_row_z(const float* xres, const f32x4 (&z)[4], const float* pg, float* orow, bf16* xbrow, int lane, float* h0row, const float* pgn) {
    const f32x4* xr = (const f32x4*)xres + lane; const f32x4* gr = (const f32x4*)pg + lane;
    float s = 0.f;
#pragma unroll
    for (int j = 0; j < 4; ++j) s += (z[j].x * z[j].x + z[j].y * z[j].y) + (z[j].z * z[j].z + z[j].w * z[j].w);
    const float rstd = 1.f / sqrtf(wave_sum(s) * (1.f / DM) + EPS);
    f32x4 xn[4]; float s2 = 0.f;
#pragma unroll
    for (int j = 0; j < 4; ++j) { const f32x4 x = xr[64 * j], g = gr[64 * j]; xn[j] = x + z[j] * rstd * g; s2 += (xn[j].x * xn[j].x + xn[j].y * xn[j].y) + (xn[j].z * xn[j].z + xn[j].w * xn[j].w); }
    f32x4* o = (f32x4*)orow + lane;
#pragma unroll
    for (int j = 0; j < 4; ++j) o[64 * j] = xn[j];
    if (xbrow) {
        const float r2 = 1.f / sqrtf(wave_sum(s2) * (1.f / DM) + EPS);
        v2u* o8 = (v2u*)xbrow + lane;
#pragma unroll
        for (int j = 0; j < 4; ++j) { v2u w; w.x = pk2(xn[j].x * r2, xn[j].y * r2); w.y = pk2(xn[j].z * r2, xn[j].w * r2); o8[64 * j] = w; }
        if (h0row) {
#pragma unroll
            for (int j = 0; j < 4; ++j) *((f32x4*)h0row + lane + 64 * j) = xn[j] * r2 * *((const f32x4*)pgn + lane + 64 * j); }
    }
}
__device__ __forceinline__ void post_row(const float* xres, const bf16* zrow, const float* r0z  , const float* pg, float* orow, bf16* xbrow, int lane, float* h0row, const float* pgn) {
    f32x4 z[4];
    if (r0z) {
#pragma unroll
        for (int j = 0; j < 4; ++j) { f32x4 a = (f32x4){0.f, 0.f, 0.f, 0.f};
#pragma unroll
            for (int kc = 0; kc < R0_KCZ; ++kc) a += *((const f32x4*)(r0z + (size_t)kc * 8 * DM) + lane + 64 * j);
            z[j] = a; }
    } else {
        const v2u* zr = (const v2u*)zrow + lane;
#pragma unroll
        for (int j = 0; j < 4; ++j) { const v2u w = zr[64 * j]; z[j] = (f32x4){bf2f((unsigned short)(w.x & 0xffff)), bf2f((unsigned short)(w.x >> 16)), bf2f((unsigned short)(w.y & 0xffff)), bf2f((unsigned short)(w.y >> 16))}; }
    }
    post_row_z(xres, z, pg, orow, xbrow, lane, h0row, pgn);
}

__device__ __forceinline__ float rdl(float v, int l) { return __int_as_float(__builtin_amdgcn_readlane(__float_as_int(v), l)); }
template <int NB  >
__device__ __forceinline__ void r0_dot_task(const float* h, const float* W, int N, float* part, int task, int nchunks, int lane) {
    const int ch = task % nchunks, kc = task / nchunks, n0 = ch * 64;
    float acc[8];
#pragma unroll
    for (int b = 0; b < 8; ++b) acc[b] = 0.f;
#pragma unroll 1
    for (int sb = 0; sb < NB; ++sb) { const int k0 = (kc * NB + sb) * 32;
        float hv[4], w[32];
#pragma unroll
        for (int i = 0; i < 4; ++i) { const int idx = lane + 64 * i; hv[i] = h[(idx >> 5) * DM + k0 + (idx & 31)]; }
#pragma unroll
        for (int kk = 0; kk < 32; ++kk) w[kk] = W[(size_t)(k0 + kk) * N + n0 + lane];
#pragma unroll
        for (int kk = 0; kk < 32; ++kk)
#pragma unroll
            for (int b = 0; b < 8; ++b) acc[b] += rdl(hv[b >> 1], (b & 1) * 32 + kk) * w[kk]; }
#pragma unroll
    for (int b = 0; b < 8; ++b) part[((size_t)kc * 8 + b) * N + n0 + lane] = acc[b];
}
using pg8::silu_f;
__device__ __forceinline__ void r0_mix(const float* ppart, float* y0, int b, const float* sgu_g, const float* sgu_w, const float* sgu_b, const float* ret_g, LAS float* P, int tid) {
#pragma unroll 2
    for (int n = tid; n < NIN; n += 512) { float a = 0.f;
#pragma unroll
        for (int kc = 0; kc < R0_KC; ++kc) a += ppart[((size_t)kc * 8 + b) * NIN + n];
        P[n] = a; }
    __syncthreads();
    if (tid < 64) { const int lane = tid;
        float sm = 0.f;
#pragma unroll
        for (int i = 0; i < 4; ++i) sm += P[C_BV + lane + 64 * i];
        const float mean = wave_sum(sm) * (1.f / 256.f); float sq = 0.f;
#pragma unroll
        for (int i = 0; i < 4; ++i) { const float d = P[C_BV + lane + 64 * i] - mean; sq += d * d; }
        const float rstd = 1.f / sqrtf(wave_sum(sq) * (1.f / 256.f) + EPS);
#pragma unroll 1
        for (int i = 0; i < 4; ++i) { const int c = lane + 64 * i;
            y0[b * DM + c] = P[C_AV + c] * silu_f(P[C_AG + c]);
            const float mixed = sgu_w[(size_t)i * 16384] * ((P[C_BV + c] - mean) * rstd * sgu_g[c]) + sgu_b[i * 128];
            y0[b * DM + 256 + c] = P[C_BU + c] * mixed * silu_f(P[C_BG + c]);
            y0[b * DM + 512 + c] = 0.f;
            const float cc = wave_sum(P[C_DQ + c] * P[C_DK + c]) * 0.125f; const float of = cc * P[C_DV + c];
            const float mu = wave_sum(of) * (1.f / 64.f); const float d0 = of - mu; const float var = wave_sum(d0 * d0) * (1.f / 64.f);
            y0[b * DM + 768 + c] = d0 / sqrtf(var + EPS) * ret_g[c] * silu_f(P[C_DG + c]); } }
    __syncthreads();
}

__device__ __forceinline__ void na_attn(const bf16* proj, bf16* y, int gw, int NGW, int lane) {
    for (int task = gw; task < M * 4; task += NGW) {
        const int m = task >> 2, h = task & 3, t = m & (SEQ - 1);
        const float q = bf2f(proj[(size_t)m * NIN + C_AQ + h * 64 + lane]);
        const float slope2 = exp2f(-2.0f * (h + 1)) * LOG2E;
        float mr = -INFINITY, l = 0.f, o = 0.f;
        for (int g = 0; g < 3; ++g) { const int dil = 1 << (2 * g);
            for (int j = 0; j <= 128; ++j) { const int tk = t - j * dil; if (tk < 0) break;
                const size_t row = (size_t)(m - j * dil) * NIN;
                const float kd = bf2f(proj[row + C_AK + h * 64 + lane]), vd = bf2f(proj[row + C_AV + h * 64 + lane]);
                const float s = wave_sum(q * kd) - slope2 * (float)(j * dil);
                const float mn = fmaxf(mr, s), corr = exp2f(mr - mn), pp = exp2f(s - mn);
                l = l * corr + pp; o = o * corr + pp * vd; mr = mn; } }
        const float gate = bf2f(proj[(size_t)m * NIN + C_AG + h * 64 + lane]);
        y[(size_t)m * DM + h * 64 + lane] = (bf16)f2bf(o / l * gate);
    }
}
__device__ __forceinline__ void na_sgu(const bf16* proj, bf16* y, const float* sgu_g, const float* sgu_w, const float* sgu_b, int gw, int NGW, int lane) {
    for (int m = gw; m < M; m += NGW) {
        const int t = m & 127; const size_t base = (size_t)(m - t);
        float acc[4] = {0.f, 0.f, 0.f, 0.f}; float gg[4];
#pragma unroll
        for (int i = 0; i < 4; ++i) gg[i] = sgu_g[lane + 64 * i];
        for (int s = 0; s <= t; ++s) { float v[4]; float sm = 0.f;
#pragma unroll
            for (int i = 0; i < 4; ++i) { v[i] = bf2f(proj[(base + s) * NIN + C_BV + lane + 64 * i]); sm += v[i]; }
            const float mean = wave_sum(sm) * (1.f / 256.f); float sq = 0.f;
#pragma unroll
            for (int i = 0; i < 4; ++i) { v[i] -= mean; sq += v[i] * v[i]; }
            const float rstd = 1.f / sqrtf(wave_sum(sq) * (1.f / 256.f) + EPS);
#pragma unroll
            for (int i = 0; i < 4; ++i) acc[i] += sgu_w[(size_t)i * 16384 + t * 128 + s] * (v[i] * rstd * gg[i]); }
#pragma unroll
        for (int i = 0; i < 4; ++i) { const float mixed = acc[i] + sgu_b[i * 128 + t];
            const float u = bf2f(proj[(size_t)m * NIN + C_BU + lane + 64 * i]), gate = bf2f(proj[(size_t)m * NIN + C_BG + lane + 64 * i]);
            y[(size_t)m * DM + 256 + lane + 64 * i] = (bf16)f2bf(u * mixed * gate); }
    }
}
__device__ __forceinline__ void na_pool(const bf16* proj, bf16* y, const float* pool_w, const float* pool_scale, int gw, int NGW, int lane) {
    for (int task = gw; task < M * 4; task += NGW) {
        const int m = task >> 2, g = task & 3, t = m & (SEQ - 1), p = 2 << g;
        const int cnt = (t + 1 < p) ? (t + 1) : p; float sum = 0.f;
        for (int j = 0; j < cnt; ++j) sum += bf2f(proj[(size_t)(m - j) * NIN + C_CX + g * 64 + lane]);
        const float pooled = sum / (float)cnt - bf2f(proj[(size_t)m * NIN + C_CX + g * 64 + lane]);
        float o = 0.f;
        for (int c = 0; c < 64; ++c) o += __shfl(pooled, c) * pool_w[(size_t)g * 4096 + c * 64 + lane];
        const float gate = bf2f(proj[(size_t)m * NIN + C_CG + g * 64 + lane]);
        y[(size_t)m * DM + 512 + g * 64 + lane] = (bf16)f2bf(o * pool_scale[g * 64 + lane] * gate);
    }
}
__device__ __forceinline__ void na_ret(const bf16* proj, bf16* y, const float* ret_g, LAS float* part, int bh, int tid) {
    const int b = bh >> 2, h = bh & 3, e = tid & 63, dg = tid >> 6;
    const float g = 1.0f - exp2f(-5.0f - (float)h);
    float S[8];
#pragma unroll
    for (int i = 0; i < 8; ++i) S[i] = 0.f;
    const float rg = ret_g[h * 64 + e];
    for (int t0 = 0; t0 < SEQ; t0 += 8) {
        for (int tt = 0; tt < 8; ++tt) { const size_t row = ((size_t)b * SEQ + t0 + tt) * NIN;
            const float ve = bf2f(proj[row + C_DV + h * 64 + e]); float pr = 0.f;
#pragma unroll
            for (int i = 0; i < 8; ++i) { const float kd = bf2f(proj[row + C_DK + h * 64 + dg * 8 + i]), qd = bf2f(proj[row + C_DQ + h * 64 + dg * 8 + i]);
                S[i] = g * S[i] + kd * ve; pr += qd * S[i]; }
            part[(tt * 8 + dg) * 64 + e] = pr; }
        __syncthreads();
        { const int tt = dg; float o = 0.f;
#pragma unroll
          for (int d8 = 0; d8 < 8; ++d8) o += part[(tt * 8 + d8) * 64 + e];
          const float mean = wave_sum(o) * (1.f / 64.f); const float dv = o - mean; const float var = wave_sum(dv * dv) * (1.f / 64.f);
          const float on = dv / sqrtf(var + EPS) * rg;
          const size_t m = (size_t)b * SEQ + t0 + tt;
          const float gate = bf2f(proj[m * NIN + C_DG + h * 64 + e]);
          y[m * DM + 768 + h * 64 + e] = (bf16)f2bf(on * gate); }
        __syncthreads();
    }
}

#define XB_TMO      128
#define XB_XCNT(j)  (256  + 64 * (j))
#define XB_XSUB(j)  (1280 + 64 * (j))
#define XB_XGEN(j)  (2304 + 64 * (j))
#define XB_TOP      3328
#define XB_TOPGEN   3392
#define XCD_BAR_WORDS 3456
#define XB_SPIN_CAP (1u << 18)

__device__ __forceinline__ unsigned xb_ld(unsigned* p)              { return __hip_atomic_load(p, __ATOMIC_RELAXED, __HIP_MEMORY_SCOPE_AGENT); }
__device__ __forceinline__ unsigned xb_add(unsigned* p, unsigned v) { return __hip_atomic_fetch_add(p, v, __ATOMIC_RELAXED, __HIP_MEMORY_SCOPE_AGENT); }
__device__ __forceinline__ unsigned xb_xcc_id() { return (unsigned)__builtin_amdgcn_s_getreg((3 << 11) | 20) & 0xFu; }
#define XB_SPIN(cond, bar) do { unsigned _sp = 0; while (cond) { __builtin_amdgcn_s_sleep(1); \
    if ((++_sp & 255u) == 0u) { if (xb_ld(&(bar)[XB_TMO])) break; if (_sp > XB_SPIN_CAP) { atomicAdd(&(bar)[XB_TMO], 1u); break; } } } } while (0)

struct XcdBarrier {
    unsigned* bar; unsigned x;
    volatile LAS unsigned* st;
};

__device__ __forceinline__ XcdBarrier xcd_barrier_post(unsigned* bar, volatile LAS unsigned* st) {
    XcdBarrier b; b.bar = bar; b.x = xb_xcc_id(); b.st = st;
    if (threadIdx.x == 0) (void)xb_add(&bar[XB_XCNT(b.x)], 1u);
    return b;
}
__device__ __forceinline__ void xcd_barrier_complete(unsigned* bar, unsigned x, unsigned& nloc, unsigned& nx) {
    const unsigned G = gridDim.x * gridDim.y * gridDim.z;
    unsigned sum, cnt, mine, sp = 0u;
    for (;;) {
        sum = 0u; cnt = 0u; mine = 0u;
#pragma unroll
        for (unsigned j = 0; j < 16; ++j) { const unsigned c = xb_ld(&bar[XB_XCNT(j)]); sum += c; cnt += (c > 0u) ? 1u : 0u; mine = (j == x) ? c : mine; }
        if (sum == G) break;
        __builtin_amdgcn_s_sleep(1);
        if ((++sp & 255u) == 0u) { if (xb_ld(&bar[XB_TMO])) break; if (sp > XB_SPIN_CAP) { atomicAdd(&bar[XB_TMO], 1u); break; } }
    }
    nloc = mine > 0u ? mine : 1u; nx = cnt > 0u ? cnt : 1u;
}

__device__ __forceinline__ void xcd_barrier(const XcdBarrier& b) {
    asm volatile("s_waitcnt vmcnt(0)" ::: "memory");
    __syncthreads();
    if (threadIdx.x == 0) {
        unsigned* bar = b.bar;
        __builtin_amdgcn_s_waitcnt(0);
        unsigned nloc = b.st[0], nx = b.st[1];
        if (nloc == 0u) { xcd_barrier_complete(bar, b.x, nloc, nx); b.st[0] = nloc; b.st[1] = nx; }
        const unsigned old = xb_add(&bar[XB_XSUB(b.x)], 1u);
        const unsigned gen = old / nloc;
        if (old + 1u == (gen + 1u) * nloc) {
            __builtin_amdgcn_fence(__ATOMIC_RELEASE, "agent");
            asm volatile("s_waitcnt vmcnt(0)" ::: "memory");
            const unsigned og = xb_add(&bar[XB_TOP], 1u);
            const unsigned tg = og / nx;
            if (og + 1u == (tg + 1u) * nx) xb_add(&bar[XB_TOPGEN], 1u);
            else XB_SPIN(xb_ld(&bar[XB_TOPGEN]) == tg, bar);
            __builtin_amdgcn_fence(__ATOMIC_ACQUIRE, "agent");
            xb_add(&bar[XB_XGEN(b.x)], 1u);
            asm volatile("s_waitcnt vmcnt(0)" ::: "memory");
        } else {
            XB_SPIN(xb_ld(&bar[XB_XGEN(b.x)]) == gen, bar);
            __builtin_amdgcn_fence(__ATOMIC_ACQUIRE, "agent");
            asm volatile("s_waitcnt vmcnt(0)" ::: "memory");
        }
    }
    __syncthreads();
}


typedef short bf16x8 __attribute__((ext_vector_type(8)));
typedef float f32x16 __attribute__((ext_vector_type(16)));
typedef float f32x2 __attribute__((ext_vector_type(2)));
typedef __bf16 bf16x2_t __attribute__((ext_vector_type(2)));
__device__ __forceinline__ unsigned cvtpk(float lo, float hi) { f32x2 v = {lo, hi}; return __builtin_bit_cast(unsigned, __builtin_convertvector(v, bf16x2_t)); }
#define MFMA32(a, b, c) __builtin_amdgcn_mfma_f32_32x32x16_bf16((a), (b), (c), 0, 0, 0)
#define PACK8(x, s) __builtin_bit_cast(bf16x8, (v4u){cvtpk((x)[8 * (s)], (x)[8 * (s) + 1]), cvtpk((x)[8 * (s) + 2], (x)[8 * (s) + 3]), cvtpk((x)[8 * (s) + 4], (x)[8 * (s) + 5]), cvtpk((x)[8 * (s) + 6], (x)[8 * (s) + 7])})
__device__ __forceinline__ int crow(int reg, int h) { return (reg & 3) + 8 * (reg >> 2) + 4 * h; }
__device__ __forceinline__ int keyperm(int k) { return (k & ~12) | ((k & 4) << 1) | ((k & 8) >> 1); }
constexpr int KP = 144;
__device__ __forceinline__ int vt_off(int d, int kp, int VP) { return d * VP + ((((kp >> 3) ^ ((d >> 3) & 7))) << 4) + ((kp & 7) << 1); }
__device__ __forceinline__ void vt_write8(LAS unsigned char* Vt, int VP, int c  , int kp, v4u v) {
    LAS unsigned char* base = Vt + (((kp >> 3) ^ c) << 4) + ((kp & 7) << 1) + (8 * c) * VP;
    *(LAS unsigned short*)(base + 0 * VP) = (unsigned short)(v.x & 0xffff); *(LAS unsigned short*)(base + 1 * VP) = (unsigned short)(v.x >> 16);
    *(LAS unsigned short*)(base + 2 * VP) = (unsigned short)(v.y & 0xffff); *(LAS unsigned short*)(base + 3 * VP) = (unsigned short)(v.y >> 16);
    *(LAS unsigned short*)(base + 4 * VP) = (unsigned short)(v.z & 0xffff); *(LAS unsigned short*)(base + 5 * VP) = (unsigned short)(v.z >> 16);
    *(LAS unsigned short*)(base + 6 * VP) = (unsigned short)(v.w & 0xffff); *(LAS unsigned short*)(base + 7 * VP) = (unsigned short)(v.w >> 16);
}

__device__ __forceinline__ void attn_unit(const bf16* proj, bf16* og, float* lse, int u, LAS unsigned char* L, int tid) {
    const int lane = tid & 63, wave = tid >> 6;
    const int w16 = u & 15; int t = u >> 4; const int g = t % 3; t /= 3; const int h = t & 3, b = t >> 2;
    const int dil = 1 << (2 * g), res = w16 & (dil - 1), qb = w16 >> (2 * g), Q0 = qb * 256;
    constexpr int VP = 784;
    LAS unsigned char* Kimg = L; LAS unsigned char* Vt = L + 384 * KP;
    const size_t rowbase = (size_t)b * SEQ;
#pragma unroll
    for (int it = 0; it < 6; ++it) { const int idx = tid + it * 512; const int key = idx >> 3, c = idx & 7, i = Q0 - 128 + key;
        if (i >= 0) { const bf16* src = proj + (rowbase + (size_t)i * dil + res) * NIN + h * 64 + c * 8;
            const v4u kv = *(const v4u*)(src + C_AK), vv = *(const v4u*)(src + C_AV);
            *(LAS v4u*)(Kimg + key * KP + c * 16) = kv;
            vt_write8(Vt, VP, c, keyperm(key), vv); } }
    __syncthreads();
    {
        const int r = lane & 31, hh = lane >> 5, wave_u = __builtin_amdgcn_readfirstlane(tid >> 6);
        const size_t qrow = rowbase + (size_t)(Q0 + 32 * wave + r) * dil + res;
        bf16x8 qf[4];
#pragma unroll
        for (int s = 0; s < 4; ++s) qf[s] = *(const bf16x8*)(proj + qrow * NIN + C_AQ + h * 64 + 16 * s + 8 * hh);
        const float slope2 = exp2f(-2.0f * (float)(h + 1)) * LOG2E * (float)dil;
        const int jt0 = (Q0 == 0 && wave_u < 4) ? 4 - wave_u : 0;
        float mx = -INFINITY, l = 0.f;
        f32x16 O[2];
#pragma unroll
        for (int i = 0; i < 16; ++i) { O[0][i] = 0.f; O[1][i] = 0.f; }
        const LAS unsigned char* kb = Kimg + (32 * wave + r) * KP + 16 * hh;
#pragma unroll 1
        for (int jt = jt0; jt < 5; ++jt) {
            f32x16 acc;
#pragma unroll
            for (int i = 0; i < 16; ++i) acc[i] = 0.f;
#pragma unroll
            for (int s = 0; s < 4; ++s) { const bf16x8 kf = *(const LAS bf16x8*)(kb + jt * (32 * KP) + 32 * s); acc = MFMA32(kf, qf[s], acc); }
            const float bq = slope2 * (float)(128 + r - 32 * jt); float tmax = -INFINITY;
#pragma unroll
            for (int i = 0; i < 16; ++i) { const int kk = crow(i, hh); float v = acc[i] - bq + slope2 * (float)kk;
                if (jt == 0 && kk < r) v = -INFINITY; if (jt == 4 && kk > r) v = -INFINITY; acc[i] = v; tmax = fmaxf(tmax, v); }
            tmax = fmaxf(tmax, __shfl_xor(tmax, 32));
            const float mn = fmaxf(mx, tmax), corr = __builtin_amdgcn_exp2f(mx - mn);
            l *= corr;
#pragma unroll
            for (int i = 0; i < 16; ++i) { O[0][i] *= corr; O[1][i] *= corr; }
#pragma unroll
            for (int i = 0; i < 16; ++i) { const float pv = __builtin_amdgcn_exp2f(acc[i] - mn); acc[i] = pv; l += pv; }
            mx = mn;
            const int T = wave + jt;
#pragma unroll
            for (int s = 0; s < 2; ++s) { const bf16x8 pf = PACK8(acc, s);
#pragma unroll
                for (int dt = 0; dt < 2; ++dt) { const int d = 32 * dt + r, G = 4 * T + 2 * s + hh;
                    const bf16x8 vf = *(const LAS bf16x8*)(Vt + d * VP + ((G ^ ((d >> 3) & 7)) << 4)); O[dt] = MFMA32(vf, pf, O[dt]); } }
        }
        l += __shfl_xor(l, 32);
        const float inv = 1.0f / l;
        bf16* orow = og + ((size_t)g * M + qrow) * 256 + h * 64;
#pragma unroll
        for (int dt = 0; dt < 2; ++dt)
#pragma unroll
            for (int i4 = 0; i4 < 4; ++i4) { v2u w; w.x = cvtpk(O[dt][4 * i4] * inv, O[dt][4 * i4 + 1] * inv); w.y = cvtpk(O[dt][4 * i4 + 2] * inv, O[dt][4 * i4 + 3] * inv);
                *(v2u*)(orow + 32 * dt + 8 * i4 + 4 * hh) = w; }
        if (hh == 0) lse[((size_t)g * M + qrow) * 4 + h] = mx + __builtin_amdgcn_logf(l);
    }
    __syncthreads();
}
__device__ __forceinline__ void attn_combine(const bf16* proj, const bf16* og, const float* lse, bf16* y, int gtid, int gthreads) {
    for (int idx = gtid; idx < M * 32; idx += gthreads) { const int row = idx >> 5, hc = idx & 31, h = hc >> 3, c = hc & 7;
        const float l0 = lse[(size_t)row * 4 + h], l1 = lse[((size_t)M + row) * 4 + h], l2 = lse[((size_t)2 * M + row) * 4 + h];
        const float mx = fmaxf(l0, fmaxf(l1, l2)); float w0 = __builtin_amdgcn_exp2f(l0 - mx), w1 = __builtin_amdgcn_exp2f(l1 - mx), w2 = __builtin_amdgcn_exp2f(l2 - mx);
        const float inv = 1.0f / (w0 + w1 + w2); w0 *= inv; w1 *= inv; w2 *= inv;
        const size_t off = (size_t)row * 256 + h * 64 + c * 8;
        const v4u a0 = *(const v4u*)(og + off), a1 = *(const v4u*)(og + (size_t)M * 256 + off), a2 = *(const v4u*)(og + (size_t)2 * M * 256 + off);
        const v4u gt = *(const v4u*)(proj + (size_t)row * NIN + C_AG + h * 64 + c * 8);
        v4u o;
#define CMB(f) { const float e0 = (w0 * bf2f((unsigned short)(a0.f & 0xffff)) + w1 * bf2f((unsigned short)(a1.f & 0xffff)) + w2 * bf2f((unsigned short)(a2.f & 0xffff))) * bf2f((unsigned short)(gt.f & 0xffff)); \
                 const float e1 = (w0 * bf2f((unsigned short)(a0.f >> 16)) + w1 * bf2f((unsigned short)(a1.f >> 16)) + w2 * bf2f((unsigned short)(a2.f >> 16))) * bf2f((unsigned short)(gt.f >> 16)); o.f = cvtpk(e0, e1); }
        CMB(x) CMB(y) CMB(z) CMB(w)
#undef CMB
        *(v4u*)(y + (size_t)row * DM + h * 64 + c * 8) = o; }
}

__device__ __forceinline__ void retkv_pair(const bf16* proj, float* kvT, int pair, LAS unsigned char* L, int tid) {
    const int half = tid >> 8, t256 = tid & 255, lane = tid & 63, w4 = (tid >> 6) & 3;
    const int uu = pair * 2 + half, n = uu & 31, h = (uu >> 5) & 3, b = uu >> 7;
    constexpr int VP = 272;
    LAS unsigned char* Vt = L + half * (2 * 64 * VP); LAS unsigned char* Kz = Vt + 64 * VP;
    const float lg2 = __builtin_amdgcn_logf(1.0f - exp2f(-5.0f - (float)h));
    const size_t row0 = (size_t)b * SEQ + n * 128;
#pragma unroll
    for (int it = 0; it < 4; ++it) { const int idx = t256 + it * 256, j = idx >> 3, c = idx & 7;
        const bf16* src = proj + (row0 + j) * NIN + h * 64 + c * 8;
        const v4u kv = *(const v4u*)(src + C_DK), vv = *(const v4u*)(src + C_DV);
        const float z = __builtin_amdgcn_exp2f(lg2 * (float)(127 - j));
        v4u kz; kz.x = cvtpk(bf2f((unsigned short)(kv.x & 0xffff)) * z, bf2f((unsigned short)(kv.x >> 16)) * z); kz.y = cvtpk(bf2f((unsigned short)(kv.y & 0xffff)) * z, bf2f((unsigned short)(kv.y >> 16)) * z);
        kz.z = cvtpk(bf2f((unsigned short)(kv.z & 0xffff)) * z, bf2f((unsigned short)(kv.z >> 16)) * z); kz.w = cvtpk(bf2f((unsigned short)(kv.w & 0xffff)) * z, bf2f((unsigned short)(kv.w >> 16)) * z);
        vt_write8(Kz, VP, c, j, kz); vt_write8(Vt, VP, c, j, vv); }
    __syncthreads();
    { const int r = lane & 31, hh = lane >> 5, et = w4 >> 1, dt = w4 & 1;
      f32x16 acc;
#pragma unroll
      for (int i = 0; i < 16; ++i) acc[i] = 0.f;
      const int e = 32 * et + r, d = 32 * dt + r;
#pragma unroll
      for (int ks = 0; ks < 8; ++ks) { const int G = 2 * ks + hh;
          const bf16x8 af = *(const LAS bf16x8*)(Vt + e * VP + ((G ^ ((e >> 3) & 7)) << 4));
          const bf16x8 bfr = *(const LAS bf16x8*)(Kz + d * VP + ((G ^ ((d >> 3) & 7)) << 4));
          acc = MFMA32(af, bfr, acc); }
      float* o = kvT + (size_t)uu * 4096;
#pragma unroll
      for (int i = 0; i < 16; ++i) o[(32 * et + crow(i, hh)) * 64 + d] = acc[i]; }
    __syncthreads();
}
__device__ __forceinline__ void ret_scan(const float* kvT, bf16* prev, int gtid) {
    if (gtid >= 65536) return;
    const int bh = gtid >> 11, el = (gtid & 2047) * 2, h = bh & 3;
    const float lg2 = __builtin_amdgcn_logf(1.0f - exp2f(-5.0f - (float)h)); const float cd = __builtin_amdgcn_exp2f(lg2 * 128.0f);
    f32x2 v[32];
#pragma unroll
    for (int n = 0; n < 32; ++n) v[n] = *(const f32x2*)(kvT + ((size_t)bh * 32 + n) * 4096 + el);
    f32x2 st = (f32x2){0.f, 0.f};
#pragma unroll
    for (int n = 0; n < 32; ++n) { *(unsigned*)(prev + ((size_t)bh * 32 + n) * 4096 + el) = cvtpk(st.x, st.y); st = st * cd + v[n]; }
}
__device__ __forceinline__ void ret_pair(const bf16* proj, const bf16* prev, const float* ret_g, bf16* y, int pair, LAS unsigned char* L, int tid) {
    const int half = tid >> 8, t256 = tid & 255, lane = tid & 63, w4 = (tid >> 6) & 3, w4u = __builtin_amdgcn_readfirstlane((tid >> 6) & 3);
    const int uu = pair * 2 + half, n = uu & 31, h = (uu >> 5) & 3, b = uu >> 7;
    constexpr int VP = 272;
    LAS unsigned char* Kimg = L + half * 45056; LAS unsigned char* Vt = Kimg + 128 * KP; LAS unsigned char* Pv = Vt + 64 * VP;
    const float lg2 = __builtin_amdgcn_logf(1.0f - exp2f(-5.0f - (float)h));
    const size_t row0 = (size_t)b * SEQ + n * 128;
#pragma unroll
    for (int it = 0; it < 4; ++it) { const int idx = t256 + it * 256, j = idx >> 3, c = idx & 7;
        const bf16* src = proj + (row0 + j) * NIN + h * 64 + c * 8;
        const v4u kv = *(const v4u*)(src + C_DK), vv = *(const v4u*)(src + C_DV);
        *(LAS v4u*)(Kimg + j * KP + c * 16) = kv;
        vt_write8(Vt, VP, c, keyperm(j), vv); }
    { const int e = t256 >> 2, d0 = (t256 & 3) * 16;
      const v4u* pp = (const v4u*)(prev + (size_t)uu * 4096 + e * 64 + d0);
      const v4u w0 = pp[0], w1 = pp[1];
      *(LAS v4u*)(Pv + e * KP + d0 * 2) = w0; *(LAS v4u*)(Pv + e * KP + d0 * 2 + 16) = w1; }
    __syncthreads();
    {
        const int r = lane & 31, hh = lane >> 5, il = 32 * w4 + r;
        const size_t qrow = row0 + il;
        bf16x8 qf[4];
#pragma unroll
        for (int s = 0; s < 4; ++s) qf[s] = *(const bf16x8*)(proj + qrow * NIN + C_DQ + h * 64 + 16 * s + 8 * hh);
        f32x16 O[2], C[2];
#pragma unroll
        for (int i = 0; i < 16; ++i) { O[0][i] = 0.f; O[1][i] = 0.f; C[0][i] = 0.f; C[1][i] = 0.f; }
#pragma unroll 1
        for (int T = 0; T <= w4u; ++T) {
            f32x16 acc;
#pragma unroll
            for (int i = 0; i < 16; ++i) acc[i] = 0.f;
#pragma unroll
            for (int s = 0; s < 4; ++s) { const bf16x8 kf = *(const LAS bf16x8*)(Kimg + (32 * T + r) * KP + 32 * s + 16 * hh); acc = MFMA32(kf, qf[s], acc); }
#pragma unroll
            for (int i = 0; i < 16; ++i) { const int diff = il - 32 * T - crow(i, hh); acc[i] = (diff >= 0) ? acc[i] * __builtin_amdgcn_exp2f(lg2 * (float)diff) : 0.f; }
#pragma unroll
            for (int s = 0; s < 2; ++s) { const bf16x8 pf = PACK8(acc, s);
#pragma unroll
                for (int dt = 0; dt < 2; ++dt) { const int d = 32 * dt + r, G = 4 * T + 2 * s + hh;
                    const bf16x8 vf = *(const LAS bf16x8*)(Vt + d * VP + ((G ^ ((d >> 3) & 7)) << 4)); O[dt] = MFMA32(vf, pf, O[dt]); } }
        }
#pragma unroll
        for (int dt = 0; dt < 2; ++dt)
#pragma unroll
            for (int s = 0; s < 4; ++s) { const bf16x8 pf = *(const LAS bf16x8*)(Pv + (32 * dt + r) * KP + 32 * s + 16 * hh); C[dt] = MFMA32(pf, qf[s], C[dt]); }
        const float xi = __builtin_amdgcn_exp2f(lg2 * (float)(il + 1));
        float sm = 0.f;
#pragma unroll
        for (int dt = 0; dt < 2; ++dt)
#pragma unroll
            for (int i = 0; i < 16; ++i) { O[dt][i] += xi * C[dt][i]; sm += O[dt][i]; }
        sm += __shfl_xor(sm, 32); const float mu = sm * (1.f / 64.f); float sq = 0.f;
#pragma unroll
        for (int dt = 0; dt < 2; ++dt)
#pragma unroll
            for (int i = 0; i < 16; ++i) { O[dt][i] -= mu; sq += O[dt][i] * O[dt][i]; }
        sq += __shfl_xor(sq, 32); const float rstd = 1.f / sqrtf(sq * (1.f / 64.f) + EPS);
#pragma unroll
        for (int dt = 0; dt < 2; ++dt)
#pragma unroll
            for (int i4 = 0; i4 < 4; ++i4) { const int e = 32 * dt + 8 * i4 + 4 * hh;
                const f32x4 rg = *(const f32x4*)(ret_g + h * 64 + e); const v2u gt = *(const v2u*)(proj + qrow * NIN + C_DG + h * 64 + e);
                v2u w; w.x = cvtpk(O[dt][4 * i4] * rstd * rg.x * bf2f((unsigned short)(gt.x & 0xffff)), O[dt][4 * i4 + 1] * rstd * rg.y * bf2f((unsigned short)(gt.x >> 16)));
                w.y = cvtpk(O[dt][4 * i4 + 2] * rstd * rg.z * bf2f((unsigned short)(gt.y & 0xffff)), O[dt][4 * i4 + 3] * rstd * rg.w * bf2f((unsigned short)(gt.y >> 16)));
                *(v2u*)(y + qrow * DM + 768 + h * 64 + e) = w; }
    }
    __syncthreads();
}

__device__ __forceinline__ void sgu_unit(const bf16* proj, bf16* y, const float* sgu_g, const bf16* wb  , const float* sgu_b, int u, LAS unsigned char* L, int tid) {
    const int lane = tid & 63, wave = tid >> 6;
    constexpr int VP = 272;
    LAS unsigned char* Vt = L; LAS float* stats = (LAS float*)(L + 256 * VP);
    const size_t row0 = (size_t)u * 128;
    { v2u wv[16];
#pragma unroll
      for (int i = 0; i < 16; ++i) wv[i] = *(const v2u*)(proj + (row0 + wave * 16 + i) * NIN + C_BV + 4 * lane);
#pragma unroll
      for (int i = 0; i < 16; ++i) { const int s = wave * 16 + i; const v2u w = wv[i];
        const float v0 = bf2f((unsigned short)(w.x & 0xffff)), v1 = bf2f((unsigned short)(w.x >> 16)), v2 = bf2f((unsigned short)(w.y & 0xffff)), v3 = bf2f((unsigned short)(w.y >> 16));
        const float mean = wave_sum((v0 + v1) + (v2 + v3)) * (1.f / 256.f); const float d0 = v0 - mean, d1 = v1 - mean, d2 = v2 - mean, d3 = v3 - mean;
        const float rstd = 1.f / sqrtf(wave_sum((d0 * d0 + d1 * d1) + (d2 * d2 + d3 * d3)) * (1.f / 256.f) + EPS);
        if (lane == 0) { stats[2 * s] = mean; stats[2 * s + 1] = rstd; } } }
    __syncthreads();
#pragma unroll
    for (int it = 0; it < 8; ++it) { const int idx = tid + it * 512, s = idx >> 5, c32 = idx & 31;
        const v4u w = *(const v4u*)(proj + (row0 + s) * NIN + C_BV + 8 * c32);
        const f32x4 g0 = *(const f32x4*)(sgu_g + 8 * c32), g1 = *(const f32x4*)(sgu_g + 8 * c32 + 4);
        const float mean = stats[2 * s], rstd = stats[2 * s + 1];
        v4u o; o.x = cvtpk((bf2f((unsigned short)(w.x & 0xffff)) - mean) * rstd * g0.x, (bf2f((unsigned short)(w.x >> 16)) - mean) * rstd * g0.y);
        o.y = cvtpk((bf2f((unsigned short)(w.y & 0xffff)) - mean) * rstd * g0.z, (bf2f((unsigned short)(w.y >> 16)) - mean) * rstd * g0.w);
        o.z = cvtpk((bf2f((unsigned short)(w.z & 0xffff)) - mean) * rstd * g1.x, (bf2f((unsigned short)(w.z >> 16)) - mean) * rstd * g1.y);
        o.w = cvtpk((bf2f((unsigned short)(w.w & 0xffff)) - mean) * rstd * g1.z, (bf2f((unsigned short)(w.w >> 16)) - mean) * rstd * g1.w);
        vt_write8(Vt + (c32 >> 3) * (64 * VP), VP, c32 & 7, s, o); }
    __syncthreads();
    { const int r = lane & 31, hh = lane >> 5, g = wave >> 1, dt = wave & 1, d = 32 * dt + r;
      const LAS unsigned char* vg = Vt + g * (64 * VP) + d * VP; const int sw = (d >> 3) & 7;
#pragma unroll
      for (int tt = 0; tt < 4; ++tt) { f32x16 acc;
#pragma unroll
          for (int i = 0; i < 16; ++i) acc[i] = 0.f;
          const bf16* wrow = wb + ((size_t)g * 128 + 32 * tt + r) * 128 + 8 * hh;
#pragma unroll
          for (int ks = 0; ks < 2 * (tt + 1); ++ks) { const bf16x8 af = *(const LAS bf16x8*)(vg + (((2 * ks + hh) ^ sw) << 4)); const bf16x8 bfr = *(const bf16x8*)(wrow + 16 * ks); acc = MFMA32(af, bfr, acc); }
          const int t = 32 * tt + r; const size_t row = row0 + t; const float bias = sgu_b[g * 128 + t];
#pragma unroll
          for (int i4 = 0; i4 < 4; ++i4) { const int d0 = 32 * dt + 8 * i4 + 4 * hh;
              const v2u uu = *(const v2u*)(proj + row * NIN + C_BU + g * 64 + d0), gt = *(const v2u*)(proj + row * NIN + C_BG + g * 64 + d0);
              v2u w; w.x = cvtpk((acc[4 * i4] + bias) * bf2f((unsigned short)(uu.x & 0xffff)) * bf2f((unsigned short)(gt.x & 0xffff)), (acc[4 * i4 + 1] + bias) * bf2f((unsigned short)(uu.x >> 16)) * bf2f((unsigned short)(gt.x >> 16)));
              w.y = cvtpk((acc[4 * i4 + 2] + bias) * bf2f((unsigned short)(uu.y & 0xffff)) * bf2f((unsigned short)(gt.y & 0xffff)), (acc[4 * i4 + 3] + bias) * bf2f((unsigned short)(uu.y >> 16)) * bf2f((unsigned short)(gt.y >> 16)));
              *(v2u*)(y + row * DM + 256 + g * 64 + d0) = w; } } }
    __syncthreads();
}
template <int PW>
__device__ __forceinline__ void pool_run(const bf16* src  , LAS unsigned char* dst, int tok  , int AP) {
    v4u x[PW + 7];
#pragma unroll
    for (int q = 0; q < PW + 7; ++q) { const int rel = q - (PW - 1); x[q] = (tok + rel >= 0) ? *(const v4u*)(src + (ptrdiff_t)rel * NIN) : (v4u){0u, 0u, 0u, 0u}; }
    float s[8];
#pragma unroll
    for (int c = 0; c < 8; ++c) s[c] = 0.f;
#define ADDX(q, sg) { s[0] += sg bf2f((unsigned short)(x[q].x & 0xffff)); s[1] += sg bf2f((unsigned short)(x[q].x >> 16)); s[2] += sg bf2f((unsigned short)(x[q].y & 0xffff)); s[3] += sg bf2f((unsigned short)(x[q].y >> 16)); \
                      s[4] += sg bf2f((unsigned short)(x[q].z & 0xffff)); s[5] += sg bf2f((unsigned short)(x[q].z >> 16)); s[6] += sg bf2f((unsigned short)(x[q].w & 0xffff)); s[7] += sg bf2f((unsigned short)(x[q].w >> 16)); }
#pragma unroll
    for (int q = 0; q < PW - 1; ++q) ADDX(q, +)
#pragma unroll
    for (int i = 0; i < 8; ++i) { const int q = PW - 1 + i; ADDX(q, +)
        const int cnt = (tok + i + 1 < PW) ? tok + i + 1 : PW; const float ic = 1.0f / (float)cnt; const v4u w0 = x[q];
        v4u o; o.x = cvtpk(s[0] * ic - bf2f((unsigned short)(w0.x & 0xffff)), s[1] * ic - bf2f((unsigned short)(w0.x >> 16))); o.y = cvtpk(s[2] * ic - bf2f((unsigned short)(w0.y & 0xffff)), s[3] * ic - bf2f((unsigned short)(w0.y >> 16)));
        o.z = cvtpk(s[4] * ic - bf2f((unsigned short)(w0.z & 0xffff)), s[5] * ic - bf2f((unsigned short)(w0.z >> 16))); o.w = cvtpk(s[6] * ic - bf2f((unsigned short)(w0.w & 0xffff)), s[7] * ic - bf2f((unsigned short)(w0.w >> 16)));
        *(LAS v4u*)(dst + i * AP) = o;
        ADDX(i, -) }
#undef ADDX
}
__device__ __forceinline__ void pool_unit(const bf16* proj, bf16* y, const bf16* pwt  , const float* pool_scale, int u, LAS unsigned char* L, int tid) {
    const int lane = tid & 63, wave = tid >> 6;
    constexpr int AP = 528;
    const size_t row0 = (size_t)u * 128; const int tok0 = (u & 31) * 128;
    { const int wu = __builtin_amdgcn_readfirstlane(tid >> 6), g = wu >> 1, c32 = 8 * g + (lane & 7), run = (lane >> 3) + 8 * (wu & 1), t0 = 8 * run;
      const bf16* src = proj + (row0 + t0) * NIN + C_CX + 8 * c32; LAS unsigned char* dst = L + t0 * AP + c32 * 16; const int tk = tok0 + t0;
      if (g == 0) pool_run<2>(src, dst, tk, AP); else if (g == 1) pool_run<4>(src, dst, tk, AP); else if (g == 2) pool_run<8>(src, dst, tk, AP); else pool_run<16>(src, dst, tk, AP); }
    __syncthreads();
    { const int r = lane & 31, hh = lane >> 5, g = wave >> 1, dt = wave & 1;
      bf16x8 af[4];
#pragma unroll
      for (int ks = 0; ks < 4; ++ks) af[ks] = *(const bf16x8*)(pwt + ((size_t)g * 64 + 32 * dt + r) * 64 + 16 * ks + 8 * hh);
#pragma unroll 1
      for (int tt = 0; tt < 4; ++tt) { f32x16 acc;
#pragma unroll
          for (int i = 0; i < 16; ++i) acc[i] = 0.f;
#pragma unroll
          for (int ks = 0; ks < 4; ++ks) { const bf16x8 bfr = *(const LAS bf16x8*)(L + (32 * tt + r) * AP + (g * 64 + 16 * ks + 8 * hh) * 2); acc = MFMA32(af[ks], bfr, acc); }
          const size_t row = row0 + 32 * tt + r;
#pragma unroll
          for (int i4 = 0; i4 < 4; ++i4) { const int d0 = 32 * dt + 8 * i4 + 4 * hh;
              const f32x4 sc = *(const f32x4*)(pool_scale + g * 64 + d0); const v2u gt = *(const v2u*)(proj + row * NIN + C_CG + g * 64 + d0);
              v2u w; w.x = cvtpk(acc[4 * i4] * sc.x * bf2f((unsigned short)(gt.x & 0xffff)), acc[4 * i4 + 1] * sc.y * bf2f((unsigned short)(gt.x >> 16)));
              w.y = cvtpk(acc[4 * i4 + 2] * sc.z * bf2f((unsigned short)(gt.y & 0xffff)), acc[4 * i4 + 3] * sc.w * bf2f((unsigned short)(gt.y >> 16)));
              *(v2u*)(y + row * DM + 512 + g * 64 + d0) = w; } } }
    __syncthreads();
}

#define PHASE_IDS() int tid = threadIdx.x; asm volatile("" : "+v"(tid)); const int lane = tid & 63; const int wave = __builtin_amdgcn_readfirstlane(tid >> 6); const int gw = (int)blockIdx.x * 8 + wave; (void)lane; (void)gw
#define PHASE_PTRS() unsigned char* ws = p.ws; asm volatile("" : "+s"(ws)); const float* x = p.in[0]; const float* w_in = p.in[2]; const float* w_out = p.in[9]; \
    const float* PRM = (const float*)(ws + WS_SMALL); bf16* WinT = (bf16*)(ws + WS_WIN); bf16* WoutT = (bf16*)(ws + WS_WOUT); bf16* XB = (bf16*)(ws + WS_XB); bf16* PROJ = (bf16*)(ws + WS_PROJ); \
    bf16* Y = (bf16*)(ws + WS_Y); bf16* Z = (bf16*)(ws + WS_Z); float* KVT = (float*)(ws + WS_KV); bf16* OG = (bf16*)(ws + WS_OG); float* LSE = (float*)(ws + WS_LSE); \
    float* R0P_ = (float*)(ws + WS_R0 + R0_PPART); float* R0Y_ = (float*)(ws + WS_R0 + R0_Y); float* R0Z_ = (float*)(ws + WS_R0 + R0_ZPART); float* R0H_ = (float*)(ws + WS_R0 + R0_H); (void)R0H_; \
    (void)x; (void)w_in; (void)w_out; (void)PRM; (void)WinT; (void)WoutT; (void)XB; (void)PROJ; (void)Y; (void)Z; (void)KVT; (void)OG; (void)LSE; (void)R0P_; (void)R0Y_; (void)R0Z_
__global__ void __launch_bounds__(512, 2) fwd(Params p) {
    extern __shared__ __attribute__((aligned(16))) unsigned char lds[];
    cg::grid_group grid = cg::this_grid();
    LAS unsigned char* L = (LAS unsigned char*)lds;
    const int G = gridDim.x, NGW = G * 8;
    { volatile LAS unsigned* st = (volatile LAS unsigned*)(L + 139264); if (threadIdx.x < 2) st[threadIdx.x] = 0u; }
    __syncthreads();
    const XcdBarrier bar = xcd_barrier_post((unsigned*)(p.ws + WS_CTL), (volatile LAS unsigned*)(L + 139264));
    {
        PHASE_IDS(); PHASE_PTRS();
        { float* prm = (float*)(ws + WS_SMALL);
          for (int i = (int)blockIdx.x * 512 + tid; i < P_END; i += G * 512) { float v;
              if (i < P_SGUG) v = p.in[1][i]; else if (i < P_SGUW) v = p.in[3][i - P_SGUG]; else if (i < P_SGUB) v = p.in[4][i - P_SGUW]; else if (i < P_POOLW) v = p.in[5][i - P_SGUB];
              else if (i < P_POOLS) v = p.in[6][i - P_POOLW]; else if (i < P_RETG) v = p.in[7][i - P_POOLS]; else if (i < P_POSTG) v = p.in[8][i - P_RETG]; else v = p.in[10][i - P_POSTG];
              prm[i] = v; } }
        { bf16* sw = (bf16*)(ws + WS_SGUWB); bf16* pw = (bf16*)(ws + WS_PWT);
          for (int i = (int)blockIdx.x * 512 + tid; i < 2 * 65536; i += G * 512) { const int s = i & 127, t = (i >> 7) & 127; sw[i] = (s <= t) ? (bf16)f2bf(p.in[4][i]) : (bf16)0; }
          for (int i = (int)blockIdx.x * 512 + tid; i < 2 * 16384; i += G * 512) { const int c = i & 63, d = (i >> 6) & 63, lg = i >> 12; pw[i] = (bf16)f2bf(p.in[6][(size_t)lg * 4096 + c * 64 + d]); } }
        LAS float* scr = (LAS float*)(L + wave * 16384);
        constexpr int I_IN = (DM / 64) * (NIN / 32), I_OUT = (DM / 64) * (DM / 32), I_L = I_IN + I_OUT;
        for (int it = gw; it < DEPTH * I_L; it += NGW) { const int l = it / I_L; int r = it % I_L;
            if (r < I_IN) p0_transpose_item(w_in + (size_t)l * DM * NIN, DM, NIN, WinT + (size_t)l * NIN * DM, p.in[1] + l * DM, 1, scr, r, lane);
            else p0_transpose_item(w_out + (size_t)l * DM * DM, DM, DM, WoutT + (size_t)l * DM * DM, nullptr, 0, scr, r - I_IN, lane); }
        for (int i = 0; i < M / NGW; ++i) { const int m = i * NGW + (gw + i * 257) % NGW; const bool r0 = (m & (SEQ - 1)) == 0; rms_row_to_bf16(x + (size_t)m * DM, XB + (size_t)m * DM, lane, r0 ? R0H_ + (size_t)(m >> 12) * DM : nullptr, p.in[1]); }
    }
    if (G == 0x7fffffff) grid.sync();
    xcd_barrier(bar);
#pragma unroll
    for (int l = 0; l < DEPTH; ++l) {
        { PHASE_PTRS(); pg8::Gemm g{XB, WinT + (size_t)l * NIN * DM, M, NIN, DM}; pg8::StaticOrder S; S.init(M, NIN, G, (int)blockIdx.x);
          pg8::EpiOut E{PROJ, NIN, (1u << 3) | (1u << 6) | (1u << 8) | (1u << 12)};
          pg8::gemm_phase<pg8::EpiOut, pg8::StaticOrder, true, true>((PG8_LAS unsigned char*)L, g, S, E); }
        { PHASE_IDS(); PHASE_PTRS();
          for (int task = gw; task < 52 * R0_KC; task += NGW) r0_dot_task<1>(R0H_, w_in + (size_t)l * DM * NIN, NIN, R0P_, task, 52, lane); }
        xcd_barrier(bar);
        {
            PHASE_IDS(); PHASE_PTRS();
            if ((int)blockIdx.x >= 248) r0_mix(R0P_, R0Y_, (int)blockIdx.x - 248, PRM + P_SGUG + l * 256, PRM + P_SGUW + (size_t)l * 65536, PRM + P_SGUB + l * 512, PRM + P_RETG + l * 256, (LAS float*)L, tid);
            for (int pr = (int)blockIdx.x; pr < 512; pr += G) retkv_pair(PROJ, KVT, pr, L, tid);
            for (int u = (int)blockIdx.x; u < 1536; u += G) attn_unit(PROJ, OG, LSE, u, L, tid);
            for (int u = (int)blockIdx.x; u < 256; u += G) sgu_unit(PROJ, Y, PRM + P_SGUG + l * 256, (const bf16*)(ws + WS_SGUWB) + (size_t)l * 65536, PRM + P_SGUB + l * 512, u, L, tid);
            for (int u = (int)blockIdx.x; u < 256; u += G) pool_unit(PROJ, Y, (const bf16*)(ws + WS_PWT) + (size_t)l * 16384, PRM + P_POOLS + l * 256, u, L, tid);
        }
        xcd_barrier(bar);
        { PHASE_IDS(); PHASE_PTRS(); ret_scan(KVT, (bf16*)(ws + WS_PREV), (int)blockIdx.x * 256 + tid - ((tid >= 256) ? 256 - 65536 : 0)); }
        xcd_barrier(bar);
        { PHASE_IDS(); PHASE_PTRS(); for (int pr = (int)blockIdx.x; pr < 512; pr += G) ret_pair(PROJ, (const bf16*)(ws + WS_PREV), PRM + P_RETG + l * 256, Y, pr, L, tid);
          attn_combine(PROJ, OG, LSE, Y, (int)blockIdx.x * 512 + tid, G * 512); }
        xcd_barrier(bar);
        { PHASE_PTRS(); pg8::Gemm g{Y, WoutT + (size_t)l * DM * DM, M, DM, DM}; pg8::StaticOrder S; S.init(M, DM, G, (int)blockIdx.x);
          pg8::EpiOut E{Z, DM, 0u};
          pg8::gemm_phase<pg8::EpiOut, pg8::StaticOrder, true, true>((PG8_LAS unsigned char*)L, g, S, E); }
        { PHASE_IDS(); PHASE_PTRS(); for (int task = gw; task < 16 * R0_KCZ; task += NGW) r0_dot_task<4>(R0Y_, w_out + (size_t)l * DM * DM, DM, R0Z_, task, 16, lane); }
        xcd_barrier(bar);
        { PHASE_IDS(); PHASE_PTRS(); const float* xres = (l == 0) ? x : p.out;
          for (int i = 0; i < M / NGW; ++i) { const int m = i * NGW + (gw + i * 257) % NGW; const bool r0 = (m & (SEQ - 1)) == 0;
              post_row(xres + (size_t)m * DM, Z + (size_t)m * DM, r0 ? R0Z_ + (size_t)(m >> 12) * DM : nullptr, PRM + P_POSTG + l * DM, p.out + (size_t)m * DM, (l + 1 < DEPTH) ? XB + (size_t)m * DM : nullptr, lane,
                       (r0 && l + 1 < DEPTH) ? R0H_ + (size_t)(m >> 12) * DM : nullptr, PRM + P_PREG + (l + 1 < DEPTH ? (l + 1) * DM : 0)); } }
        if (l + 1 < DEPTH) xcd_barrier(bar);
    }
}

extern "C" void kernel_launch(void* const* d_in, const int* in_sizes, int n_in, void* d_out, int out_size, void* d_ws, size_t ws_size, hipStream_t stream) {
    static int grid = 0;
    if (grid == 0) {
        if (n_in != 11 || in_sizes[0] != M * DM || out_size != M * DM || ws_size < WS_END) { fprintf(stderr, "kernel_launch: unexpected shapes (n_in %d, in0 %d, out %d, ws %zu)\n", n_in, n_in > 0 ? in_sizes[0] : -1, out_size, ws_size); grid = -1; return; }
        int dev = 0, cus = 0, per_cu = 0;
        hipGetDevice(&dev); hipDeviceGetAttribute(&cus, hipDeviceAttributeMultiprocessorCount, dev);
        if (hipFuncSetAttribute((const void*)fwd, hipFuncAttributeMaxDynamicSharedMemorySize, LDS_BYTES) != hipSuccess) { fprintf(stderr, "kernel_launch: hipFuncSetAttribute failed\n"); grid = -1; return; }
        if (hipOccupancyMaxActiveBlocksPerMultiprocessor(&per_cu, (const void*)fwd, 512, LDS_BYTES) != hipSuccess || per_cu < 1) { fprintf(stderr, "kernel_launch: occupancy query says %d\n", per_cu); per_cu = 1; }
        (void)hipGetLastError();
        grid = cus * 1;
        fprintf(stderr, "kernel_launch: cus %d per_cu %d grid %d\n", cus, per_cu, grid);
    }
    if (grid < 0) return;
    if (hipMemsetAsync((char*)d_ws + WS_CTL, 0, 65536, stream) != hipSuccess) { fprintf(stderr, "kernel_launch: memset failed\n"); return; }
    Params p{};
    for (int i = 0; i < 11; ++i) p.in[i] = (const float*)d_in[i];
    p.out = (float*)d_out; p.ws = (unsigned char*)d_ws;
    void* args[] = {&p};
    hipError_t e = hipLaunchCooperativeKernel((const void*)fwd, dim3(grid), dim3(512), args, LDS_BYTES, stream);
    if (e != hipSuccess) fprintf(stderr, "kernel_launch: cooperative launch failed: %s (grid %d)\n", hipGetErrorString(e), grid);
}
```

```cpp
#include <hip/hip_runtime.h>
#include <hip/hip_cooperative_groups.h>
#include <cstdio>
#include <cstdint>
namespace cg = cooperative_groups;
namespace pg8 {
#define PG8_LAS __attribute__((address_space(3)))
typedef unsigned short bf16_t;
typedef short bf16x8 __attribute__((ext_vector_type(8)));
typedef float f32x4 __attribute__((ext_vector_type(4)));
typedef unsigned u32x4 __attribute__((ext_vector_type(4)));
constexpr int BM = 256, BK = 64, HALF = 128, HTB = HALF * BK * 2  , STAGE_BYTES = 8 * HTB, NXCD = 8, WGM = 8;

__host__ __device__ __forceinline__ int lds_byte(int r, int c) { const int st = (r >> 4) * 2 + (c >> 5), rr = r & 15, cc = c & 31, ob = rr * 64 + cc * 2; return st * 1024 + (ob ^ (((ob >> 9) & 1) << 5)); }
__host__ __device__ __forceinline__ void stage_rc(int b, int& R, int& C) { const int st = b / 1024, sb = b % 1024, swz = sb ^ (((sb >> 9) & 1) << 5); R = (st >> 1) * 16 + swz / 64; C = (st & 1) * 32 + (swz % 64) / 2; }
__host__ __device__ __forceinline__ int perm32(int rho) { const int n = rho >> 4, i = rho & 15; return 8 * (i >> 2) + 4 * n + (i & 3); }

struct Unit { int pm, pn; };
struct Gemm { const bf16_t* A; const bf16_t* Bt; int M, N, K; };

struct StaticOrder {
    int nM, nN, nwg, G, c;
    __host__ __device__ void init(int M, int N, int G_, int c_) { nM = M / BM; nN = N / BM; nwg = nM * nN; G = G_; c = c_; }
    __host__ __device__ bool next(int i, Unit& u) const {
        const long L = (long)i * G + c; if (L >= nwg) return false;
        int wgid = (int)L; { const int q = nwg / NXCD, r = nwg % NXCD, xcd = wgid % NXCD, off = wgid / NXCD; wgid = (xcd < r ? xcd * (q + 1) : r * (q + 1) + (xcd - r) * q) + off; }
        const int nig = WGM * nN, gid = wgid / nig, fm = gid * WGM, gsz = (nM - fm) < WGM ? (nM - fm) : WGM;
        u.pm = fm + ((wgid % nig) % gsz); u.pn = (wgid % nig) / gsz; return true;
    }
    __device__ __forceinline__ void a_ready(const Unit&) const {}
    __device__ __forceinline__ void done(const Unit&) const {}
};

__device__ __forceinline__ unsigned cvt_pk_bf16(float lo, float hi) { unsigned r; asm volatile("v_cvt_pk_bf16_f32 %0, %1, %2" : "=v"(r) : "v"(lo), "v"(hi)); return r; }
__device__ __forceinline__ float silu_f(float x) { return x / (1.0f + __expf(-x)); }
struct EpiOut {
    static constexpr bool PERM = true, AFTER_DRAIN = false;
    bf16_t* O; int ldc; unsigned gate_mask;
    __device__ __forceinline__ void operator()(const f32x4 (&acc)[2][2][4][2], const Unit& u, int wr, int wc, int fr, int fq) const {
        const int row0 = u.pm * BM + wr * 64 + fr; const int col0 = u.pn * BM + wc * 32 + 8 * fq;
        const bool gate = (gate_mask >> u.pn) & 1u;
#pragma unroll
        for (int ai = 0; ai < 2; ++ai)
#pragma unroll
            for (int m = 0; m < 4; ++m) { bf16_t* rowp = O + (size_t)(row0 + ai * HALF + m * 16) * ldc + col0;
#pragma unroll
                for (int bj = 0; bj < 2; ++bj) { f32x4 v0 = acc[ai][bj][m][0], v1 = acc[ai][bj][m][1];
                    if (gate) { v0 = (f32x4){silu_f(v0[0]), silu_f(v0[1]), silu_f(v0[2]), silu_f(v0[3])}; v1 = (f32x4){silu_f(v1[0]), silu_f(v1[1]), silu_f(v1[2]), silu_f(v1[3])}; }
                    u32x4 w; w.x = cvt_pk_bf16(v0[0], v0[1]); w.y = cvt_pk_bf16(v0[2], v0[3]); w.z = cvt_pk_bf16(v1[0], v1[1]); w.w = cvt_pk_bf16(v1[2], v1[3]);
                    *(u32x4*)(rowp + bj * HALF) = w; } }
    }
};
template <class Epi, class Sched, bool ALIGN_EPI = false, bool SP2 = false>
__device__ __forceinline__ void gemm_phase(PG8_LAS unsigned char* lds, const Gemm g, const Sched& S, const Epi& E) {
    int tid_ = threadIdx.x; asm volatile("" : "+v"(tid_));
    const int tid = tid_, wid = __builtin_amdgcn_readfirstlane(tid >> 6), lane = tid & 63, wr = wid >> 2, wc = wid & 3, fr = lane & 15, fq = lane >> 4;
    const int K = g.K, nt = K / BK;
    unsigned voffA[2], voffB[2];
#pragma unroll
    for (int i = 0; i < 2; ++i) { int R, C; stage_rc(tid * 16 + i * 8192, R, C); const int Rb = Epi::PERM ? ((R & ~31) + perm32(R & 31)) : R;
        voffA[i] = (unsigned)(R * K + C) * 2u; voffB[i] = (unsigned)(Rb * K + C) * 2u; }
    const size_t kstep = (size_t)(BK * 2);
    const size_t hstep = (size_t)HALF * K * 2;
    const size_t tstep = 2 * hstep;
    const unsigned ldsw = (unsigned)wid * 1024u;
    const int aoff = lds_byte(wr * 64 + fr, fq * 8), boff = lds_byte(wc * 32 + fr, fq * 8);
#define PG8_SA(b, h) (((b) * 2 + (h)) * HTB)
#define PG8_SB(b, h) ((4 + (b) * 2 + (h)) * HTB)
#define PG8_STAGE(bufoff, gbase, voff) do { _Pragma("unroll") for (int _i = 0; _i < 2; ++_i) \
        __builtin_amdgcn_global_load_lds((const unsigned*)((const char*)(gbase) + (voff)[_i]), (PG8_LAS unsigned*)(lds + (bufoff) + ldsw + _i * 8192), 16, 0, 0); } while (0)
#define PG8_LDA(dst, b, h) do { _Pragma("unroll") for (int m = 0; m < 4; ++m) _Pragma("unroll") for (int k = 0; k < 2; ++k) dst[m][k] = *(const PG8_LAS bf16x8*)(lds + PG8_SA(b, h) + aoff + m * 2048 + k * 1024); } while (0)
#define PG8_LDB(dst, b, h) do { _Pragma("unroll") for (int n = 0; n < 2; ++n) _Pragma("unroll") for (int k = 0; k < 2; ++k) dst[n][k] = *(const PG8_LAS bf16x8*)(lds + PG8_SB(b, h) + boff + n * 2048 + k * 1024); } while (0)
#define PG8_MMA(ai, bj, At, Bt) do { __builtin_amdgcn_s_setprio(1); _Pragma("unroll") for (int m = 0; m < 4; ++m) _Pragma("unroll") for (int n = 0; n < 2; ++n) _Pragma("unroll") for (int k = 0; k < 2; ++k) \
        acc[ai][bj][m][n] = __builtin_amdgcn_mfma_f32_16x16x32_bf16(Bt[n][k], At[m][k], acc[ai][bj][m][n], 0, 0, 0); __builtin_amdgcn_s_setprio(0); } while (0)
#define PG8_WAIT_V(n) asm volatile("s_waitcnt vmcnt(" #n ")" ::: "memory")
#define PG8_WAIT_L(n) asm volatile("s_waitcnt lgkmcnt(" #n ")" ::: "memory")
#define PG8_BAR __builtin_amdgcn_s_barrier()
#define PG8_SCHED __builtin_amdgcn_sched_barrier(0)
    Unit cur, nxt; int ui = 0;
    if (!S.next(0, cur)) return;
    f32x4 acc[2][2][4][2];
#pragma unroll
    for (int a = 0; a < 2; ++a)
#pragma unroll
        for (int b = 0; b < 2; ++b)
#pragma unroll
            for (int m = 0; m < 4; ++m)
#pragma unroll
                for (int n = 0; n < 2; ++n) acc[a][b][m][n] = (f32x4){0.f, 0.f, 0.f, 0.f};
    bf16x8 At[4][2], B0[2][2], B1[2][2];
    const char* cA = (const char*)g.A + (size_t)cur.pm * tstep; const char* cB = (const char*)g.Bt + (size_t)cur.pn * tstep;
    S.a_ready(cur);
    if constexpr (SP2) {
        PG8_STAGE(PG8_SB(0, 0), cB, voffB); PG8_STAGE(PG8_SB(0, 1), cB + hstep, voffB); PG8_STAGE(PG8_SA(0, 0), cA, voffA); PG8_STAGE(PG8_SA(0, 1), cA + hstep, voffA);
        if (wr == 1) PG8_BAR;
        PG8_WAIT_V(2); PG8_BAR;
        PG8_STAGE(PG8_SB(1, 0), cB + kstep, voffB); PG8_STAGE(PG8_SA(1, 0), cA + kstep, voffA); PG8_STAGE(PG8_SB(1, 1), cB + hstep + kstep, voffB);
        PG8_WAIT_V(6); PG8_BAR;
    } else {
        PG8_STAGE(PG8_SB(0, 0), cB, voffB); PG8_STAGE(PG8_SA(0, 0), cA, voffA); PG8_STAGE(PG8_SB(0, 1), cB + hstep, voffB); PG8_STAGE(PG8_SA(0, 1), cA + hstep, voffA);
        if (wr == 1) PG8_BAR;
        PG8_WAIT_V(4); PG8_BAR;
        PG8_STAGE(PG8_SB(1, 0), cB + kstep, voffB); PG8_STAGE(PG8_SA(1, 0), cA + kstep, voffA); PG8_STAGE(PG8_SB(1, 1), cB + hstep + kstep, voffB);
        PG8_WAIT_V(6); PG8_BAR;
    }
    for (;;) {
        const bool has_next = S.next(ui + 1, nxt);
        const char* nA = has_next ? (const char*)g.A + (size_t)nxt.pm * tstep : cA; const char* nB = has_next ? (const char*)g.Bt + (size_t)nxt.pn * tstep : cB;
        for (int t = 0; t < nt; t += 2) {
            const bool last = (t == nt - 2);
            const char* a1 = cA + (size_t)(t + 1) * kstep;
            const char* a2 = last ? nA : cA + (size_t)(t + 2) * kstep; const char* b2 = last ? nB : cB + (size_t)(t + 2) * kstep;
            const char* a3 = a2 + kstep; const char* b3 = b2 + kstep;
            if (last && has_next) S.a_ready(nxt);
            if constexpr (SP2) {
            PG8_LDB(B0, 0, 0); PG8_LDB(B1, 0, 1); PG8_SCHED; PG8_LDA(At, 0, 0); PG8_STAGE(PG8_SA(1, 1), a1 + hstep, voffA);
            PG8_WAIT_V(8); PG8_WAIT_L(0); PG8_BAR; PG8_MMA(0, 0, At, B0); PG8_MMA(0, 1, At, B1); PG8_BAR; PG8_SCHED;
            PG8_LDA(At, 0, 1); PG8_STAGE(PG8_SB(0, 0), b2, voffB); PG8_STAGE(PG8_SB(0, 1), b2 + hstep, voffB); PG8_STAGE(PG8_SA(0, 0), a2, voffA);
            PG8_WAIT_V(8); PG8_WAIT_L(0); PG8_BAR; PG8_MMA(1, 0, At, B0); PG8_MMA(1, 1, At, B1); PG8_BAR; PG8_SCHED;
            PG8_LDB(B0, 1, 0); PG8_LDB(B1, 1, 1); PG8_SCHED; PG8_LDA(At, 1, 0); PG8_STAGE(PG8_SA(0, 1), a2 + hstep, voffA);
            PG8_WAIT_V(8); PG8_WAIT_L(0); PG8_BAR; PG8_MMA(0, 0, At, B0); PG8_MMA(0, 1, At, B1); PG8_BAR; PG8_SCHED;
            PG8_LDA(At, 1, 1); PG8_STAGE(PG8_SB(1, 0), b3, voffB); PG8_STAGE(PG8_SB(1, 1), b3 + hstep, voffB); PG8_STAGE(PG8_SA(1, 0), a3, voffA);
            PG8_WAIT_V(8); PG8_WAIT_L(0); PG8_BAR; PG8_MMA(1, 0, At, B0); PG8_MMA(1, 1, At, B1); PG8_BAR; PG8_SCHED;
            } else {
            PG8_LDB(B0, 0, 0); PG8_SCHED; PG8_LDA(At, 0, 0); PG8_STAGE(PG8_SA(1, 1), a1 + hstep, voffA);
            PG8_WAIT_L(8); PG8_BAR; PG8_WAIT_L(0); PG8_MMA(0, 0, At, B0); PG8_BAR; PG8_SCHED;
            PG8_LDB(B1, 0, 1); PG8_STAGE(PG8_SB(0, 0), b2, voffB);
            PG8_BAR; PG8_WAIT_L(0); PG8_MMA(0, 1, At, B1); PG8_BAR;
            PG8_LDA(At, 0, 1); PG8_STAGE(PG8_SA(0, 0), a2, voffA);
            PG8_BAR; PG8_WAIT_L(0); PG8_MMA(1, 0, At, B0); PG8_BAR; PG8_SCHED;
            PG8_STAGE(PG8_SB(0, 1), b2 + hstep, voffB);
            PG8_WAIT_V(6); PG8_BAR; PG8_MMA(1, 1, At, B1); PG8_BAR;
            PG8_LDB(B0, 1, 0); PG8_SCHED; PG8_LDA(At, 1, 0); PG8_STAGE(PG8_SA(0, 1), a2 + hstep, voffA);
            PG8_WAIT_L(8); PG8_BAR; PG8_WAIT_L(0); PG8_MMA(0, 0, At, B0); PG8_BAR; PG8_SCHED;
            PG8_LDB(B1, 1, 1); PG8_STAGE(PG8_SB(1, 0), b3, voffB);
            PG8_BAR; PG8_WAIT_L(0); PG8_MMA(0, 1, At, B1); PG8_BAR;
            PG8_LDA(At, 1, 1); PG8_STAGE(PG8_SA(1, 0), a3, voffA);
            PG8_BAR; PG8_WAIT_L(0); PG8_MMA(1, 0, At, B0); PG8_BAR; PG8_SCHED;
            PG8_STAGE(PG8_SB(1, 1), b3 + hstep, voffB);
            PG8_WAIT_V(6); PG8_BAR; PG8_MMA(1, 1, At, B1); PG8_BAR;
            }
        }
        if constexpr (ALIGN_EPI) { if (wr == 0) PG8_BAR; }
        if constexpr (!Epi::AFTER_DRAIN) { E(acc, cur, wr, wc, fr, fq); S.done(cur); }
        if (!has_next) break;
#pragma unroll
        for (int a = 0; a < 2; ++a)
#pragma unroll
            for (int b = 0; b < 2; ++b)
#pragma unroll
                for (int m = 0; m < 4; ++m)
#pragma unroll
                    for (int n = 0; n < 2; ++n) acc[a][b][m][n] = (f32x4){0.f, 0.f, 0.f, 0.f};
        cur = nxt; cA = nA; cB = nB; ++ui;
        if constexpr (ALIGN_EPI) { if (wr == 1) PG8_BAR; }
    }
    PG8_WAIT_V(0);
    if constexpr (!ALIGN_EPI) { if (wr == 0) PG8_BAR; }
    PG8_BAR;
    if constexpr (Epi::AFTER_DRAIN) { E.fused(acc, cur, wr, wc, fr, fq, lds, wid, lane); S.done(cur); }
#undef PG8_SA
#undef PG8_SB
#undef PG8_STAGE
#undef PG8_LDA
#undef PG8_LDB
#undef PG8_MMA
#undef PG8_WAIT_V
#undef PG8_WAIT_L
#undef PG8_BAR
#undef PG8_SCHED
}
}
#define LAS __attribute__((address_space(3)))
typedef unsigned short bf16;
typedef unsigned v4u __attribute__((ext_vector_type(4)));
typedef unsigned v2u __attribute__((ext_vector_type(2)));
typedef float f32x4 __attribute__((ext_vector_type(4)));
constexpr int SEQ = 4096, BATCH = 8, DM = 1024, M = BATCH * SEQ, NIN = 3328, DEPTH = 2;
constexpr float EPS = 1e-6f;
constexpr float LOG2E = 1.4426950408889634f;
constexpr float QSCALE = 0.125f * LOG2E;
constexpr int C_AQ = 0, C_AK = 256, C_AV = 512, C_AG = 768, C_BU = 1024, C_BV = 1280, C_BG = 1536, C_CX = 1792, C_CG = 2048, C_DQ = 2304, C_DK = 2560, C_DV = 2816, C_DG = 3072;
constexpr size_t MiB = 1u << 20;
constexpr size_t WS_WIN = 0, WS_WOUT = 13 * MiB, WS_SMALL = 17 * MiB, WS_XB = 18 * MiB, WS_PROJ = 82 * MiB, WS_Y = 290 * MiB, WS_Z = 354 * MiB, WS_OG = 418 * MiB, WS_LSE = 466 * MiB, WS_KV = 468 * MiB, WS_R0 = 484 * MiB, WS_CTL = 490 * MiB, WS_PREV = 491 * MiB, WS_RS = 499 * MiB, WS_END = 500 * MiB;
constexpr size_t R0_PPART = 0, R0_Y = 4 * MiB, R0_H = R0_Y + 65536, R0_ZPART = 5 * MiB;
constexpr int R0_KC = 32, R0_KCZ = 8;
constexpr int LDS_BYTES = 147456;
constexpr size_t WS_SGUWB = WS_SMALL + 704 * 1024, WS_PWT = WS_SMALL + 960 * 1024;
constexpr int P_PREG = 0, P_SGUG = 2048, P_SGUW = 2560, P_SGUB = 133632, P_POOLW = 134656, P_POOLS = 167424, P_RETG = 167936, P_POSTG = 168448, P_END = 170496;

__device__ __forceinline__ float bf2f(unsigned short u) { return __uint_as_float(((unsigned)u) << 16); }
__device__ __forceinline__ unsigned f2bf(float f) { unsigned u = __float_as_uint(f); return (u + 0x7fffu + ((u >> 16) & 1u)) >> 16; }
__device__ __forceinline__ unsigned pk2(float lo, float hi) { return f2bf(lo) | (f2bf(hi) << 16); }
__device__ __forceinline__ float wave_sum(float v) {
#pragma unroll
    for (int o = 1; o < 64; o <<= 1) v += __shfl_xor(v, o);
    return v;
}
#define LDS_WAIT() asm volatile("s_waitcnt lgkmcnt(0)" ::: "memory")

struct Params { const float* in[11]; float* out; unsigned char* ws; };

__device__ __forceinline__ void p0_transpose_item(const float* W, int K, int N, bf16* WT, const float* rs, int col_mode, LAS float* scr, int item, int lane) {
    const int nblk = N / 32, kb = item / nblk, nb = item % nblk, k0 = 64 * kb, n0 = 32 * nb;
    float cs = 1.f;
    if (col_mode) { const int n = n0 + (lane & 31); if (n < 256) cs = QSCALE; else if (n >= C_DK && n < C_DK + 256) cs = 0.125f; }
#pragma unroll
    for (int i = 0; i < 32; ++i) { const int kk = 2 * i + (lane >> 5); float v = W[(size_t)(k0 + kk) * N + n0 + (lane & 31)] * cs; if (rs) v *= rs[k0 + kk]; scr[kk * 33 + (lane & 31)] = v; }
    LDS_WAIT(); asm volatile("" ::: "memory");
    const int c = lane & 7;
#pragma unroll
    for (int j = 0; j < 4; ++j) { const int n = (lane >> 3) + 8 * j; const LAS float* s = scr + (8 * c) * 33 + n;
        v4u o; o.x = pk2(s[0 * 33], s[1 * 33]); o.y = pk2(s[2 * 33], s[3 * 33]); o.z = pk2(s[4 * 33], s[5 * 33]); o.w = pk2(s[6 * 33], s[7 * 33]);
        *(v4u*)(WT + (size_t)(n0 + n) * K + k0 + 8 * c) = o; }
    LDS_WAIT(); asm volatile("" ::: "memory");
}

__device__ __forceinline__ void rms_row_to_bf16(const float* xrow, bf16* orow, int lane, float* h0row = nullptr, const float* pgn = nullptr) {
    const f32x4* xr = (const f32x4*)xrow + lane;
    f32x4 v[4]; float s = 0.f;
#pragma unroll
    for (int j = 0; j < 4; ++j) { v[j] = xr[64 * j]; s += (v[j].x * v[j].x + v[j].y * v[j].y) + (v[j].z * v[j].z + v[j].w * v[j].w); }
    const float rstd = 1.f / sqrtf(wave_sum(s) * (1.f / DM) + EPS);
    v2u* o8 = (v2u*)orow + lane;
#pragma unroll
    for (int j = 0; j < 4; ++j) { v2u w; w.x = pk2(v[j].x * rstd, v[j].y * rstd); w.y = pk2(v[j].z * rstd, v[j].w * rstd); o8[64 * j] = w; }
    if (h0row) {
#pragma unroll
        for (int j = 0; j < 4; ++j) *((f32x4*)h0row + lane + 64 * j) = v[j] * rstd * *((const f32x4*)pgn + lane + 64 * j); }
}

__device__ __forceinline__ void unpack4(const v2u w, f32x4& o) { o = (f32x4){bf2f((unsigned short)(w.x & 0xffff)), bf2f((unsigned short)(w.x >> 16)), bf2f((unsigned short)(w.y & 0xffff)), bf2f((unsigned short)(w.y >> 16))}; }
__device__ __forceinline__ float ssq4(const f32x4 (&v)[4]) { float s = 0.f;
#pragma unroll
    for (int j = 0; j < 4; ++j) s += (v[j].x * v[j].x + v[j].y * v[j].y) + (v[j].z * v[j].z + v[j].w * v[j].w);
    return s; }
__device__ __forceinline__ void r0z_sum(const float* r0z, int lane, f32x4 (&z)[4]) {
#pragma unroll
    for (int j = 0; j < 4; ++j) { asm volatile("" ::: "memory"); f32x4 a = (f32x4){0.f, 0.f, 0.f, 0.f};
#pragma unroll
        for (int kc = 0; kc < R0_KCZ; ++kc) a += *((const f32x4*)(r0z + (size_t)kc * 8 * DM) + lane + 64 * j);
        z[j] = a; }
}

__device__ __forceinline__ float rdl(float v, int l) { return __int_as_float(__builtin_amdgcn_readlane(__float_as_int(v), l)); }
template <int NB  >
__device__ __forceinline__ void r0_dot_task(const float* h, const float* W, int N, float* part, int task, int nchunks, int lane) {
    const int ch = task % nchunks, kc = task / nchunks, n0 = ch * 64;
    float acc[8];
#pragma unroll
    for (int b = 0; b < 8; ++b) acc[b] = 0.f;
#pragma unroll 1
    for (int sb = 0; sb < NB; ++sb) { const int k0 = (kc * NB + sb) * 32;
        float hv[4], w[32];
#pragma unroll
        for (int i = 0; i < 4; ++i) { const int idx = lane + 64 * i; hv[i] = h[(idx >> 5) * DM + k0 + (idx & 31)]; }
#pragma unroll
        for (int kk = 0; kk < 32; ++kk) w[kk] = W[(size_t)(k0 + kk) * N + n0 + lane];
#pragma unroll
        for (int kk = 0; kk < 32; ++kk)
#pragma unroll
            for (int b = 0; b < 8; ++b) acc[b] += rdl(hv[b >> 1], (b & 1) * 32 + kk) * w[kk]; }
#pragma unroll
    for (int b = 0; b < 8; ++b) part[((size_t)kc * 8 + b) * N + n0 + lane] = acc[b];
}
using pg8::silu_f;
__device__ __forceinline__ void r0_mix(const float* ppart, float* y0, int b, const float* sgu_g, const float* sgu_w, const float* sgu_b, const float* ret_g, LAS float* P, int tid) {
#pragma unroll 2
    for (int n = tid; n < NIN; n += 512) { float a = 0.f;
#pragma unroll
        for (int kc = 0; kc < R0_KC; ++kc) a += ppart[((size_t)kc * 8 + b) * NIN + n];
        P[n] = a; }
    __syncthreads();
    if (tid < 64) { const int lane = tid;
        float sm = 0.f;
#pragma unroll
        for (int i = 0; i < 4; ++i) sm += P[C_BV + lane + 64 * i];
        const float mean = wave_sum(sm) * (1.f / 256.f); float sq = 0.f;
#pragma unroll
        for (int i = 0; i < 4; ++i) { const float d = P[C_BV + lane + 64 * i] - mean; sq += d * d; }
        const float rstd = 1.f / sqrtf(wave_sum(sq) * (1.f / 256.f) + EPS);
#pragma unroll 1
        for (int i = 0; i < 4; ++i) { const int c = lane + 64 * i;
            y0[b * DM + c] = P[C_AV + c] * silu_f(P[C_AG + c]);
            const float mixed = sgu_w[(size_t)i * 16384] * ((P[C_BV + c] - mean) * rstd * sgu_g[c]) + sgu_b[i * 128];
            y0[b * DM + 256 + c] = P[C_BU + c] * mixed * silu_f(P[C_BG + c]);
            y0[b * DM + 512 + c] = 0.f;
            const float cc = wave_sum(P[C_DQ + c] * P[C_DK + c]) * 0.125f; const float of = cc * P[C_DV + c];
            const float mu = wave_sum(of) * (1.f / 64.f); const float d0 = of - mu; const float var = wave_sum(d0 * d0) * (1.f / 64.f);
            y0[b * DM + 768 + c] = d0 / sqrtf(var + EPS) * ret_g[c] * silu_f(P[C_DG + c]); } }
    __syncthreads();
}

__device__ __forceinline__ void na_attn(const bf16* proj, bf16* y, int gw, int NGW, int lane) {
    for (int task = gw; task < M * 4; task += NGW) {
        const int m = task >> 2, h = task & 3, t = m & (SEQ - 1);
        const float q = bf2f(proj[(size_t)m * NIN + C_AQ + h * 64 + lane]);
        const float slope2 = exp2f(-2.0f * (h + 1)) * LOG2E;
        float mr = -INFINITY, l = 0.f, o = 0.f;
        for (int g = 0; g < 3; ++g) { const int dil = 1 << (2 * g);
            for (int j = 0; j <= 128; ++j) { const int tk = t - j * dil; if (tk < 0) break;
                const size_t row = (size_t)(m - j * dil) * NIN;
                const float kd = bf2f(proj[row + C_AK + h * 64 + lane]), vd = bf2f(proj[row + C_AV + h * 64 + lane]);
                const float s = wave_sum(q * kd) - slope2 * (float)(j * dil);
                const float mn = fmaxf(mr, s), corr = exp2f(mr - mn), pp = exp2f(s - mn);
                l = l * corr + pp; o = o * corr + pp * vd; mr = mn; } }
        const float gate = bf2f(proj[(size_t)m * NIN + C_AG + h * 64 + lane]);
        y[(size_t)m * DM + h * 64 + lane] = (bf16)f2bf(o / l * gate);
    }
}
__device__ __forceinline__ void na_sgu(const bf16* proj, bf16* y, const float* sgu_g, const float* sgu_w, const float* sgu_b, int gw, int NGW, int lane) {
    for (int m = gw; m < M; m += NGW) {
        const int t = m & 127; const size_t base = (size_t)(m - t);
        float acc[4] = {0.f, 0.f, 0.f, 0.f}; float gg[4];
#pragma unroll
        for (int i = 0; i < 4; ++i) gg[i] = sgu_g[lane + 64 * i];
        for (int s = 0; s <= t; ++s) { float v[4]; float sm = 0.f;
#pragma unroll
            for (int i = 0; i < 4; ++i) { v[i] = bf2f(proj[(base + s) * NIN + C_BV + lane + 64 * i]); sm += v[i]; }
            const float mean = wave_sum(sm) * (1.f / 256.f); float sq = 0.f;
#pragma unroll
            for (int i = 0; i < 4; ++i) { v[i] -= mean; sq += v[i] * v[i]; }
            const float rstd = 1.f / sqrtf(wave_sum(sq) * (1.f / 256.f) + EPS);
#pragma unroll
            for (int i = 0; i < 4; ++i) acc[i] += sgu_w[(size_t)i * 16384 + t * 128 + s] * (v[i] * rstd * gg[i]); }
#pragma unroll
        for (int i = 0; i < 4; ++i) { const float mixed = acc[i] + sgu_b[i * 128 + t];
            const float u = bf2f(proj[(size_t)m * NIN + C_BU + lane + 64 * i]), gate = bf2f(proj[(size_t)m * NIN + C_BG + lane + 64 * i]);
            y[(size_t)m * DM + 256 + lane + 64 * i] = (bf16)f2bf(u * mixed * gate); }
    }
}
__device__ __forceinline__ void na_pool(const bf16* proj, bf16* y, const float* pool_w, const float* pool_scale, int gw, int NGW, int lane) {
    for (int task = gw; task < M * 4; task += NGW) {
        const int m = task >> 2, g = task & 3, t = m & (SEQ - 1), p = 2 << g;
        const int cnt = (t + 1 < p) ? (t + 1) : p; float sum = 0.f;
        for (int j = 0; j < cnt; ++j) sum += bf2f(proj[(size_t)(m - j) * NIN + C_CX + g * 64 + lane]);
        const float pooled = sum / (float)cnt - bf2f(proj[(size_t)m * NIN + C_CX + g * 64 + lane]);
        float o = 0.f;
        for (int c = 0; c < 64; ++c) o += __shfl(pooled, c) * pool_w[(size_t)g * 4096 + c * 64 + lane];
        const float gate = bf2f(proj[(size_t)m * NIN + C_CG + g * 64 + lane]);
        y[(size_t)m * DM + 512 + g * 64 + lane] = (bf16)f2bf(o * pool_scale[g * 64 + lane] * gate);
    }
}
__device__ __forceinline__ void na_ret(const bf16* proj, bf16* y, const float* ret_g, LAS float* part, int bh, int tid) {
    const int b = bh >> 2, h = bh & 3, e = tid & 63, dg = tid >> 6;
    const float g = 1.0f - exp2f(-5.0f - (float)h);
    float S[8];
#pragma unroll
    for (int i = 0; i < 8; ++i) S[i] = 0.f;
    const float rg = ret_g[h * 64 + e];
    for (int t0 = 0; t0 < SEQ; t0 += 8) {
        for (int tt = 0; tt < 8; ++tt) { const size_t row = ((size_t)b * SEQ + t0 + tt) * NIN;
            const float ve = bf2f(proj[row + C_DV + h * 64 + e]); float pr = 0.f;
#pragma unroll
            for (int i = 0; i < 8; ++i) { const float kd = bf2f(proj[row + C_DK + h * 64 + dg * 8 + i]), qd = bf2f(proj[row + C_DQ + h * 64 + dg * 8 + i]);
                S[i] = g * S[i] + kd * ve; pr += qd * S[i]; }
            part[(tt * 8 + dg) * 64 + e] = pr; }
        __syncthreads();
        { const int tt = dg; float o = 0.f;
#pragma unroll
          for (int d8 = 0; d8 < 8; ++d8) o += part[(tt * 8 + d8) * 64 + e];
          const float mean = wave_sum(o) * (1.f / 64.f); const float dv = o - mean; const float var = wave_sum(dv * dv) * (1.f / 64.f);
          const float on = dv / sqrtf(var + EPS) * rg;
          const size_t m = (size_t)b * SEQ + t0 + tt;
          const float gate = bf2f(proj[m * NIN + C_DG + h * 64 + e]);
          y[m * DM + 768 + h * 64 + e] = (bf16)f2bf(on * gate); }
        __syncthreads();
    }
}

#define XB_TMO      128
#define XB_XCNT(j)  (256  + 64 * (j))
#define XB_XSUB(j)  (1280 + 64 * (j))
#define XB_XGEN(j)  (2304 + 64 * (j))
#define XB_TOP      3328
#define XB_TOPGEN   3392
#define XCD_BAR_WORDS 3456
#define XB_SPIN_CAP (1u << 18)

__device__ __forceinline__ unsigned xb_ld(unsigned* p)              { return __hip_atomic_load(p, __ATOMIC_RELAXED, __HIP_MEMORY_SCOPE_AGENT); }
__device__ __forceinline__ unsigned xb_add(unsigned* p, unsigned v) { return __hip_atomic_fetch_add(p, v, __ATOMIC_RELAXED, __HIP_MEMORY_SCOPE_AGENT); }
__device__ __forceinline__ unsigned xb_xcc_id() { return (unsigned)__builtin_amdgcn_s_getreg((3 << 11) | 20) & 0xFu; }
#define XB_SPIN(cond, bar) do { unsigned _sp = 0; while (cond) { __builtin_amdgcn_s_sleep(1); \
    if ((++_sp & 255u) == 0u) { if (xb_ld(&(bar)[XB_TMO])) break; if (_sp > XB_SPIN_CAP) { atomicAdd(&(bar)[XB_TMO], 1u); break; } } } } while (0)

struct XcdBarrier {
    unsigned* bar; unsigned x;
    volatile LAS unsigned* st;
};

__device__ __forceinline__ XcdBarrier xcd_barrier_post(unsigned* bar, volatile LAS unsigned* st) {
    XcdBarrier b; b.bar = bar; b.x = xb_xcc_id(); b.st = st;
    if (threadIdx.x == 0) (void)xb_add(&bar[XB_XCNT(b.x)], 1u);
    return b;
}
__device__ __forceinline__ void xcd_barrier_complete(unsigned* bar, unsigned x, unsigned& nloc, unsigned& nx) {
    const unsigned G = gridDim.x * gridDim.y * gridDim.z;
    unsigned sum, cnt, mine, sp = 0u;
    for (;;) {
        sum = 0u; cnt = 0u; mine = 0u;
#pragma unroll
        for (unsigned j = 0; j < 16; ++j) { const unsigned c = xb_ld(&bar[XB_XCNT(j)]); sum += c; cnt += (c > 0u) ? 1u : 0u; mine = (j == x) ? c : mine; }
        if (sum == G) break;
        __builtin_amdgcn_s_sleep(1);
        if ((++sp & 255u) == 0u) { if (xb_ld(&bar[XB_TMO])) break; if (sp > XB_SPIN_CAP) { atomicAdd(&bar[XB_TMO], 1u); break; } }
    }
    nloc = mine > 0u ? mine : 1u; nx = cnt > 0u ? cnt : 1u;
}

__device__ __forceinline__ void xcd_barrier(const XcdBarrier& b) {
    asm volatile("s_waitcnt vmcnt(0)" ::: "memory");
    __syncthreads();
    if (threadIdx.x == 0) {
        size_t z0_ = 0; asm volatile("" : "+s"(z0_)); unsigned* bar = b.bar + z0_;
        const unsigned bx = xb_xcc_id();
        __builtin_amdgcn_s_waitcnt(0);
        unsigned nloc = b.st[0], nx = b.st[1];
        if (nloc == 0u) { xcd_barrier_complete(bar, bx, nloc, nx); b.st[0] = nloc; b.st[1] = nx; }
        const unsigned old = xb_add(&bar[XB_XSUB(bx)], 1u);
        const unsigned gen = old / nloc;
        if (old + 1u == (gen + 1u) * nloc) {
            __builtin_amdgcn_fence(__ATOMIC_RELEASE, "agent");
            asm volatile("s_waitcnt vmcnt(0)" ::: "memory");
            const unsigned og = xb_add(&bar[XB_TOP], 1u);
            const unsigned tg = og / nx;
            if (og + 1u == (tg + 1u) * nx) xb_add(&bar[XB_TOPGEN], 1u);
            else XB_SPIN(xb_ld(&bar[XB_TOPGEN]) == tg, bar);
            __builtin_amdgcn_fence(__ATOMIC_ACQUIRE, "agent");
            xb_add(&bar[XB_XGEN(bx)], 1u);
            asm volatile("s_waitcnt vmcnt(0)" ::: "memory");
        } else {
            XB_SPIN(xb_ld(&bar[XB_XGEN(bx)]) == gen, bar);
            __builtin_amdgcn_fence(__ATOMIC_ACQUIRE, "agent");
            asm volatile("s_waitcnt vmcnt(0)" ::: "memory");
        }
    }
    __syncthreads();
}


typedef short bf16x8 __attribute__((ext_vector_type(8)));
typedef float f32x16 __attribute__((ext_vector_type(16)));
typedef float f32x2 __attribute__((ext_vector_type(2)));
typedef __bf16 bf16x2_t __attribute__((ext_vector_type(2)));
__device__ __forceinline__ unsigned cvtpk(float lo, float hi) { f32x2 v = {lo, hi}; return __builtin_bit_cast(unsigned, __builtin_convertvector(v, bf16x2_t)); }
#define MFMA32(a, b, c) __builtin_amdgcn_mfma_f32_32x32x16_bf16((a), (b), (c), 0, 0, 0)
#define PACK8(x, s) __builtin_bit_cast(bf16x8, (v4u){cvtpk((x)[8 * (s)], (x)[8 * (s) + 1]), cvtpk((x)[8 * (s) + 2], (x)[8 * (s) + 3]), cvtpk((x)[8 * (s) + 4], (x)[8 * (s) + 5]), cvtpk((x)[8 * (s) + 6], (x)[8 * (s) + 7])})
__device__ __forceinline__ int crow(int reg, int h) { return (reg & 3) + 8 * (reg >> 2) + 4 * h; }
__device__ __forceinline__ int keyperm(int k) { return (k & ~12) | ((k & 4) << 1) | ((k & 8) >> 1); }
constexpr int KP = 144;
__device__ __forceinline__ int vt_off(int d, int kp, int VP) { return d * VP + ((((kp >> 3) ^ ((d >> 3) & 7))) << 4) + ((kp & 7) << 1); }
__device__ __forceinline__ void vt_write8(LAS unsigned char* Vt, int VP, int c  , int kp, v4u v) {
    LAS unsigned char* base = Vt + (((kp >> 3) ^ c) << 4) + ((kp & 7) << 1) + (8 * c) * VP;
    *(LAS unsigned short*)(base + 0 * VP) = (unsigned short)(v.x & 0xffff); *(LAS unsigned short*)(base + 1 * VP) = (unsigned short)(v.x >> 16);
    *(LAS unsigned short*)(base + 2 * VP) = (unsigned short)(v.y & 0xffff); *(LAS unsigned short*)(base + 3 * VP) = (unsigned short)(v.y >> 16);
    *(LAS unsigned short*)(base + 4 * VP) = (unsigned short)(v.z & 0xffff); *(LAS unsigned short*)(base + 5 * VP) = (unsigned short)(v.z >> 16);
    *(LAS unsigned short*)(base + 6 * VP) = (unsigned short)(v.w & 0xffff); *(LAS unsigned short*)(base + 7 * VP) = (unsigned short)(v.w >> 16);
}

struct AttnU { int b, h, g, dil, res, Q0; };
__device__ __forceinline__ AttnU attn_decode(int u) { AttnU a; const int w16 = u & 15; int t = u >> 4; a.g = t % 3; t /= 3; a.h = t & 3; a.b = t >> 2; a.dil = 1 << (2 * a.g); a.res = w16 & (a.dil - 1); a.Q0 = (w16 >> (2 * a.g)) * 256; return a; }
__device__ __forceinline__ void attn_load(const bf16* proj, const AttnU& a, int tid, v4u (&pk)[6], v4u (&pv)[6]) {
#pragma unroll
    for (int it = 0; it < 6; ++it) { const int idx = tid + it * 512; const int key = idx >> 3, c = idx & 7, i = a.Q0 - 128 + key;
        if (i >= 0) { const bf16* src = proj + ((size_t)a.b * SEQ + (size_t)i * a.dil + a.res) * NIN + a.h * 64 + c * 8; pk[it] = *(const v4u*)(src + C_AK); pv[it] = *(const v4u*)(src + C_AV); } }
}
__device__ __forceinline__ void attn_phase(const bf16* proj, bf16* og, float* lse, int u0, int ustride, int nunits, LAS unsigned char* L, int tid) {
    const int lane = tid & 63, wave = tid >> 6, wave_u = __builtin_amdgcn_readfirstlane(tid >> 6);
    constexpr int VP = 784;
    LAS unsigned char* Kimg = L; LAS unsigned char* Vt = L + 384 * KP;
    v4u pk[6], pv[6];
    if (u0 < nunits) { const AttnU a0 = attn_decode(u0); attn_load(proj, a0, tid, pk, pv); }
#pragma unroll 1
    for (int u = u0; u < nunits; u += ustride) {
        const AttnU a = attn_decode(u);
        const int r = lane & 31, hh = lane >> 5;
        const size_t rowbase = (size_t)a.b * SEQ;
        const size_t qrow = rowbase + (size_t)(a.Q0 + 32 * wave + r) * a.dil + a.res;
        bf16x8 qf[4];
#pragma unroll
        for (int s = 0; s < 4; ++s) qf[s] = *(const bf16x8*)(proj + qrow * NIN + C_AQ + a.h * 64 + 16 * s + 8 * hh);
#pragma unroll
        for (int it = 0; it < 6; ++it) { const int idx = tid + it * 512; const int key = idx >> 3, c = idx & 7, i = a.Q0 - 128 + key;
            if (i >= 0) { *(LAS v4u*)(Kimg + key * KP + c * 16) = pk[it]; vt_write8(Vt, VP, c, keyperm(key), pv[it]); } }
        __syncthreads();
        if (u + ustride < nunits) { const AttnU an = attn_decode(u + ustride); attn_load(proj, an, tid, pk, pv); }
        {
            const float slope2 = exp2f(-2.0f * (float)(a.h + 1)) * LOG2E * (float)a.dil;
            const int jt0 = (a.Q0 == 0 && wave_u < 4) ? 4 - wave_u : 0;
            float mx = -INFINITY, l = 0.f;
            f32x16 O[2];
#pragma unroll
            for (int i = 0; i < 16; ++i) { O[0][i] = 0.f; O[1][i] = 0.f; }
            const LAS unsigned char* kb = Kimg + (32 * wave + r) * KP + 16 * hh;
#pragma unroll 1
            for (int jt = jt0; jt < 5; ++jt) {
                f32x16 acc;
#pragma unroll
                for (int i = 0; i < 16; ++i) acc[i] = 0.f;
#pragma unroll
                for (int s = 0; s < 4; ++s) { const bf16x8 kf = *(const LAS bf16x8*)(kb + jt * (32 * KP) + 32 * s); acc = MFMA32(kf, qf[s], acc); }
                const float bq = slope2 * (float)(128 + r - 32 * jt); float tmax = -INFINITY;
#pragma unroll
                for (int i = 0; i < 16; ++i) { const int kk = crow(i, hh); float v = acc[i] - bq + slope2 * (float)kk;
                    if (jt == 0 && kk < r) v = -INFINITY; if (jt == 4 && kk > r) v = -INFINITY; acc[i] = v; tmax = fmaxf(tmax, v); }
                tmax = fmaxf(tmax, __shfl_xor(tmax, 32));
                const float mn = fmaxf(mx, tmax), corr = __builtin_amdgcn_exp2f(mx - mn);
                l *= corr;
#pragma unroll
                for (int i = 0; i < 16; ++i) { O[0][i] *= corr; O[1][i] *= corr; }
#pragma unroll
                for (int i = 0; i < 16; ++i) { const float pvv = __builtin_amdgcn_exp2f(acc[i] - mn); acc[i] = pvv; l += pvv; }
                mx = mn;
                const int T = wave + jt;
#pragma unroll
                for (int s = 0; s < 2; ++s) { const bf16x8 pf = PACK8(acc, s);
#pragma unroll
                    for (int dt = 0; dt < 2; ++dt) { const int d = 32 * dt + r, G = 4 * T + 2 * s + hh;
                        const bf16x8 vf = *(const LAS bf16x8*)(Vt + d * VP + ((G ^ ((d >> 3) & 7)) << 4)); O[dt] = MFMA32(vf, pf, O[dt]); } }
            }
            l += __shfl_xor(l, 32);
            const float inv = 1.0f / l;
            bf16* orow = og + ((size_t)a.g * M + qrow) * 256 + a.h * 64;
#pragma unroll
            for (int dt = 0; dt < 2; ++dt)
#pragma unroll
                for (int i4 = 0; i4 < 4; ++i4) { v2u w; w.x = cvtpk(O[dt][4 * i4] * inv, O[dt][4 * i4 + 1] * inv); w.y = cvtpk(O[dt][4 * i4 + 2] * inv, O[dt][4 * i4 + 3] * inv);
                    *(v2u*)(orow + 32 * dt + 8 * i4 + 4 * hh) = w; }
            if (hh == 0) lse[((size_t)a.g * M + qrow) * 4 + a.h] = mx + __builtin_amdgcn_logf(l);
        }
        __syncthreads();
    }
}
__device__ __forceinline__ void attn_combine(const bf16* proj, const bf16* og, const float* lse, bf16* y, int gtid, int gthreads) {
    for (int idx = gtid; idx < M * 32; idx += gthreads) { const int row = idx >> 5, hc = idx & 31, h = hc >> 3, c = hc & 7;
        const float l0 = lse[(size_t)row * 4 + h], l1 = lse[((size_t)M + row) * 4 + h], l2 = lse[((size_t)2 * M + row) * 4 + h];
        const float mx = fmaxf(l0, fmaxf(l1, l2)); float w0 = __builtin_amdgcn_exp2f(l0 - mx), w1 = __builtin_amdgcn_exp2f(l1 - mx), w2 = __builtin_amdgcn_exp2f(l2 - mx);
        const float inv = 1.0f / (w0 + w1 + w2); w0 *= inv; w1 *= inv; w2 *= inv;
        const size_t off = (size_t)row * 256 + h * 64 + c * 8;
        const v4u a0 = *(const v4u*)(og + off), a1 = *(const v4u*)(og + (size_t)M * 256 + off), a2 = *(const v4u*)(og + (size_t)2 * M * 256 + off);
        const v4u gt = *(const v4u*)(proj + (size_t)row * NIN + C_AG + h * 64 + c * 8);
        v4u o;
#define CMB(f) { const float e0 = (w0 * bf2f((unsigned short)(a0.f & 0xffff)) + w1 * bf2f((unsigned short)(a1.f & 0xffff)) + w2 * bf2f((unsigned short)(a2.f & 0xffff))) * bf2f((unsigned short)(gt.f & 0xffff)); \
                 const float e1 = (w0 * bf2f((unsigned short)(a0.f >> 16)) + w1 * bf2f((unsigned short)(a1.f >> 16)) + w2 * bf2f((unsigned short)(a2.f >> 16))) * bf2f((unsigned short)(gt.f >> 16)); o.f = cvtpk(e0, e1); }
        CMB(x) CMB(y) CMB(z) CMB(w)
#undef CMB
        *(v4u*)(y + (size_t)row * DM + h * 64 + c * 8) = o; }
}

__device__ __forceinline__ void retkv_pair(const bf16* proj, float* kvT, int pair, LAS unsigned char* L, int tid) {
    const int half = tid >> 8, t256 = tid & 255, lane = tid & 63, w4 = (tid >> 6) & 3;
    const int uu = pair * 2 + half, n = uu & 31, h = (uu >> 5) & 3, b = uu >> 7;
    constexpr int VP = 272;
    LAS unsigned char* Vt = L + half * (2 * 64 * VP); LAS unsigned char* Kz = Vt + 64 * VP;
    const float lg2 = __builtin_amdgcn_logf(1.0f - exp2f(-5.0f - (float)h));
    const size_t row0 = (size_t)b * SEQ + n * 128;
#pragma unroll
    for (int it = 0; it < 4; ++it) { const int idx = t256 + it * 256, j = idx >> 3, c = idx & 7;
        const bf16* src = proj + (row0 + j) * NIN + h * 64 + c * 8;
        const v4u kv = *(const v4u*)(src + C_DK), vv = *(const v4u*)(src + C_DV);
        const float z = __builtin_amdgcn_exp2f(lg2 * (float)(127 - j));
        v4u kz; kz.x = cvtpk(bf2f((unsigned short)(kv.x & 0xffff)) * z, bf2f((unsigned short)(kv.x >> 16)) * z); kz.y = cvtpk(bf2f((unsigned short)(kv.y & 0xffff)) * z, bf2f((unsigned short)(kv.y >> 16)) * z);
        kz.z = cvtpk(bf2f((unsigned short)(kv.z & 0xffff)) * z, bf2f((unsigned short)(kv.z >> 16)) * z); kz.w = cvtpk(bf2f((unsigned short)(kv.w & 0xffff)) * z, bf2f((unsigned short)(kv.w >> 16)) * z);
        vt_write8(Kz, VP, c, j, kz); vt_write8(Vt, VP, c, j, vv); }
    __syncthreads();
    { const int r = lane & 31, hh = lane >> 5, et = w4 >> 1, dt = w4 & 1;
      f32x16 acc;
#pragma unroll
      for (int i = 0; i < 16; ++i) acc[i] = 0.f;
      const int e = 32 * et + r, d = 32 * dt + r;
#pragma unroll
      for (int ks = 0; ks < 8; ++ks) { const int G = 2 * ks + hh;
          const bf16x8 af = *(const LAS bf16x8*)(Vt + e * VP + ((G ^ ((e >> 3) & 7)) << 4));
          const bf16x8 bfr = *(const LAS bf16x8*)(Kz + d * VP + ((G ^ ((d >> 3) & 7)) << 4));
          acc = MFMA32(af, bfr, acc); }
      float* o = kvT + (size_t)uu * 4096;
#pragma unroll
      for (int i = 0; i < 16; ++i) o[(32 * et + crow(i, hh)) * 64 + d] = acc[i]; }
    __syncthreads();
}
__device__ __forceinline__ void ret_scan(const float* kvT, bf16* prev, int gtid) {
    if (gtid >= 65536) return;
    const int bh = gtid >> 11, el = (gtid & 2047) * 2, h = bh & 3;
    const float lg2 = __builtin_amdgcn_logf(1.0f - exp2f(-5.0f - (float)h)); const float cd = __builtin_amdgcn_exp2f(lg2 * 128.0f);
    f32x2 v[32];
#pragma unroll
    for (int n = 0; n < 32; ++n) v[n] = *(const f32x2*)(kvT + ((size_t)bh * 32 + n) * 4096 + el);
    f32x2 st = (f32x2){0.f, 0.f};
#pragma unroll
    for (int n = 0; n < 32; ++n) { *(unsigned*)(prev + ((size_t)bh * 32 + n) * 4096 + el) = cvtpk(st.x, st.y); st = st * cd + v[n]; }
}
__device__ __forceinline__ void ret_pair(const bf16* proj, const bf16* prev, const float* ret_g, bf16* y, int pair, LAS unsigned char* L, int tid) {
    const int half = tid >> 8, t256 = tid & 255, lane = tid & 63, w4 = (tid >> 6) & 3, w4u = __builtin_amdgcn_readfirstlane((tid >> 6) & 3);
    const int uu = pair * 2 + half, n = uu & 31, h = (uu >> 5) & 3, b = uu >> 7;
    constexpr int VP = 272;
    LAS unsigned char* Kimg = L + half * 45056; LAS unsigned char* Vt = Kimg + 128 * KP; LAS unsigned char* Pv = Vt + 64 * VP;
    const float lg2 = __builtin_amdgcn_logf(1.0f - exp2f(-5.0f - (float)h));
    const size_t row0 = (size_t)b * SEQ + n * 128;
#pragma unroll
    for (int it = 0; it < 4; ++it) { const int idx = t256 + it * 256, j = idx >> 3, c = idx & 7;
        const bf16* src = proj + (row0 + j) * NIN + h * 64 + c * 8;
        const v4u kv = *(const v4u*)(src + C_DK), vv = *(const v4u*)(src + C_DV);
        *(LAS v4u*)(Kimg + j * KP + c * 16) = kv;
        vt_write8(Vt, VP, c, keyperm(j), vv); }
    { const int e = t256 >> 2, d0 = (t256 & 3) * 16;
      const v4u* pp = (const v4u*)(prev + (size_t)uu * 4096 + e * 64 + d0);
      const v4u w0 = pp[0], w1 = pp[1];
      *(LAS v4u*)(Pv + e * KP + d0 * 2) = w0; *(LAS v4u*)(Pv + e * KP + d0 * 2 + 16) = w1; }
    __syncthreads();
    {
        const int r = lane & 31, hh = lane >> 5, il = 32 * w4 + r;
        const size_t qrow = row0 + il;
        bf16x8 qf[4];
#pragma unroll
        for (int s = 0; s < 4; ++s) qf[s] = *(const bf16x8*)(proj + qrow * NIN + C_DQ + h * 64 + 16 * s + 8 * hh);
        f32x16 O[2], C[2];
#pragma unroll
        for (int i = 0; i < 16; ++i) { O[0][i] = 0.f; O[1][i] = 0.f; C[0][i] = 0.f; C[1][i] = 0.f; }
#pragma unroll 1
        for (int T = 0; T <= w4u; ++T) {
            f32x16 acc;
#pragma unroll
            for (int i = 0; i < 16; ++i) acc[i] = 0.f;
#pragma unroll
            for (int s = 0; s < 4; ++s) { const bf16x8 kf = *(const LAS bf16x8*)(Kimg + (32 * T + r) * KP + 32 * s + 16 * hh); acc = MFMA32(kf, qf[s], acc); }
#pragma unroll
            for (int i = 0; i < 16; ++i) { const int diff = il - 32 * T - crow(i, hh); acc[i] = (diff >= 0) ? acc[i] * __builtin_amdgcn_exp2f(lg2 * (float)diff) : 0.f; }
#pragma unroll
            for (int s = 0; s < 2; ++s) { const bf16x8 pf = PACK8(acc, s);
#pragma unroll
                for (int dt = 0; dt < 2; ++dt) { const int d = 32 * dt + r, G = 4 * T + 2 * s + hh;
                    const bf16x8 vf = *(const LAS bf16x8*)(Vt + d * VP + ((G ^ ((d >> 3) & 7)) << 4)); O[dt] = MFMA32(vf, pf, O[dt]); } }
        }
#pragma unroll
        for (int dt = 0; dt < 2; ++dt)
#pragma unroll
            for (int s = 0; s < 4; ++s) { const bf16x8 pf = *(const LAS bf16x8*)(Pv + (32 * dt + r) * KP + 32 * s + 16 * hh); C[dt] = MFMA32(pf, qf[s], C[dt]); }
        const float xi = __builtin_amdgcn_exp2f(lg2 * (float)(il + 1));
        float sm = 0.f;
#pragma unroll
        for (int dt = 0; dt < 2; ++dt)
#pragma unroll
            for (int i = 0; i < 16; ++i) { O[dt][i] += xi * C[dt][i]; sm += O[dt][i]; }
        sm += __shfl_xor(sm, 32); const float mu = sm * (1.f / 64.f); float sq = 0.f;
#pragma unroll
        for (int dt = 0; dt < 2; ++dt)
#pragma unroll
            for (int i = 0; i < 16; ++i) { O[dt][i] -= mu; sq += O[dt][i] * O[dt][i]; }
        sq += __shfl_xor(sq, 32); const float rstd = 1.f / sqrtf(sq * (1.f / 64.f) + EPS);
#pragma unroll
        for (int dt = 0; dt < 2; ++dt)
#pragma unroll
            for (int i4 = 0; i4 < 4; ++i4) { const int e = 32 * dt + 8 * i4 + 4 * hh;
                const f32x4 rg = *(const f32x4*)(ret_g + h * 64 + e); const v2u gt = *(const v2u*)(proj + qrow * NIN + C_DG + h * 64 + e);
                v2u w; w.x = cvtpk(O[dt][4 * i4] * rstd * rg.x * bf2f((unsigned short)(gt.x & 0xffff)), O[dt][4 * i4 + 1] * rstd * rg.y * bf2f((unsigned short)(gt.x >> 16)));
                w.y = cvtpk(O[dt][4 * i4 + 2] * rstd * rg.z * bf2f((unsigned short)(gt.y & 0xffff)), O[dt][4 * i4 + 3] * rstd * rg.w * bf2f((unsigned short)(gt.y >> 16)));
                *(v2u*)(y + qrow * DM + 768 + h * 64 + e) = w; }
    }
    __syncthreads();
}

__device__ __forceinline__ void sgu_unit(const bf16* proj, bf16* y, const float* sgu_g, const bf16* wb  , const float* sgu_b, int u, LAS unsigned char* L, int tid) {
    const int lane = tid & 63, wave = tid >> 6;
    constexpr int VP = 272;
    LAS unsigned char* Vt = L; LAS float* stats = (LAS float*)(L + 256 * VP);
    const size_t row0 = (size_t)u * 128;
    { v2u wv[16];
#pragma unroll
      for (int i = 0; i < 16; ++i) wv[i] = *(const v2u*)(proj + (row0 + wave * 16 + i) * NIN + C_BV + 4 * lane);
#pragma unroll
      for (int i = 0; i < 16; ++i) { const int s = wave * 16 + i; const v2u w = wv[i];
        const float v0 = bf2f((unsigned short)(w.x & 0xffff)), v1 = bf2f((unsigned short)(w.x >> 16)), v2 = bf2f((unsigned short)(w.y & 0xffff)), v3 = bf2f((unsigned short)(w.y >> 16));
        const float mean = wave_sum((v0 + v1) + (v2 + v3)) * (1.f / 256.f); const float d0 = v0 - mean, d1 = v1 - mean, d2 = v2 - mean, d3 = v3 - mean;
        const float rstd = 1.f / sqrtf(wave_sum((d0 * d0 + d1 * d1) + (d2 * d2 + d3 * d3)) * (1.f / 256.f) + EPS);
        if (lane == 0) { stats[2 * s] = mean; stats[2 * s + 1] = rstd; } } }
    __syncthreads();
#pragma unroll
    for (int it = 0; it < 8; ++it) { const int idx = tid + it * 512, s = idx >> 5, c32 = idx & 31;
        const v4u w = *(const v4u*)(proj + (row0 + s) * NIN + C_BV + 8 * c32);
        const f32x4 g0 = *(const f32x4*)(sgu_g + 8 * c32), g1 = *(const f32x4*)(sgu_g + 8 * c32 + 4);
        const float mean = stats[2 * s], rstd = stats[2 * s + 1];
        v4u o; o.x = cvtpk((bf2f((unsigned short)(w.x & 0xffff)) - mean) * rstd * g0.x, (bf2f((unsigned short)(w.x >> 16)) - mean) * rstd * g0.y);
        o.y = cvtpk((bf2f((unsigned short)(w.y & 0xffff)) - mean) * rstd * g0.z, (bf2f((unsigned short)(w.y >> 16)) - mean) * rstd * g0.w);
        o.z = cvtpk((bf2f((unsigned short)(w.z & 0xffff)) - mean) * rstd * g1.x, (bf2f((unsigned short)(w.z >> 16)) - mean) * rstd * g1.y);
        o.w = cvtpk((bf2f((unsigned short)(w.w & 0xffff)) - mean) * rstd * g1.z, (bf2f((unsigned short)(w.w >> 16)) - mean) * rstd * g1.w);
        vt_write8(Vt + (c32 >> 3) * (64 * VP), VP, c32 & 7, s, o); }
    __syncthreads();
    { const int r = lane & 31, hh = lane >> 5, g = wave >> 1, dt = wave & 1, d = 32 * dt + r;
      const LAS unsigned char* vg = Vt + g * (64 * VP) + d * VP; const int sw = (d >> 3) & 7;
#pragma unroll
      for (int tt = 0; tt < 4; ++tt) { f32x16 acc;
#pragma unroll
          for (int i = 0; i < 16; ++i) acc[i] = 0.f;
          const bf16* wrow = wb + ((size_t)g * 128 + 32 * tt + r) * 128 + 8 * hh;
#pragma unroll
          for (int ks = 0; ks < 2 * (tt + 1); ++ks) { const bf16x8 af = *(const LAS bf16x8*)(vg + (((2 * ks + hh) ^ sw) << 4)); const bf16x8 bfr = *(const bf16x8*)(wrow + 16 * ks); acc = MFMA32(af, bfr, acc); }
          const int t = 32 * tt + r; const size_t row = row0 + t; const float bias = sgu_b[g * 128 + t];
#pragma unroll
          for (int i4 = 0; i4 < 4; ++i4) { const int d0 = 32 * dt + 8 * i4 + 4 * hh;
              const v2u uu = *(const v2u*)(proj + row * NIN + C_BU + g * 64 + d0), gt = *(const v2u*)(proj + row * NIN + C_BG + g * 64 + d0);
              v2u w; w.x = cvtpk((acc[4 * i4] + bias) * bf2f((unsigned short)(uu.x & 0xffff)) * bf2f((unsigned short)(gt.x & 0xffff)), (acc[4 * i4 + 1] + bias) * bf2f((unsigned short)(uu.x >> 16)) * bf2f((unsigned short)(gt.x >> 16)));
              w.y = cvtpk((acc[4 * i4 + 2] + bias) * bf2f((unsigned short)(uu.y & 0xffff)) * bf2f((unsigned short)(gt.y & 0xffff)), (acc[4 * i4 + 3] + bias) * bf2f((unsigned short)(uu.y >> 16)) * bf2f((unsigned short)(gt.y >> 16)));
              *(v2u*)(y + row * DM + 256 + g * 64 + d0) = w; } } }
    __syncthreads();
}
template <int PW>
__device__ __forceinline__ void pool_run(const bf16* src  , LAS unsigned char* dst, int tok  , int AP) {
    v4u x[PW + 7];
#pragma unroll
    for (int q = 0; q < PW + 7; ++q) { const int rel = q - (PW - 1); x[q] = (tok + rel >= 0) ? *(const v4u*)(src + (ptrdiff_t)rel * NIN) : (v4u){0u, 0u, 0u, 0u}; }
    float s[8];
#pragma unroll
    for (int c = 0; c < 8; ++c) s[c] = 0.f;
#define ADDX(q, sg) { s[0] += sg bf2f((unsigned short)(x[q].x & 0xffff)); s[1] += sg bf2f((unsigned short)(x[q].x >> 16)); s[2] += sg bf2f((unsigned short)(x[q].y & 0xffff)); s[3] += sg bf2f((unsigned short)(x[q].y >> 16)); \
                      s[4] += sg bf2f((unsigned short)(x[q].z & 0xffff)); s[5] += sg bf2f((unsigned short)(x[q].z >> 16)); s[6] += sg bf2f((unsigned short)(x[q].w & 0xffff)); s[7] += sg bf2f((unsigned short)(x[q].w >> 16)); }
#pragma unroll
    for (int q = 0; q < PW - 1; ++q) ADDX(q, +)
#pragma unroll
    for (int i = 0; i < 8; ++i) { const int q = PW - 1 + i; ADDX(q, +)
        const int cnt = (tok + i + 1 < PW) ? tok + i + 1 : PW; const float ic = 1.0f / (float)cnt; const v4u w0 = x[q];
        v4u o; o.x = cvtpk(s[0] * ic - bf2f((unsigned short)(w0.x & 0xffff)), s[1] * ic - bf2f((unsigned short)(w0.x >> 16))); o.y = cvtpk(s[2] * ic - bf2f((unsigned short)(w0.y & 0xffff)), s[3] * ic - bf2f((unsigned short)(w0.y >> 16)));
        o.z = cvtpk(s[4] * ic - bf2f((unsigned short)(w0.z & 0xffff)), s[5] * ic - bf2f((unsigned short)(w0.z >> 16))); o.w = cvtpk(s[6] * ic - bf2f((unsigned short)(w0.w & 0xffff)), s[7] * ic - bf2f((unsigned short)(w0.w >> 16)));
        *(LAS v4u*)(dst + i * AP) = o;
        ADDX(i, -) }
#undef ADDX
}
__device__ __forceinline__ void pool_unit(const bf16* proj, bf16* y, const bf16* pwt  , const float* pool_scale, int u, LAS unsigned char* L, int tid) {
    const int lane = tid & 63, wave = tid >> 6;
    constexpr int AP = 528;
    const size_t row0 = (size_t)u * 128; const int tok0 = (u & 31) * 128;
    { const int wu = __builtin_amdgcn_readfirstlane(tid >> 6), g = wu >> 1, c32 = 8 * g + (lane & 7), run = (lane >> 3) + 8 * (wu & 1), t0 = 8 * run;
      const bf16* src = proj + (row0 + t0) * NIN + C_CX + 8 * c32; LAS unsigned char* dst = L + t0 * AP + c32 * 16; const int tk = tok0 + t0;
      if (g == 0) pool_run<2>(src, dst, tk, AP); else if (g == 1) pool_run<4>(src, dst, tk, AP); else if (g == 2) pool_run<8>(src, dst, tk, AP); else pool_run<16>(src, dst, tk, AP); }
    __syncthreads();
    { const int r = lane & 31, hh = lane >> 5, g = wave >> 1, dt = wave & 1;
      bf16x8 af[4];
#pragma unroll
      for (int ks = 0; ks < 4; ++ks) af[ks] = *(const bf16x8*)(pwt + ((size_t)g * 64 + 32 * dt + r) * 64 + 16 * ks + 8 * hh);
#pragma unroll 1
      for (int tt = 0; tt < 4; ++tt) { f32x16 acc;
#pragma unroll
          for (int i = 0; i < 16; ++i) acc[i] = 0.f;
#pragma unroll
          for (int ks = 0; ks < 4; ++ks) { const bf16x8 bfr = *(const LAS bf16x8*)(L + (32 * tt + r) * AP + (g * 64 + 16 * ks + 8 * hh) * 2); acc = MFMA32(af[ks], bfr, acc); }
          const size_t row = row0 + 32 * tt + r;
#pragma unroll
          for (int i4 = 0; i4 < 4; ++i4) { const int d0 = 32 * dt + 8 * i4 + 4 * hh;
              const f32x4 sc = *(const f32x4*)(pool_scale + g * 64 + d0); const v2u gt = *(const v2u*)(proj + row * NIN + C_CG + g * 64 + d0);
              v2u w; w.x = cvtpk(acc[4 * i4] * sc.x * bf2f((unsigned short)(gt.x & 0xffff)), acc[4 * i4 + 1] * sc.y * bf2f((unsigned short)(gt.x >> 16)));
              w.y = cvtpk(acc[4 * i4 + 2] * sc.z * bf2f((unsigned short)(gt.y & 0xffff)), acc[4 * i4 + 3] * sc.w * bf2f((unsigned short)(gt.y >> 16)));
              *(v2u*)(y + row * DM + 512 + g * 64 + d0) = w; } } }
    __syncthreads();
}

#define PHASE_IDS() int tid = threadIdx.x; asm volatile("" : "+v"(tid)); const int lane = tid & 63; const int wave = __builtin_amdgcn_readfirstlane(tid >> 6); const int gw = (int)blockIdx.x * 8 + wave; (void)lane; (void)gw
#define PHASE_PTRS() size_t z0_ = 0; asm volatile("" : "+s"(z0_)); unsigned char* ws = p.ws + z0_;     const float* x = p.in[0]; const float* w_in = p.in[2]; const float* w_out = p.in[9]; \
    const float* PRM = (const float*)(ws + WS_SMALL); bf16* WinT = (bf16*)(ws + WS_WIN); bf16* WoutT = (bf16*)(ws + WS_WOUT); bf16* XB = (bf16*)(ws + WS_XB); bf16* PROJ = (bf16*)(ws + WS_PROJ); \
    bf16* Y = (bf16*)(ws + WS_Y); bf16* Z = (bf16*)(ws + WS_Z); float* KVT = (float*)(ws + WS_KV); bf16* OG = (bf16*)(ws + WS_OG); float* LSE = (float*)(ws + WS_LSE); \
    float* R0P_ = (float*)(ws + WS_R0 + R0_PPART); float* R0Y_ = (float*)(ws + WS_R0 + R0_Y); float* R0Z_ = (float*)(ws + WS_R0 + R0_ZPART); float* R0H_ = (float*)(ws + WS_R0 + R0_H); (void)R0H_; \
    (void)x; (void)w_in; (void)w_out; (void)PRM; (void)WinT; (void)WoutT; (void)XB; (void)PROJ; (void)Y; (void)Z; (void)KVT; (void)OG; (void)LSE; (void)R0P_; (void)R0Y_; (void)R0Z_
template <int l>
__device__ __forceinline__ void layer_body(const Params& p, LAS unsigned char* L, const XcdBarrier& bar) {
    constexpr int G = 256, NGW = G * 8;

        { PHASE_PTRS(); pg8::Gemm g{XB, WinT + (size_t)l * NIN * DM, M, NIN, DM}; pg8::StaticOrder S; S.init(M, NIN, G, (int)blockIdx.x);
          pg8::EpiOut E{PROJ, NIN, (1u << 3) | (1u << 6) | (1u << 8) | (1u << 12)};
          pg8::gemm_phase<pg8::EpiOut, pg8::StaticOrder, true, true>((PG8_LAS unsigned char*)L, g, S, E); }
        { PHASE_IDS(); PHASE_PTRS();
          for (int task = gw; task < 52 * R0_KC; task += NGW) r0_dot_task<1>(R0H_, w_in + (size_t)l * DM * NIN, NIN, R0P_, task, 52, lane); }
        xcd_barrier(bar);
        {
            PHASE_IDS(); PHASE_PTRS();
            if ((int)blockIdx.x >= 248) r0_mix(R0P_, R0Y_, (int)blockIdx.x - 248, PRM + P_SGUG + l * 256, PRM + P_SGUW + (size_t)l * 65536, PRM + P_SGUB + l * 512, PRM + P_RETG + l * 256, (LAS float*)L, tid);
            for (int pr = (int)blockIdx.x; pr < 512; pr += G) retkv_pair(PROJ, KVT, pr, L, tid);
            attn_phase(PROJ, OG, LSE, (int)blockIdx.x, G, 1536, L, tid);
            for (int u = (int)blockIdx.x; u < 256; u += G) sgu_unit(PROJ, Y, PRM + P_SGUG + l * 256, (const bf16*)(ws + WS_SGUWB) + (size_t)l * 65536, PRM + P_SGUB + l * 512, u, L, tid);
            for (int u = (int)blockIdx.x; u < 256; u += G) pool_unit(PROJ, Y, (const bf16*)(ws + WS_PWT) + (size_t)l * 16384, PRM + P_POOLS + l * 256, u, L, tid);
        }
        xcd_barrier(bar);
        { PHASE_IDS(); PHASE_PTRS(); ret_scan(KVT, (bf16*)(ws + WS_PREV), (int)blockIdx.x * 256 + tid - ((tid >= 256) ? 256 - 65536 : 0)); }
        xcd_barrier(bar);
        { PHASE_IDS(); PHASE_PTRS(); for (int pr = (int)blockIdx.x; pr < 512; pr += G) ret_pair(PROJ, (const bf16*)(ws + WS_PREV), PRM + P_RETG + l * 256, Y, pr, L, tid);
          attn_combine(PROJ, OG, LSE, Y, (int)blockIdx.x * 512 + tid, G * 512); }
        xcd_barrier(bar);
        { PHASE_PTRS(); pg8::Gemm g{Y, WoutT + (size_t)l * DM * DM, M, DM, DM}; pg8::StaticOrder S; S.init(M, DM, G, (int)blockIdx.x);
          pg8::EpiOut E{Z, DM, 0u};
          pg8::gemm_phase<pg8::EpiOut, pg8::StaticOrder, true, true>((PG8_LAS unsigned char*)L, g, S, E); }
        { PHASE_IDS(); PHASE_PTRS(); for (int task = gw; task < 16 * R0_KCZ; task += NGW) r0_dot_task<4>(R0Y_, w_out + (size_t)l * DM * DM, DM, R0Z_, task, 16, lane); }
        xcd_barrier(bar);
        { PHASE_IDS(); PHASE_PTRS(); const int NR = M / NGW; float* RS = (float*)(ws + WS_RS); float* R0X = (float*)(ws + WS_RS + 262144);
          f32x4 pg[4];
#pragma unroll
          for (int j = 0; j < 4; ++j) pg[j] = *((const f32x4*)(PRM + P_POSTG + l * DM) + lane + 64 * j);
          v2u zc[4], zn[4]; f32x4 xc[4], xn_[4]; v2u bc[4], bn[4];
          { const int m = gw % NGW;
#pragma unroll
            for (int j = 0; j < 4; ++j) { zc[j] = *((const v2u*)(Z + (size_t)m * DM) + lane + 64 * j);
                if (l == 0) xc[j] = *((const f32x4*)(x + (size_t)m * DM) + lane + 64 * j); else bc[j] = *((const v2u*)(XB + (size_t)m * DM) + lane + 64 * j); } }
#pragma unroll 1
          for (int i = 0; i < NR; ++i) { const int m = i * NGW + (gw + i * 257) % NGW; const bool r0 = (m & (SEQ - 1)) == 0;
              if (i + 1 < NR) { const int mn = (i + 1) * NGW + (gw + (i + 1) * 257) % NGW;
#pragma unroll
                  for (int j = 0; j < 4; ++j) { zn[j] = *((const v2u*)(Z + (size_t)mn * DM) + lane + 64 * j);
                      if (l == 0) xn_[j] = *((const f32x4*)(x + (size_t)mn * DM) + lane + 64 * j); else bn[j] = *((const v2u*)(XB + (size_t)mn * DM) + lane + 64 * j); } }
              f32x4 z[4], xv[4];
              if (r0) r0z_sum(R0Z_ + (size_t)(m >> 12) * DM, lane, z);
              else {
#pragma unroll
                  for (int j = 0; j < 4; ++j) unpack4(zc[j], z[j]); }
              if (l == 0) {
#pragma unroll
                  for (int j = 0; j < 4; ++j) xv[j] = xc[j];
              } else if (r0) {
#pragma unroll
                  for (int j = 0; j < 4; ++j) xv[j] = *((const f32x4*)(R0X + (size_t)(m >> 12) * DM) + lane + 64 * j);
              } else { const float rs = RS[m];
#pragma unroll
                  for (int j = 0; j < 4; ++j) { unpack4(bc[j], xv[j]); xv[j] = xv[j] * rs; } }
              const float rstd = 1.f / sqrtf(wave_sum(ssq4(z)) * (1.f / DM) + EPS);
#pragma unroll
              for (int j = 0; j < 4; ++j) xv[j] = xv[j] + z[j] * rstd * pg[j];
              if (l + 1 < DEPTH) {
                  const float q2 = wave_sum(ssq4(xv)) * (1.f / DM) + EPS; const float r2 = 1.f / sqrtf(q2);
                  v2u* o8 = (v2u*)(XB + (size_t)m * DM) + lane;
#pragma unroll
                  for (int j = 0; j < 4; ++j) { v2u w; w.x = cvtpk(xv[j].x * r2, xv[j].y * r2); w.y = cvtpk(xv[j].z * r2, xv[j].w * r2); o8[64 * j] = w; }
                  if (lane == 0) RS[m] = sqrtf(q2);
                  if (r0) {
#pragma unroll
                      for (int j = 0; j < 4; ++j) { *((f32x4*)(R0X + (size_t)(m >> 12) * DM) + lane + 64 * j) = xv[j];
                          *((f32x4*)(R0H_ + (size_t)(m >> 12) * DM) + lane + 64 * j) = xv[j] * r2 * *((const f32x4*)(PRM + P_PREG + (l + 1 < DEPTH ? l + 1 : 0) * DM) + lane + 64 * j); } }
              } else {
                  f32x4* o = (f32x4*)(p.out + (size_t)m * DM) + lane;
#pragma unroll
                  for (int j = 0; j < 4; ++j) o[64 * j] = xv[j];
              }
#pragma unroll
              for (int j = 0; j < 4; ++j) { zc[j] = zn[j]; xc[j] = xn_[j]; bc[j] = bn[j]; } } }
        if (l + 1 < DEPTH) xcd_barrier(bar);

}

__global__ void __launch_bounds__(512, 2) fwd(Params p) {
    extern __shared__ __attribute__((aligned(16))) unsigned char lds[];
    cg::grid_group grid = cg::this_grid();
    LAS unsigned char* L = (LAS unsigned char*)lds;
    constexpr int G = 256, NGW = G * 8;
    { volatile LAS unsigned* st = (volatile LAS unsigned*)(L + 139264); if (threadIdx.x < 2) st[threadIdx.x] = 0u; }
    __syncthreads();
    const XcdBarrier bar = xcd_barrier_post((unsigned*)(p.ws + WS_CTL), (volatile LAS unsigned*)(L + 139264));
    {
        PHASE_IDS(); PHASE_PTRS();
        { float* prm = (float*)(ws + WS_SMALL);
          for (int i = (int)blockIdx.x * 512 + tid; i < P_END; i += G * 512) { float v;
              if (i < P_SGUG) v = p.in[1][i]; else if (i < P_SGUW) v = p.in[3][i - P_SGUG]; else if (i < P_SGUB) v = p.in[4][i - P_SGUW]; else if (i < P_POOLW) v = p.in[5][i - P_SGUB];
              else if (i < P_POOLS) v = p.in[6][i - P_POOLW]; else if (i < P_RETG) v = p.in[7][i - P_POOLS]; else if (i < P_POSTG) v = p.in[8][i - P_RETG]; else v = p.in[10][i - P_POSTG];
              prm[i] = v; } }
        { bf16* sw = (bf16*)(ws + WS_SGUWB); bf16* pw = (bf16*)(ws + WS_PWT);
          for (int i = (int)blockIdx.x * 512 + tid; i < 2 * 65536; i += G * 512) { const int s = i & 127, t = (i >> 7) & 127; sw[i] = (s <= t) ? (bf16)f2bf(p.in[4][i]) : (bf16)0; }
          for (int i = (int)blockIdx.x * 512 + tid; i < 2 * 16384; i += G * 512) { const int c = i & 63, d = (i >> 6) & 63, lg = i >> 12; pw[i] = (bf16)f2bf(p.in[6][(size_t)lg * 4096 + c * 64 + d]); } }
        LAS float* scr = (LAS float*)(L + wave * 16384);
        constexpr int I_IN = (DM / 64) * (NIN / 32), I_OUT = (DM / 64) * (DM / 32), I_L = I_IN + I_OUT;
        for (int it = gw; it < DEPTH * I_L; it += NGW) { const int l = it / I_L; int r = it % I_L;
            if (r < I_IN) p0_transpose_item(w_in + (size_t)l * DM * NIN, DM, NIN, WinT + (size_t)l * NIN * DM, p.in[1] + l * DM, 1, scr, r, lane);
            else p0_transpose_item(w_out + (size_t)l * DM * DM, DM, DM, WoutT + (size_t)l * DM * DM, nullptr, 0, scr, r - I_IN, lane); }
        { const int NR = M / NGW; f32x4 cur[4], nxt[4];
          { const int m = gw % NGW;
#pragma unroll
            for (int j = 0; j < 4; ++j) cur[j] = *((const f32x4*)(x + (size_t)m * DM) + lane + 64 * j); }
#pragma unroll 1
          for (int i = 0; i < NR; ++i) { const int m = i * NGW + (gw + i * 257) % NGW;
              if (i + 1 < NR) { const int mn = (i + 1) * NGW + (gw + (i + 1) * 257) % NGW;
#pragma unroll
                  for (int j = 0; j < 4; ++j) nxt[j] = *((const f32x4*)(x + (size_t)mn * DM) + lane + 64 * j); }
              const float rstd = 1.f / sqrtf(wave_sum(ssq4(cur)) * (1.f / DM) + EPS);
              v2u* o8 = (v2u*)(XB + (size_t)m * DM) + lane;
#pragma unroll
              for (int j = 0; j < 4; ++j) { v2u w; w.x = cvtpk(cur[j].x * rstd, cur[j].y * rstd); w.y = cvtpk(cur[j].z * rstd, cur[j].w * rstd); o8[64 * j] = w; }
              if ((m & (SEQ - 1)) == 0) {
#pragma unroll
                  for (int j = 0; j < 4; ++j) *((f32x4*)(R0H_ + (size_t)(m >> 12) * DM) + lane + 64 * j) = cur[j] * rstd * *((const f32x4*)p.in[1] + lane + 64 * j); }
#pragma unroll
              for (int j = 0; j < 4; ++j) cur[j] = nxt[j]; } }
    }
    if (p.ws == nullptr) grid.sync();
    xcd_barrier(bar);
    layer_body<0>(p, L, bar);
    layer_body<1>(p, L, bar);
}

extern "C" void kernel_launch(void* const* d_in, const int* in_sizes, int n_in, void* d_out, int out_size, void* d_ws, size_t ws_size, hipStream_t stream) {
    static int grid = 0;
    if (grid == 0) {
        if (n_in != 11 || in_sizes[0] != M * DM || out_size != M * DM || ws_size < WS_END) { fprintf(stderr, "kernel_launch: unexpected shapes (n_in %d, in0 %d, out %d, ws %zu)\n", n_in, n_in > 0 ? in_sizes[0] : -1, out_size, ws_size); grid = -1; return; }
        int dev = 0, cus = 0, per_cu = 0;
        hipGetDevice(&dev); hipDeviceGetAttribute(&cus, hipDeviceAttributeMultiprocessorCount, dev);
        if (hipFuncSetAttribute((const void*)fwd, hipFuncAttributeMaxDynamicSharedMemorySize, LDS_BYTES) != hipSuccess) { fprintf(stderr, "kernel_launch: hipFuncSetAttribute failed\n"); grid = -1; return; }
        if (hipOccupancyMaxActiveBlocksPerMultiprocessor(&per_cu, (const void*)fwd, 512, LDS_BYTES) != hipSuccess || per_cu < 1) { fprintf(stderr, "kernel_launch: occupancy query says %d\n", per_cu); per_cu = 1; }
        (void)hipGetLastError();
        grid = 256;
        if (cus != 256) fprintf(stderr, "kernel_launch: built for a 256-CU device, found %d CUs\n", cus);
        fprintf(stderr, "kernel_launch: cus %d per_cu %d grid %d\n", cus, per_cu, grid);
    }
    if (grid < 0) return;
    if (hipMemsetAsync((char*)d_ws + WS_CTL, 0, 65536, stream) != hipSuccess) { fprintf(stderr, "kernel_launch: memset failed\n"); return; }
    Params p{};
    for (int i = 0; i < 11; ++i) p.in[i] = (const float*)d_in[i];
    p.out = (float*)d_out; p.ws = (unsigned char*)d_ws;
    void* args[] = {&p};
    hipError_t e = hipLaunchCooperativeKernel((const void*)fwd, dim3(grid), dim3(512), args, LDS_BYTES, stream);
    if (e != hipSuccess) fprintf(stderr, "kernel_launch: cooperative launch failed: %s (grid %d)\n", hipGetErrorString(e), grid);
}
```

```cpp
#include <hip/hip_runtime.h>
#include <hip/hip_cooperative_groups.h>
#include <cstdio>
#include <cstdint>
namespace cg = cooperative_groups;
namespace pg8 {
#define PG8_LAS __attribute__((address_space(3)))
typedef unsigned short bf16_t;
typedef short bf16x8 __attribute__((ext_vector_type(8)));
typedef float f32x4 __attribute__((ext_vector_type(4)));
typedef unsigned u32x4 __attribute__((ext_vector_type(4)));
constexpr int BM = 256, BK = 64, HALF = 128, HTB = HALF * BK * 2  , STAGE_BYTES = 8 * HTB, NXCD = 8, WGM = 4;

__host__ __device__ __forceinline__ int lds_byte(int r, int c) { const int st = (r >> 4) * 2 + (c >> 5), rr = r & 15, cc = c & 31, ob = rr * 64 + cc * 2; return st * 1024 + (ob ^ (((ob >> 9) & 1) << 5)); }
__host__ __device__ __forceinline__ void stage_rc(int b, int& R, int& C) { const int st = b / 1024, sb = b % 1024, swz = sb ^ (((sb >> 9) & 1) << 5); R = (st >> 1) * 16 + swz / 64; C = (st & 1) * 32 + (swz % 64) / 2; }
__host__ __device__ __forceinline__ int perm32(int rho) { const int n = rho >> 4, i = rho & 15; return 8 * (i >> 2) + 4 * n + (i & 3); }

struct Unit { int pm, pn; };
struct Gemm { const bf16_t* A; const bf16_t* Bt; int M, N, K; };

struct StaticOrder {
    int nM, nN, nwg, G, c;
    __host__ __device__ void init(int M, int N, int G_, int c_) { nM = M / BM; nN = N / BM; nwg = nM * nN; G = G_; c = c_; }
    __host__ __device__ bool next(int i, Unit& u) const {
        const long L = (long)i * G + c; if (L >= nwg) return false;
        int wgid = (int)L; { const int q = nwg / NXCD, r = nwg % NXCD, xcd = wgid % NXCD, off = wgid / NXCD; wgid = (xcd < r ? xcd * (q + 1) : r * (q + 1) + (xcd - r) * q) + off; }
        const int nig = WGM * nN, gid = wgid / nig, fm = gid * WGM, gsz = (nM - fm) < WGM ? (nM - fm) : WGM;
        u.pm = fm + ((wgid % nig) % gsz); u.pn = (wgid % nig) / gsz; return true;
    }
    __device__ __forceinline__ void a_ready(const Unit&) const {}
    __device__ __forceinline__ void done(const Unit&) const {}
};

__device__ __forceinline__ unsigned cvt_pk_bf16(float lo, float hi) { unsigned r; asm volatile("v_cvt_pk_bf16_f32 %0, %1, %2" : "=v"(r) : "v"(lo), "v"(hi)); return r; }
__device__ __forceinline__ float silu_f(float x) { return x / (1.0f + __expf(-x)); }
__device__ __forceinline__ float silu_fast(float x) { return x * __builtin_amdgcn_rcpf(1.0f + __builtin_amdgcn_exp2f(x * -1.4426950408889634f)); }
struct EpiOut {
    static constexpr bool PERM = true, AFTER_DRAIN = false;
    bf16_t* O; int ldc; unsigned gate_mask;
    __device__ __forceinline__ void operator()(const f32x4 (&acc)[2][2][4][2], const Unit& u, int wr, int wc, int fr, int fq) const {
        const int row0 = u.pm * BM + wr * 64 + fr; const int col0 = u.pn * BM + wc * 32 + 8 * fq;
        const bool gate = (gate_mask >> u.pn) & 1u;
#pragma unroll
        for (int ai = 0; ai < 2; ++ai)
#pragma unroll
            for (int m = 0; m < 4; ++m) { bf16_t* rowp = O + (size_t)(row0 + ai * HALF + m * 16) * ldc + col0;
#pragma unroll
                for (int bj = 0; bj < 2; ++bj) { f32x4 v0 = acc[ai][bj][m][0], v1 = acc[ai][bj][m][1];
                    if (gate) { v0 = (f32x4){silu_fast(v0[0]), silu_fast(v0[1]), silu_fast(v0[2]), silu_fast(v0[3])}; v1 = (f32x4){silu_fast(v1[0]), silu_fast(v1[1]), silu_fast(v1[2]), silu_fast(v1[3])}; }
                    u32x4 w; w.x = cvt_pk_bf16(v0[0], v0[1]); w.y = cvt_pk_bf16(v0[2], v0[3]); w.z = cvt_pk_bf16(v1[0], v1[1]); w.w = cvt_pk_bf16(v1[2], v1[3]);
                    *(u32x4*)(rowp + bj * HALF) = w; } }
    }
};
template <class Epi, class Sched, bool ALIGN_EPI = false, bool SP2 = false>
__device__ __forceinline__ void gemm_phase(PG8_LAS unsigned char* lds, const Gemm g, const Sched& S, const Epi& E) {
    int tid_ = threadIdx.x; asm volatile("" : "+v"(tid_));
    const int tid = tid_, wid = __builtin_amdgcn_readfirstlane(tid >> 6), lane = tid & 63, wr = wid >> 2, wc = wid & 3, fr = lane & 15, fq = lane >> 4;
    const int K = g.K, nt = K / BK;
    unsigned voffA[2], voffB[2];
#pragma unroll
    for (int i = 0; i < 2; ++i) { int R, C; stage_rc(tid * 16 + i * 8192, R, C); const int Rb = Epi::PERM ? ((R & ~31) + perm32(R & 31)) : R;
        voffA[i] = (unsigned)(R * K + C) * 2u; voffB[i] = (unsigned)(Rb * K + C) * 2u; }
    const size_t kstep = (size_t)(BK * 2);
    const size_t hstep = (size_t)HALF * K * 2;
    const size_t tstep = 2 * hstep;
    const unsigned ldsw = (unsigned)wid * 1024u;
    const int aoff = lds_byte(wr * 64 + fr, fq * 8), boff = lds_byte(wc * 32 + fr, fq * 8);
#define PG8_SA(b, h) (((b) * 2 + (h)) * HTB)
#define PG8_SB(b, h) ((4 + (b) * 2 + (h)) * HTB)
#define PG8_STAGE(bufoff, gbase, voff) do { _Pragma("unroll") for (int _i = 0; _i < 2; ++_i) \
        __builtin_amdgcn_global_load_lds((const unsigned*)((const char*)(gbase) + (voff)[_i]), (PG8_LAS unsigned*)(lds + (bufoff) + ldsw + _i * 8192), 16, 0, 0); } while (0)
#define PG8_LDA(dst, b, h) do { _Pragma("unroll") for (int m = 0; m < 4; ++m) _Pragma("unroll") for (int k = 0; k < 2; ++k) dst[m][k] = *(const PG8_LAS bf16x8*)(lds + PG8_SA(b, h) + aoff + m * 2048 + k * 1024); } while (0)
#define PG8_LDB(dst, b, h) do { _Pragma("unroll") for (int n = 0; n < 2; ++n) _Pragma("unroll") for (int k = 0; k < 2; ++k) dst[n][k] = *(const PG8_LAS bf16x8*)(lds + PG8_SB(b, h) + boff + n * 2048 + k * 1024); } while (0)
#define PG8_MMA(ai, bj, At, Bt) do { __builtin_amdgcn_s_setprio(1); _Pragma("unroll") for (int m = 0; m < 4; ++m) _Pragma("unroll") for (int n = 0; n < 2; ++n) _Pragma("unroll") for (int k = 0; k < 2; ++k) \
        acc[ai][bj][m][n] = __builtin_amdgcn_mfma_f32_16x16x32_bf16(Bt[n][k], At[m][k], acc[ai][bj][m][n], 0, 0, 0); __builtin_amdgcn_s_setprio(0); } while (0)
#define PG8_WAIT_V(n) asm volatile("s_waitcnt vmcnt(" #n ")" ::: "memory")
#define PG8_WAIT_L(n) asm volatile("s_waitcnt lgkmcnt(" #n ")" ::: "memory")
#define PG8_BAR __builtin_amdgcn_s_barrier()
#define PG8_SCHED __builtin_amdgcn_sched_barrier(0)
    Unit cur, nxt; int ui = 0;
    if (!S.next(0, cur)) return;
    f32x4 acc[2][2][4][2];
#pragma unroll
    for (int a = 0; a < 2; ++a)
#pragma unroll
        for (int b = 0; b < 2; ++b)
#pragma unroll
            for (int m = 0; m < 4; ++m)
#pragma unroll
                for (int n = 0; n < 2; ++n) acc[a][b][m][n] = (f32x4){0.f, 0.f, 0.f, 0.f};
    bf16x8 At[4][2], B0[2][2], B1[2][2];
    const char* cA = (const char*)g.A + (size_t)cur.pm * tstep; const char* cB = (const char*)g.Bt + (size_t)cur.pn * tstep;
    S.a_ready(cur);
    if constexpr (SP2) {
        PG8_STAGE(PG8_SB(0, 0), cB, voffB); PG8_STAGE(PG8_SB(0, 1), cB + hstep, voffB); PG8_STAGE(PG8_SA(0, 0), cA, voffA); PG8_STAGE(PG8_SA(0, 1), cA + hstep, voffA);
        if (wr == 1) PG8_BAR;
        PG8_WAIT_V(2); PG8_BAR;
        PG8_STAGE(PG8_SB(1, 0), cB + kstep, voffB); PG8_STAGE(PG8_SA(1, 0), cA + kstep, voffA); PG8_STAGE(PG8_SB(1, 1), cB + hstep + kstep, voffB);
        PG8_WAIT_V(6); PG8_BAR;
    } else {
        PG8_STAGE(PG8_SB(0, 0), cB, voffB); PG8_STAGE(PG8_SA(0, 0), cA, voffA); PG8_STAGE(PG8_SB(0, 1), cB + hstep, voffB); PG8_STAGE(PG8_SA(0, 1), cA + hstep, voffA);
        if (wr == 1) PG8_BAR;
        PG8_WAIT_V(4); PG8_BAR;
        PG8_STAGE(PG8_SB(1, 0), cB + kstep, voffB); PG8_STAGE(PG8_SA(1, 0), cA + kstep, voffA); PG8_STAGE(PG8_SB(1, 1), cB + hstep + kstep, voffB);
        PG8_WAIT_V(6); PG8_BAR;
    }
    for (;;) {
        const bool has_next = S.next(ui + 1, nxt);
        const char* nA = has_next ? (const char*)g.A + (size_t)nxt.pm * tstep : cA; const char* nB = has_next ? (const char*)g.Bt + (size_t)nxt.pn * tstep : cB;
        for (int t = 0; t < nt; t += 2) {
            const bool last = (t == nt - 2);
            const char* a1 = cA + (size_t)(t + 1) * kstep;
            const char* a2 = last ? nA : cA + (size_t)(t + 2) * kstep; const char* b2 = last ? nB : cB + (size_t)(t + 2) * kstep;
            const char* a3 = a2 + kstep; const char* b3 = b2 + kstep;
            if (last && has_next) S.a_ready(nxt);
            if constexpr (SP2) {
            PG8_LDB(B0, 0, 0); PG8_LDB(B1, 0, 1); PG8_SCHED; PG8_LDA(At, 0, 0); PG8_STAGE(PG8_SA(1, 1), a1 + hstep, voffA);
            PG8_WAIT_V(8); PG8_WAIT_L(0); PG8_BAR; PG8_MMA(0, 0, At, B0); PG8_MMA(0, 1, At, B1); PG8_BAR; PG8_SCHED;
            PG8_LDA(At, 0, 1); PG8_STAGE(PG8_SB(0, 0), b2, voffB); PG8_STAGE(PG8_SB(0, 1), b2 + hstep, voffB); PG8_STAGE(PG8_SA(0, 0), a2, voffA);
            PG8_WAIT_V(8); PG8_WAIT_L(0); PG8_BAR; PG8_MMA(1, 0, At, B0); PG8_MMA(1, 1, At, B1); PG8_BAR; PG8_SCHED;
            PG8_LDB(B0, 1, 0); PG8_LDB(B1, 1, 1); PG8_SCHED; PG8_LDA(At, 1, 0); PG8_STAGE(PG8_SA(0, 1), a2 + hstep, voffA);
            PG8_WAIT_V(8); PG8_WAIT_L(0); PG8_BAR; PG8_MMA(0, 0, At, B0); PG8_MMA(0, 1, At, B1); PG8_BAR; PG8_SCHED;
            PG8_LDA(At, 1, 1); PG8_STAGE(PG8_SB(1, 0), b3, voffB); PG8_STAGE(PG8_SB(1, 1), b3 + hstep, voffB); PG8_STAGE(PG8_SA(1, 0), a3, voffA);
            PG8_WAIT_V(8); PG8_WAIT_L(0); PG8_BAR; PG8_MMA(1, 0, At, B0); PG8_MMA(1, 1, At, B1); PG8_BAR; PG8_SCHED;
            } else {
            PG8_LDB(B0, 0, 0); PG8_SCHED; PG8_LDA(At, 0, 0); PG8_STAGE(PG8_SA(1, 1), a1 + hstep, voffA);
            PG8_WAIT_L(8); PG8_BAR; PG8_WAIT_L(0); PG8_MMA(0, 0, At, B0); PG8_BAR; PG8_SCHED;
            PG8_LDB(B1, 0, 1); PG8_STAGE(PG8_SB(0, 0), b2, voffB);
            PG8_BAR; PG8_WAIT_L(0); PG8_MMA(0, 1, At, B1); PG8_BAR;
            PG8_LDA(At, 0, 1); PG8_STAGE(PG8_SA(0, 0), a2, voffA);
            PG8_BAR; PG8_WAIT_L(0); PG8_MMA(1, 0, At, B0); PG8_BAR; PG8_SCHED;
            PG8_STAGE(PG8_SB(0, 1), b2 + hstep, voffB);
            PG8_WAIT_V(6); PG8_BAR; PG8_MMA(1, 1, At, B1); PG8_BAR;
            PG8_LDB(B0, 1, 0); PG8_SCHED; PG8_LDA(At, 1, 0); PG8_STAGE(PG8_SA(0, 1), a2 + hstep, voffA);
            PG8_WAIT_L(8); PG8_BAR; PG8_WAIT_L(0); PG8_MMA(0, 0, At, B0); PG8_BAR; PG8_SCHED;
            PG8_LDB(B1, 1, 1); PG8_STAGE(PG8_SB(1, 0), b3, voffB);
            PG8_BAR; PG8_WAIT_L(0); PG8_MMA(0, 1, At, B1); PG8_BAR;
            PG8_LDA(At, 1, 1); PG8_STAGE(PG8_SA(1, 0), a3, voffA);
            PG8_BAR; PG8_WAIT_L(0); PG8_MMA(1, 0, At, B0); PG8_BAR; PG8_SCHED;
            PG8_STAGE(PG8_SB(1, 1), b3 + hstep, voffB);
            PG8_WAIT_V(6); PG8_BAR; PG8_MMA(1, 1, At, B1); PG8_BAR;
            }
        }
        if constexpr (ALIGN_EPI) { if (wr == 0) PG8_BAR; }
        if constexpr (!Epi::AFTER_DRAIN) { E(acc, cur, wr, wc, fr, fq); S.done(cur); }
        if (!has_next) break;
#pragma unroll
        for (int a = 0; a < 2; ++a)
#pragma unroll
            for (int b = 0; b < 2; ++b)
#pragma unroll
                for (int m = 0; m < 4; ++m)
#pragma unroll
                    for (int n = 0; n < 2; ++n) acc[a][b][m][n] = (f32x4){0.f, 0.f, 0.f, 0.f};
        cur = nxt; cA = nA; cB = nB; ++ui;
        if constexpr (ALIGN_EPI) { if (wr == 1) PG8_BAR; }
    }
    PG8_WAIT_V(0);
    if constexpr (!ALIGN_EPI) { if (wr == 0) PG8_BAR; }
    PG8_BAR;
    if constexpr (Epi::AFTER_DRAIN) { E.fused(acc, cur, wr, wc, fr, fq, lds, wid, lane); S.done(cur); }
#undef PG8_SA
#undef PG8_SB
#undef PG8_STAGE
#undef PG8_LDA
#undef PG8_LDB
#undef PG8_MMA
#undef PG8_WAIT_V
#undef PG8_WAIT_L
#undef PG8_BAR
#undef PG8_SCHED
}
}
#define LAS __attribute__((address_space(3)))
typedef unsigned short bf16;
typedef unsigned v4u __attribute__((ext_vector_type(4)));
typedef unsigned v2u __attribute__((ext_vector_type(2)));
typedef float f32x4 __attribute__((ext_vector_type(4)));
constexpr int SEQ = 4096, BATCH = 8, DM = 1024, M = BATCH * SEQ, NIN = 3328, DEPTH = 2;
constexpr float EPS = 1e-6f;
constexpr float LOG2E = 1.4426950408889634f;
constexpr float QSCALE = 0.125f * LOG2E;
constexpr int C_AQ = 0, C_AK = 256, C_AV = 512, C_AG = 768, C_BU = 1024, C_BV = 1280, C_BG = 1536, C_CX = 1792, C_CG = 2048, C_DQ = 2304, C_DK = 2560, C_DV = 2816, C_DG = 3072;
constexpr size_t MiB = 1u << 20;
constexpr size_t WS_WIN = 0, WS_WOUT = 13 * MiB, WS_SMALL = 17 * MiB, WS_XB = 18 * MiB, WS_PROJ = 82 * MiB, WS_Y = 290 * MiB, WS_Z = 354 * MiB, WS_OG = 418 * MiB, WS_LSE = 466 * MiB, WS_KV = 468 * MiB, WS_R0 = 484 * MiB, WS_CTL = 490 * MiB, WS_PREV = 491 * MiB, WS_RS = 499 * MiB, WS_END = 500 * MiB;
constexpr size_t R0_PPART = 0, R0_Y = 4 * MiB, R0_H = R0_Y + 65536, R0_ZPART = 5 * MiB;
constexpr int R0_KC = 16, R0_KCZ = 8;
constexpr int LDS_BYTES = 147456;
constexpr size_t WS_SGUWB = WS_SMALL + 704 * 1024, WS_PWT = WS_SMALL + 960 * 1024;
constexpr int P_PREG = 0, P_SGUG = 2048, P_SGUW = 2560, P_SGUB = 133632, P_POOLW = 134656, P_POOLS = 167424, P_RETG = 167936, P_POSTG = 168448, P_END = 170496;

__device__ __forceinline__ float bf2f(unsigned short u) { return __uint_as_float(((unsigned)u) << 16); }
__device__ __forceinline__ unsigned f2bf(float f) { unsigned u = __float_as_uint(f); return (u + 0x7fffu + ((u >> 16) & 1u)) >> 16; }
__device__ __forceinline__ unsigned pk2(float lo, float hi) { return f2bf(lo) | (f2bf(hi) << 16); }
__device__ __forceinline__ float rdl_(float v, int l) { return __int_as_float(__builtin_amdgcn_readlane(__float_as_int(v), l)); }
#define DPP_ADD(v, ctrl) ((v) + __int_as_float(__builtin_amdgcn_update_dpp(0, __float_as_int(v), (ctrl), 0xF, 0xF, true)))
__device__ __forceinline__ float wave_sum(float v) {
    v = DPP_ADD(v, 0xB1);
    v = DPP_ADD(v, 0x4E);
    v = DPP_ADD(v, 0x141);
    v = DPP_ADD(v, 0x140);
    return (rdl_(v, 0) + rdl_(v, 16)) + (rdl_(v, 32) + rdl_(v, 48));
}
#define LDS_WAIT() asm volatile("s_waitcnt lgkmcnt(0)" ::: "memory")

struct Params { const float* in[11]; float* out; unsigned char* ws; };

__device__ __forceinline__ void p0_transpose_item(const float* W, int K, int N, bf16* WT, const float* rs, int col_mode, LAS float* scr, int item, int lane) {
    const int nblk = N / 32, kb = item / nblk, nb = item % nblk, k0 = 64 * kb, n0 = 32 * nb;
    float cs = 1.f;
    if (col_mode) { const int n = n0 + (lane & 31); if (n < 256) cs = QSCALE; else if (n >= C_DK && n < C_DK + 256) cs = 0.125f; }
#pragma unroll
    for (int i = 0; i < 32; ++i) { const int kk = 2 * i + (lane >> 5); float v = W[(size_t)(k0 + kk) * N + n0 + (lane & 31)] * cs; if (rs) v *= rs[k0 + kk]; scr[kk * 33 + (lane & 31)] = v; }
    LDS_WAIT(); asm volatile("" ::: "memory");
    const int c = lane & 7;
#pragma unroll
    for (int j = 0; j < 4; ++j) { const int n = (lane >> 3) + 8 * j; const LAS float* s = scr + (8 * c) * 33 + n;
        v4u o; o.x = pk2(s[0 * 33], s[1 * 33]); o.y = pk2(s[2 * 33], s[3 * 33]); o.z = pk2(s[4 * 33], s[5 * 33]); o.w = pk2(s[6 * 33], s[7 * 33]);
        *(v4u*)(WT + (size_t)(n0 + n) * K + k0 + 8 * c) = o; }
    LDS_WAIT(); asm volatile("" ::: "memory");
}

__device__ __forceinline__ void unpack4(const v2u w, f32x4& o) { o = (f32x4){bf2f((unsigned short)(w.x & 0xffff)), bf2f((unsigned short)(w.x >> 16)), bf2f((unsigned short)(w.y & 0xffff)), bf2f((unsigned short)(w.y >> 16))}; }
__device__ __forceinline__ float ssq4(const f32x4 (&v)[4]) { float s = 0.f;
#pragma unroll
    for (int j = 0; j < 4; ++j) s += (v[j].x * v[j].x + v[j].y * v[j].y) + (v[j].z * v[j].z + v[j].w * v[j].w);
    return s; }
__device__ __forceinline__ void r0z_sum(const float* r0z, int lane, f32x4 (&z)[4]) {
#pragma unroll
    for (int j = 0; j < 4; ++j) { asm volatile("" ::: "memory"); f32x4 a = (f32x4){0.f, 0.f, 0.f, 0.f};
#pragma unroll
        for (int kc = 0; kc < R0_KCZ; ++kc) a += *((const f32x4*)(r0z + (size_t)kc * 8 * DM) + lane + 64 * j);
        z[j] = a; }
}

__device__ __forceinline__ float rdl(float v, int l) { return __int_as_float(__builtin_amdgcn_readlane(__float_as_int(v), l)); }
template <int NB  >
__device__ __forceinline__ void r0_dot_task(const float* h, const float* W, int N, float* part, int task, int nchunks, int lane) {
    const int ch = task % nchunks, kc = task / nchunks, n0 = ch * 64;
    float acc[8];
#pragma unroll
    for (int b = 0; b < 8; ++b) acc[b] = 0.f;
#pragma unroll 1
    for (int sb = 0; sb < NB; ++sb) { const int k0 = (kc * NB + sb) * 32;
        float hv[4], w[32];
#pragma unroll
        for (int i = 0; i < 4; ++i) { const int idx = lane + 64 * i; hv[i] = h[(idx >> 5) * DM + k0 + (idx & 31)]; }
#pragma unroll
        for (int kk = 0; kk < 32; ++kk) w[kk] = W[(size_t)(k0 + kk) * N + n0 + lane];
#pragma unroll
        for (int kk = 0; kk < 32; ++kk)
#pragma unroll
            for (int b = 0; b < 8; ++b) acc[b] += rdl(hv[b >> 1], (b & 1) * 32 + kk) * w[kk]; }
#pragma unroll
    for (int b = 0; b < 8; ++b) part[((size_t)kc * 8 + b) * N + n0 + lane] = acc[b];
}
__device__ __forceinline__ void r0_dot_sub(const float* h, const float* W, int N, int task, int nchunks, int sb, int lane, float (&acc)[8]) {
    const int ch = task % nchunks, kc = task / nchunks, n0 = ch * 64; const int k0 = (kc * 4 + sb) * 32;
    float hv[4], w[32];
#pragma unroll
    for (int i = 0; i < 4; ++i) { const int idx = lane + 64 * i; hv[i] = h[(idx >> 5) * DM + k0 + (idx & 31)]; }
#pragma unroll
    for (int kk = 0; kk < 32; ++kk) w[kk] = W[(size_t)(k0 + kk) * N + n0 + lane];
#pragma unroll
    for (int b = 0; b < 8; ++b) acc[b] = 0.f;
#pragma unroll
    for (int kk = 0; kk < 32; ++kk)
#pragma unroll
        for (int b = 0; b < 8; ++b) acc[b] += rdl(hv[b >> 1], (b & 1) * 32 + kk) * w[kk];
}
using pg8::silu_f;
__device__ __forceinline__ void r0_mix(const float* ppart, float* y0, int b, const float* sgu_g, const float* sgu_w, const float* sgu_b, const float* ret_g, LAS float* P, int tid) {
#pragma unroll 2
    for (int n = tid; n < NIN; n += 512) { float a = 0.f;
#pragma unroll
        for (int kc = 0; kc < R0_KC; ++kc) a += ppart[((size_t)kc * 8 + b) * NIN + n];
        P[n] = a; }
    __syncthreads();
    if (tid < 256) { const int lane = tid & 63;
        float sm = 0.f;
#pragma unroll
        for (int i = 0; i < 4; ++i) sm += P[C_BV + lane + 64 * i];
        const float mean = wave_sum(sm) * (1.f / 256.f); float sq = 0.f;
#pragma unroll
        for (int i = 0; i < 4; ++i) { const float d = P[C_BV + lane + 64 * i] - mean; sq += d * d; }
        const float rstd = 1.f / sqrtf(wave_sum(sq) * (1.f / 256.f) + EPS);
        { const int i = tid >> 6; const int c = lane + 64 * i;
            y0[b * DM + c] = P[C_AV + c] * silu_f(P[C_AG + c]);
            const float mixed = sgu_w[(size_t)i * 16384] * ((P[C_BV + c] - mean) * rstd * sgu_g[c]) + sgu_b[i * 128];
            y0[b * DM + 256 + c] = P[C_BU + c] * mixed * silu_f(P[C_BG + c]);
            y0[b * DM + 512 + c] = 0.f;
            const float cc = wave_sum(P[C_DQ + c] * P[C_DK + c]) * 0.125f; const float of = cc * P[C_DV + c];
            const float mu = wave_sum(of) * (1.f / 64.f); const float d0 = of - mu; const float var = wave_sum(d0 * d0) * (1.f / 64.f);
            y0[b * DM + 768 + c] = d0 / sqrtf(var + EPS) * ret_g[c] * silu_f(P[C_DG + c]); } }
    __syncthreads();
}

#define XB_TMO      128
#define XB_XCNT(j)  (256  + 64 * (j))
#define XB_XSUB(j)  (1280 + 64 * (j))
#define XB_XGEN(j)  (2304 + 64 * (j))
#define XB_TOP      3328
#define XB_TOPGEN   3392
#define XCD_BAR_WORDS 3456
#define XB_SPIN_CAP (1u << 18)

__device__ __forceinline__ unsigned xb_ld(unsigned* p)              { return __hip_atomic_load(p, __ATOMIC_RELAXED, __HIP_MEMORY_SCOPE_AGENT); }
__device__ __forceinline__ unsigned xb_add(unsigned* p, unsigned v) { return __hip_atomic_fetch_add(p, v, __ATOMIC_RELAXED, __HIP_MEMORY_SCOPE_AGENT); }
__device__ __forceinline__ unsigned xb_xcc_id() { return (unsigned)__builtin_amdgcn_s_getreg((3 << 11) | 20) & 0xFu; }
#define XB_SPIN(cond, bar) do { unsigned _sp = 0; while (cond) { \
    if ((++_sp & 255u) == 0u) { if (xb_ld(&(bar)[XB_TMO])) break; if (_sp > XB_SPIN_CAP) { atomicAdd(&(bar)[XB_TMO], 1u); break; } } } } while (0)

struct XcdBarrier {
    unsigned* bar; unsigned x;
    volatile LAS unsigned* st;
};

__device__ __forceinline__ XcdBarrier xcd_barrier_post(unsigned* bar, volatile LAS unsigned* st) {
    XcdBarrier b; b.bar = bar; b.x = xb_xcc_id(); b.st = st;
    if (threadIdx.x == 0) (void)xb_add(&bar[XB_XCNT(b.x)], 1u);
    return b;
}
__device__ __forceinline__ void xcd_barrier_complete(unsigned* bar, unsigned x, unsigned& nloc, unsigned& nx) {
    const unsigned G = gridDim.x * gridDim.y * gridDim.z;
    unsigned sum, cnt, mine, sp = 0u;
    for (;;) {
        sum = 0u; cnt = 0u; mine = 0u;
#pragma unroll
        for (unsigned j = 0; j < 16; ++j) { const unsigned c = xb_ld(&bar[XB_XCNT(j)]); sum += c; cnt += (c > 0u) ? 1u : 0u; mine = (j == x) ? c : mine; }
        if (sum == G) break;
        __builtin_amdgcn_s_sleep(1);
        if ((++sp & 255u) == 0u) { if (xb_ld(&bar[XB_TMO])) break; if (sp > XB_SPIN_CAP) { atomicAdd(&bar[XB_TMO], 1u); break; } }
    }
    nloc = mine > 0u ? mine : 1u; nx = cnt > 0u ? cnt : 1u;
}

__device__ __forceinline__ void xcd_barrier(const XcdBarrier& b) {
    asm volatile("s_waitcnt vmcnt(0)" ::: "memory");
    __syncthreads();
    if (threadIdx.x == 0) {
        size_t z0_ = 0; asm volatile("" : "+s"(z0_)); unsigned* bar = b.bar + z0_;
        const unsigned bx = xb_xcc_id();
        __builtin_amdgcn_s_waitcnt(0);
        unsigned nloc = b.st[0], nx = b.st[1];
        if (nloc == 0u) { xcd_barrier_complete(bar, bx, nloc, nx); b.st[0] = nloc; b.st[1] = nx; }
        const unsigned old = xb_add(&bar[XB_XSUB(bx)], 1u);
        const unsigned gen = old / nloc;
        if (old + 1u == (gen + 1u) * nloc) {
            __builtin_amdgcn_fence(__ATOMIC_RELEASE, "agent");
            asm volatile("s_waitcnt vmcnt(0)" ::: "memory");
            const unsigned og = xb_add(&bar[XB_TOP], 1u);
            const unsigned tg = og / nx;
            if (og + 1u == (tg + 1u) * nx) xb_add(&bar[XB_TOPGEN], 1u);
            else XB_SPIN(xb_ld(&bar[XB_TOPGEN]) == tg, bar);
            __builtin_amdgcn_fence(__ATOMIC_ACQUIRE, "agent");
            xb_add(&bar[XB_XGEN(bx)], 1u);
            asm volatile("s_waitcnt vmcnt(0)" ::: "memory");
        } else {
            XB_SPIN(xb_ld(&bar[XB_XGEN(bx)]) == gen, bar);
            __builtin_amdgcn_fence(__ATOMIC_ACQUIRE, "agent");
            asm volatile("s_waitcnt vmcnt(0)" ::: "memory");
        }
    }
    __syncthreads();
}


typedef short bf16x8 __attribute__((ext_vector_type(8)));
typedef float f32x16 __attribute__((ext_vector_type(16)));
typedef float f32x2 __attribute__((ext_vector_type(2)));
typedef __bf16 bf16x2_t __attribute__((ext_vector_type(2)));
__device__ __forceinline__ unsigned cvtpk(float lo, float hi) { f32x2 v = {lo, hi}; return __builtin_bit_cast(unsigned, __builtin_convertvector(v, bf16x2_t)); }
#define MFMA32(a, b, c) __builtin_amdgcn_mfma_f32_32x32x16_bf16((a), (b), (c), 0, 0, 0)
#define PACK8(x, s) __builtin_bit_cast(bf16x8, (v4u){cvtpk((x)[8 * (s)], (x)[8 * (s) + 1]), cvtpk((x)[8 * (s) + 2], (x)[8 * (s) + 3]), cvtpk((x)[8 * (s) + 4], (x)[8 * (s) + 5]), cvtpk((x)[8 * (s) + 6], (x)[8 * (s) + 7])})
__device__ __forceinline__ int crow(int reg, int h) { return (reg & 3) + 8 * (reg >> 2) + 4 * h; }
__device__ __forceinline__ int keyperm(int k) { return (k & ~12) | ((k & 4) << 1) | ((k & 8) >> 1); }
constexpr int KP = 144;
__device__ __forceinline__ int vt_off(int d, int kp, int VP) { return d * VP + ((((kp >> 3) ^ ((d >> 3) & 7))) << 4) + ((kp & 7) << 1); }
__device__ __forceinline__ void vt_write8(LAS unsigned char* Vt, int VP, int c  , int kp, v4u v) {
    LAS unsigned char* base = Vt + (((kp >> 3) ^ c) << 4) + ((kp & 7) << 1) + (8 * c) * VP;
    *(LAS unsigned short*)(base + 0 * VP) = (unsigned short)(v.x & 0xffff); *(LAS unsigned short*)(base + 1 * VP) = (unsigned short)(v.x >> 16);
    *(LAS unsigned short*)(base + 2 * VP) = (unsigned short)(v.y & 0xffff); *(LAS unsigned short*)(base + 3 * VP) = (unsigned short)(v.y >> 16);
    *(LAS unsigned short*)(base + 4 * VP) = (unsigned short)(v.z & 0xffff); *(LAS unsigned short*)(base + 5 * VP) = (unsigned short)(v.z >> 16);
    *(LAS unsigned short*)(base + 6 * VP) = (unsigned short)(v.w & 0xffff); *(LAS unsigned short*)(base + 7 * VP) = (unsigned short)(v.w >> 16);
}

struct AttnU { int b, h, g, dil, res, Q0; };
__device__ __forceinline__ AttnU attn_decode(int u) { AttnU a; const int w16 = u & 15; int t = u >> 4; a.g = t % 3; t /= 3; a.h = t & 3; a.b = t >> 2; a.dil = 1 << (2 * a.g); a.res = w16 & (a.dil - 1); a.Q0 = (w16 >> (2 * a.g)) * 256; return a; }
__device__ __forceinline__ void attn_load(const bf16* proj, const AttnU& a, int tid, v4u (&pk)[6], v4u (&pv)[6]) {
#pragma unroll
    for (int it = 0; it < 6; ++it) { const int idx = tid + it * 512; const int key = idx >> 3, c = idx & 7, i = a.Q0 - 128 + key;
        if (i >= 0) { const bf16* src = proj + ((size_t)a.b * SEQ + (size_t)i * a.dil + a.res) * NIN + a.h * 64 + c * 8; pk[it] = *(const v4u*)(src + C_AK); pv[it] = *(const v4u*)(src + C_AV); } }
}
__device__ __forceinline__ void attn_phase(const bf16* proj, bf16* og, float* lse, int u0, int ustride, int nunits, LAS unsigned char* L, int tid) {
    const int lane = tid & 63, wave = tid >> 6, wave_u = __builtin_amdgcn_readfirstlane(tid >> 6);
    constexpr int VP = 784;
    LAS unsigned char* Kimg = L; LAS unsigned char* Vt = L + 384 * KP;
    v4u pk[6], pv[6];
    if (u0 < nunits) { const AttnU a0 = attn_decode(u0); attn_load(proj, a0, tid, pk, pv); }
#pragma unroll 1
    for (int u = u0; u < nunits; u += ustride) {
        const AttnU a = attn_decode(u);
        const int r = lane & 31, hh = lane >> 5;
        const size_t rowbase = (size_t)a.b * SEQ;
        const size_t qrow = rowbase + (size_t)(a.Q0 + 32 * wave + r) * a.dil + a.res;
        bf16x8 qf[4];
#pragma unroll
        for (int s = 0; s < 4; ++s) qf[s] = *(const bf16x8*)(proj + qrow * NIN + C_AQ + a.h * 64 + 16 * s + 8 * hh);
#pragma unroll
        for (int it = 0; it < 6; ++it) { const int idx = tid + it * 512; const int key = idx >> 3, c = idx & 7, i = a.Q0 - 128 + key;
            if (i >= 0) { *(LAS v4u*)(Kimg + key * KP + c * 16) = pk[it]; vt_write8(Vt, VP, c, keyperm(key), pv[it]); } }
        __syncthreads();
        if (u + ustride < nunits) { const AttnU an = attn_decode(u + ustride); attn_load(proj, an, tid, pk, pv); }
        {
            const float slope2 = exp2f(-2.0f * (float)(a.h + 1)) * LOG2E * (float)a.dil;
            const int jt0 = (a.Q0 == 0 && wave_u < 4) ? 4 - wave_u : 0;
            float mx = -INFINITY, l = 0.f;
            f32x16 O[2];
#pragma unroll
            for (int i = 0; i < 16; ++i) { O[0][i] = 0.f; O[1][i] = 0.f; }
            const LAS unsigned char* kb = Kimg + (32 * wave + r) * KP + 16 * hh;
            bf16x8 kf[4];
#pragma unroll
            for (int s = 0; s < 4; ++s) kf[s] = *(const LAS bf16x8*)(kb + jt0 * (32 * KP) + 32 * s);
#pragma unroll 1
            for (int jt = jt0; jt < 5; ++jt) {
                f32x16 acc;
#pragma unroll
                for (int i = 0; i < 16; ++i) acc[i] = 0.f;
#pragma unroll
                for (int s = 0; s < 4; ++s) acc = MFMA32(kf[s], qf[s], acc);
                if (jt + 1 < 5) {
#pragma unroll
                    for (int s = 0; s < 4; ++s) kf[s] = *(const LAS bf16x8*)(kb + (jt + 1) * (32 * KP) + 32 * s); }
                const float bq = slope2 * (float)(128 + r - 32 * jt); float tmax = -INFINITY;
#pragma unroll
                for (int i = 0; i < 16; ++i) { const int kk = crow(i, hh); float v = acc[i] - bq + slope2 * (float)kk;
                    if (jt == 0 && kk < r) v = -INFINITY; if (jt == 4 && kk > r) v = -INFINITY; acc[i] = v; tmax = fmaxf(tmax, v); }
                tmax = fmaxf(tmax, __shfl_xor(tmax, 32));
                const float mn = fmaxf(mx, tmax), corr = __builtin_amdgcn_exp2f(mx - mn);
                l *= corr;
#pragma unroll
                for (int i = 0; i < 16; ++i) { O[0][i] *= corr; O[1][i] *= corr; }
#pragma unroll
                for (int i = 0; i < 16; ++i) { const float pvv = __builtin_amdgcn_exp2f(acc[i] - mn); acc[i] = pvv; l += pvv; }
                mx = mn;
                const int T = wave + jt;
#pragma unroll
                for (int s = 0; s < 2; ++s) { const bf16x8 pf = PACK8(acc, s);
#pragma unroll
                    for (int dt = 0; dt < 2; ++dt) { const int d = 32 * dt + r, G = 4 * T + 2 * s + hh;
                        const bf16x8 vf = *(const LAS bf16x8*)(Vt + d * VP + ((G ^ ((d >> 3) & 7)) << 4)); O[dt] = MFMA32(vf, pf, O[dt]); } }
            }
            l += __shfl_xor(l, 32);
            const float inv = 1.0f / l;
            bf16* orow = og + ((size_t)a.g * M + qrow) * 256 + a.h * 64;
#pragma unroll
            for (int dt = 0; dt < 2; ++dt)
#pragma unroll
                for (int i4 = 0; i4 < 4; ++i4) { v2u w; w.x = cvtpk(O[dt][4 * i4] * inv, O[dt][4 * i4 + 1] * inv); w.y = cvtpk(O[dt][4 * i4 + 2] * inv, O[dt][4 * i4 + 3] * inv);
                    *(v2u*)(orow + 32 * dt + 8 * i4 + 4 * hh) = w; }
            if (hh == 0) lse[((size_t)a.g * M + qrow) * 4 + a.h] = mx + __builtin_amdgcn_logf(l);
        }
        __syncthreads();
    }
}
__device__ __forceinline__ void attn_combine(const bf16* proj, const bf16* og, const float* lse, bf16* y, int gtid, int gthreads, int iend) {
#pragma unroll 4
    for (int idx = gtid; idx < iend; idx += gthreads) { const int row = idx >> 5, hc = idx & 31, h = hc >> 3, c = hc & 7;
        const size_t off = (size_t)row * 256 + h * 64 + c * 8;
        const float l0 = lse[(size_t)row * 4 + h], l1 = lse[((size_t)M + row) * 4 + h], l2 = lse[((size_t)2 * M + row) * 4 + h];
        const v4u a0 = *(const v4u*)(og + off), a1 = *(const v4u*)(og + (size_t)M * 256 + off), a2 = *(const v4u*)(og + (size_t)2 * M * 256 + off);
        const v4u gt = *(const v4u*)(proj + (size_t)row * NIN + C_AG + h * 64 + c * 8);
        const float mx = fmaxf(l0, fmaxf(l1, l2)); float w0 = __builtin_amdgcn_exp2f(l0 - mx), w1 = __builtin_amdgcn_exp2f(l1 - mx), w2 = __builtin_amdgcn_exp2f(l2 - mx);
        const float inv = 1.0f / (w0 + w1 + w2); w0 *= inv; w1 *= inv; w2 *= inv;
        v4u o;
#define CMB(f) { const float e0 = (w0 * bf2f((unsigned short)(a0.f & 0xffff)) + w1 * bf2f((unsigned short)(a1.f & 0xffff)) + w2 * bf2f((unsigned short)(a2.f & 0xffff))) * bf2f((unsigned short)(gt.f & 0xffff)); \
                 const float e1 = (w0 * bf2f((unsigned short)(a0.f >> 16)) + w1 * bf2f((unsigned short)(a1.f >> 16)) + w2 * bf2f((unsigned short)(a2.f >> 16))) * bf2f((unsigned short)(gt.f >> 16)); o.f = cvtpk(e0, e1); }
        CMB(x) CMB(y) CMB(z) CMB(w)
#undef CMB
        *(v4u*)(y + (size_t)row * DM + h * 64 + c * 8) = o; }
}

__device__ __forceinline__ void retkv_pair(const bf16* proj, float* kvT, int pair, LAS unsigned char* L, int tid) {
    const int half = tid >> 8, t256 = tid & 255, lane = tid & 63, w4 = (tid >> 6) & 3;
    const int uu = pair * 2 + half, n = uu & 31, h = (uu >> 5) & 3, b = uu >> 7;
    constexpr int VP = 272;
    LAS unsigned char* Vt = L + half * (2 * 64 * VP); LAS unsigned char* Kz = Vt + 64 * VP;
    const float lg2 = __builtin_amdgcn_logf(1.0f - exp2f(-5.0f - (float)h));
    const size_t row0 = (size_t)b * SEQ + n * 128;
#pragma unroll
    for (int it = 0; it < 4; ++it) { const int idx = t256 + it * 256, j = idx >> 3, c = idx & 7;
        const bf16* src = proj + (row0 + j) * NIN + h * 64 + c * 8;
        const v4u kv = *(const v4u*)(src + C_DK), vv = *(const v4u*)(src + C_DV);
        const float z = __builtin_amdgcn_exp2f(lg2 * (float)(127 - j));
        v4u kz; kz.x = cvtpk(bf2f((unsigned short)(kv.x & 0xffff)) * z, bf2f((unsigned short)(kv.x >> 16)) * z); kz.y = cvtpk(bf2f((unsigned short)(kv.y & 0xffff)) * z, bf2f((unsigned short)(kv.y >> 16)) * z);
        kz.z = cvtpk(bf2f((unsigned short)(kv.z & 0xffff)) * z, bf2f((unsigned short)(kv.z >> 16)) * z); kz.w = cvtpk(bf2f((unsigned short)(kv.w & 0xffff)) * z, bf2f((unsigned short)(kv.w >> 16)) * z);
        vt_write8(Kz, VP, c, j, kz); vt_write8(Vt, VP, c, j, vv); }
    __syncthreads();
    { const int r = lane & 31, hh = lane >> 5, et = w4 >> 1, dt = w4 & 1;
      f32x16 acc;
#pragma unroll
      for (int i = 0; i < 16; ++i) acc[i] = 0.f;
      const int e = 32 * et + r, d = 32 * dt + r;
#pragma unroll
      for (int ks = 0; ks < 8; ++ks) { const int G = 2 * ks + hh;
          const bf16x8 af = *(const LAS bf16x8*)(Vt + e * VP + ((G ^ ((e >> 3) & 7)) << 4));
          const bf16x8 bfr = *(const LAS bf16x8*)(Kz + d * VP + ((G ^ ((d >> 3) & 7)) << 4));
          acc = MFMA32(af, bfr, acc); }
      float* o = kvT + (size_t)uu * 4096;
#pragma unroll
      for (int i = 0; i < 16; ++i) o[(32 * et + crow(i, hh)) * 64 + d] = acc[i]; }
    __syncthreads();
}
__device__ __forceinline__ void ret_scan(const float* kvT, bf16* prev, int gtid) {
    if (gtid >= 65536) return;
    const int bh = gtid >> 11, el = (gtid & 2047) * 2, h = bh & 3;
    const float lg2 = __builtin_amdgcn_logf(1.0f - exp2f(-5.0f - (float)h)); const float cd = __builtin_amdgcn_exp2f(lg2 * 128.0f);
    f32x2 v[32];
#pragma unroll
    for (int n = 0; n < 32; ++n) v[n] = *(const f32x2*)(kvT + ((size_t)bh * 32 + n) * 4096 + el);
    f32x2 st = (f32x2){0.f, 0.f};
#pragma unroll
    for (int n = 0; n < 32; ++n) { *(unsigned*)(prev + ((size_t)bh * 32 + n) * 4096 + el) = cvtpk(st.x, st.y); st = st * cd + v[n]; }
}
__device__ __forceinline__ void ret_pair(const bf16* proj, const bf16* prev, const float* ret_g, bf16* y, int pair, LAS unsigned char* L, int tid) {
    const int half = tid >> 8, t256 = tid & 255, lane = tid & 63, w4 = (tid >> 6) & 3, w4u = __builtin_amdgcn_readfirstlane((tid >> 6) & 3);
    const int uu = pair * 2 + half, n = uu & 31, h = (uu >> 5) & 3, b = uu >> 7;
    constexpr int VP = 272;
    LAS unsigned char* Kimg = L + half * 45056; LAS unsigned char* Vt = Kimg + 128 * KP; LAS unsigned char* Pv = Vt + 64 * VP;
    const float lg2 = __builtin_amdgcn_logf(1.0f - exp2f(-5.0f - (float)h));
    const size_t row0 = (size_t)b * SEQ + n * 128;
    const int r = lane & 31, hh = lane >> 5, il = 32 * w4 + r;
    const size_t qrow = row0 + il;
    bf16x8 qf[4];
#pragma unroll
    for (int s = 0; s < 4; ++s) qf[s] = *(const bf16x8*)(proj + qrow * NIN + C_DQ + h * 64 + 16 * s + 8 * hh);
    v2u gte[2][4]; f32x4 rge[2][4];
#pragma unroll
    for (int dt = 0; dt < 2; ++dt)
#pragma unroll
        for (int i4 = 0; i4 < 4; ++i4) { const int e = 32 * dt + 8 * i4 + 4 * hh; gte[dt][i4] = *(const v2u*)(proj + qrow * NIN + C_DG + h * 64 + e); rge[dt][i4] = *(const f32x4*)(ret_g + h * 64 + e); }
#pragma unroll
    for (int it = 0; it < 4; ++it) { const int idx = t256 + it * 256, j = idx >> 3, c = idx & 7;
        const bf16* src = proj + (row0 + j) * NIN + h * 64 + c * 8;
        const v4u kv = *(const v4u*)(src + C_DK), vv = *(const v4u*)(src + C_DV);
        *(LAS v4u*)(Kimg + j * KP + c * 16) = kv;
        vt_write8(Vt, VP, c, keyperm(j), vv); }
    { const int e = t256 >> 2, d0 = (t256 & 3) * 16;
      const v4u* pp = (const v4u*)(prev + (size_t)uu * 4096 + e * 64 + d0);
      const v4u w0 = pp[0], w1 = pp[1];
      *(LAS v4u*)(Pv + e * KP + d0 * 2) = w0; *(LAS v4u*)(Pv + e * KP + d0 * 2 + 16) = w1; }
    __syncthreads();
    {
        f32x16 O[2], C[2];
#pragma unroll
        for (int i = 0; i < 16; ++i) { O[0][i] = 0.f; O[1][i] = 0.f; C[0][i] = 0.f; C[1][i] = 0.f; }
#pragma unroll 1
        for (int T = 0; T <= w4u; ++T) {
            f32x16 acc;
#pragma unroll
            for (int i = 0; i < 16; ++i) acc[i] = 0.f;
#pragma unroll
            for (int s = 0; s < 4; ++s) { const bf16x8 kf = *(const LAS bf16x8*)(Kimg + (32 * T + r) * KP + 32 * s + 16 * hh); acc = MFMA32(kf, qf[s], acc); }
#pragma unroll
            for (int i = 0; i < 16; ++i) { const int diff = il - 32 * T - crow(i, hh); acc[i] = (diff >= 0) ? acc[i] * __builtin_amdgcn_exp2f(lg2 * (float)diff) : 0.f; }
#pragma unroll
            for (int s = 0; s < 2; ++s) { const bf16x8 pf = PACK8(acc, s);
#pragma unroll
                for (int dt = 0; dt < 2; ++dt) { const int d = 32 * dt + r, G = 4 * T + 2 * s + hh;
                    const bf16x8 vf = *(const LAS bf16x8*)(Vt + d * VP + ((G ^ ((d >> 3) & 7)) << 4)); O[dt] = MFMA32(vf, pf, O[dt]); } }
        }
#pragma unroll
        for (int dt = 0; dt < 2; ++dt)
#pragma unroll
            for (int s = 0; s < 4; ++s) { const bf16x8 pf = *(const LAS bf16x8*)(Pv + (32 * dt + r) * KP + 32 * s + 16 * hh); C[dt] = MFMA32(pf, qf[s], C[dt]); }
        const float xi = __builtin_amdgcn_exp2f(lg2 * (float)(il + 1));
        float sm = 0.f;
#pragma unroll
        for (int dt = 0; dt < 2; ++dt)
#pragma unroll
            for (int i = 0; i < 16; ++i) { O[dt][i] += xi * C[dt][i]; sm += O[dt][i]; }
        sm += __shfl_xor(sm, 32); const float mu = sm * (1.f / 64.f); float sq = 0.f;
#pragma unroll
        for (int dt = 0; dt < 2; ++dt)
#pragma unroll
            for (int i = 0; i < 16; ++i) { O[dt][i] -= mu; sq += O[dt][i] * O[dt][i]; }
        sq += __shfl_xor(sq, 32); const float rstd = 1.f / sqrtf(sq * (1.f / 64.f) + EPS);
#pragma unroll
        for (int dt = 0; dt < 2; ++dt)
#pragma unroll
            for (int i4 = 0; i4 < 4; ++i4) { const int e = 32 * dt + 8 * i4 + 4 * hh;
                const f32x4 rg = rge[dt][i4]; const v2u gt = gte[dt][i4];
                v2u w; w.x = cvtpk(O[dt][4 * i4] * rstd * rg.x * bf2f((unsigned short)(gt.x & 0xffff)), O[dt][4 * i4 + 1] * rstd * rg.y * bf2f((unsigned short)(gt.x >> 16)));
                w.y = cvtpk(O[dt][4 * i4 + 2] * rstd * rg.z * bf2f((unsigned short)(gt.y & 0xffff)), O[dt][4 * i4 + 3] * rstd * rg.w * bf2f((unsigned short)(gt.y >> 16)));
                *(v2u*)(y + qrow * DM + 768 + h * 64 + e) = w; }
    }
    __syncthreads();
}

__device__ __forceinline__ void sgu_unit(const bf16* proj, bf16* y, const float* sgu_g, const bf16* wb  , const float* sgu_b, int u, LAS unsigned char* L, int tid) {
    const int lane = tid & 63, wave = tid >> 6;
    constexpr int VP = 272, GI = 64 * VP + 32;
    LAS unsigned char* Vt = L;
    const size_t row0 = (size_t)u * 128;
    { const int s = tid >> 2, q = tid & 3;
      const bf16* src = proj + (row0 + s) * NIN + C_BV + 64 * q;
      v4u w[8];
#pragma unroll
      for (int c = 0; c < 8; ++c) w[c] = *(const v4u*)(src + 8 * c);
      float sm = 0.f, sq = 0.f;
#pragma unroll
      for (int c = 0; c < 8; ++c) {
          const float e0 = bf2f((unsigned short)(w[c].x & 0xffff)), e1 = bf2f((unsigned short)(w[c].x >> 16)), e2 = bf2f((unsigned short)(w[c].y & 0xffff)), e3 = bf2f((unsigned short)(w[c].y >> 16));
          const float e4 = bf2f((unsigned short)(w[c].z & 0xffff)), e5 = bf2f((unsigned short)(w[c].z >> 16)), e6 = bf2f((unsigned short)(w[c].w & 0xffff)), e7 = bf2f((unsigned short)(w[c].w >> 16));
          sm += ((e0 + e1) + (e2 + e3)) + ((e4 + e5) + (e6 + e7));
          sq += ((e0 * e0 + e1 * e1) + (e2 * e2 + e3 * e3)) + ((e4 * e4 + e5 * e5) + (e6 * e6 + e7 * e7)); }
      sm += __shfl_xor(sm, 1); sq += __shfl_xor(sq, 1); sm += __shfl_xor(sm, 2); sq += __shfl_xor(sq, 2);
      const float mean = sm * (1.f / 256.f); const float var = fmaxf(sq * (1.f / 256.f) - mean * mean, 0.f); const float rstd = 1.f / sqrtf(var + EPS);
#pragma unroll
      for (int c = 0; c < 8; ++c) { const f32x4 g0 = *(const f32x4*)(sgu_g + 64 * q + 8 * c), g1 = *(const f32x4*)(sgu_g + 64 * q + 8 * c + 4);
          v4u o; o.x = cvtpk((bf2f((unsigned short)(w[c].x & 0xffff)) - mean) * rstd * g0.x, (bf2f((unsigned short)(w[c].x >> 16)) - mean) * rstd * g0.y);
          o.y = cvtpk((bf2f((unsigned short)(w[c].y & 0xffff)) - mean) * rstd * g0.z, (bf2f((unsigned short)(w[c].y >> 16)) - mean) * rstd * g0.w);
          o.z = cvtpk((bf2f((unsigned short)(w[c].z & 0xffff)) - mean) * rstd * g1.x, (bf2f((unsigned short)(w[c].z >> 16)) - mean) * rstd * g1.y);
          o.w = cvtpk((bf2f((unsigned short)(w[c].w & 0xffff)) - mean) * rstd * g1.z, (bf2f((unsigned short)(w[c].w >> 16)) - mean) * rstd * g1.w);
          vt_write8(Vt + q * GI, VP, c, s, o); } }
    __syncthreads();
    { const int r = lane & 31, hh = lane >> 5, g = wave >> 1, dt = wave & 1, d = 32 * dt + r;
      const LAS unsigned char* vg = Vt + g * GI + d * VP; const int sw = (d >> 3) & 7;
#pragma unroll
      for (int tt = 0; tt < 4; ++tt) { f32x16 acc;
#pragma unroll
          for (int i = 0; i < 16; ++i) acc[i] = 0.f;
          const bf16* wrow = wb + ((size_t)g * 128 + 32 * tt + r) * 128 + 8 * hh;
#pragma unroll
          for (int ks = 0; ks < 2 * (tt + 1); ++ks) { const bf16x8 af = *(const LAS bf16x8*)(vg + (((2 * ks + hh) ^ sw) << 4)); const bf16x8 bfr = *(const bf16x8*)(wrow + 16 * ks); acc = MFMA32(af, bfr, acc); }
          const int t = 32 * tt + r; const size_t row = row0 + t; const float bias = sgu_b[g * 128 + t];
#pragma unroll
          for (int i4 = 0; i4 < 4; ++i4) { const int d0 = 32 * dt + 8 * i4 + 4 * hh;
              const v2u uu = *(const v2u*)(proj + row * NIN + C_BU + g * 64 + d0), gt = *(const v2u*)(proj + row * NIN + C_BG + g * 64 + d0);
              v2u w; w.x = cvtpk((acc[4 * i4] + bias) * bf2f((unsigned short)(uu.x & 0xffff)) * bf2f((unsigned short)(gt.x & 0xffff)), (acc[4 * i4 + 1] + bias) * bf2f((unsigned short)(uu.x >> 16)) * bf2f((unsigned short)(gt.x >> 16)));
              w.y = cvtpk((acc[4 * i4 + 2] + bias) * bf2f((unsigned short)(uu.y & 0xffff)) * bf2f((unsigned short)(gt.y & 0xffff)), (acc[4 * i4 + 3] + bias) * bf2f((unsigned short)(uu.y >> 16)) * bf2f((unsigned short)(gt.y >> 16)));
              *(v2u*)(y + row * DM + 256 + g * 64 + d0) = w; } } }
    __syncthreads();
}
template <int PW>
__device__ __forceinline__ void pool_run(const bf16* src  , LAS unsigned char* dst, int tok  , int AP) {
    v4u x[PW + 7];
#pragma unroll
    for (int q = 0; q < PW + 7; ++q) { const int rel = q - (PW - 1); x[q] = (tok + rel >= 0) ? *(const v4u*)(src + (ptrdiff_t)rel * NIN) : (v4u){0u, 0u, 0u, 0u}; }
    float s[8];
#pragma unroll
    for (int c = 0; c < 8; ++c) s[c] = 0.f;
#define ADDX(q, sg) { s[0] += sg bf2f((unsigned short)(x[q].x & 0xffff)); s[1] += sg bf2f((unsigned short)(x[q].x >> 16)); s[2] += sg bf2f((unsigned short)(x[q].y & 0xffff)); s[3] += sg bf2f((unsigned short)(x[q].y >> 16)); \
                      s[4] += sg bf2f((unsigned short)(x[q].z & 0xffff)); s[5] += sg bf2f((unsigned short)(x[q].z >> 16)); s[6] += sg bf2f((unsigned short)(x[q].w & 0xffff)); s[7] += sg bf2f((unsigned short)(x[q].w >> 16)); }
#pragma unroll
    for (int q = 0; q < PW - 1; ++q) ADDX(q, +)
#pragma unroll
    for (int i = 0; i < 8; ++i) { const int q = PW - 1 + i; ADDX(q, +)
        const int cnt = (tok + i + 1 < PW) ? tok + i + 1 : PW; const float ic = 1.0f / (float)cnt; const v4u w0 = x[q];
        v4u o; o.x = cvtpk(s[0] * ic - bf2f((unsigned short)(w0.x & 0xffff)), s[1] * ic - bf2f((unsigned short)(w0.x >> 16))); o.y = cvtpk(s[2] * ic - bf2f((unsigned short)(w0.y & 0xffff)), s[3] * ic - bf2f((unsigned short)(w0.y >> 16)));
        o.z = cvtpk(s[4] * ic - bf2f((unsigned short)(w0.z & 0xffff)), s[5] * ic - bf2f((unsigned short)(w0.z >> 16))); o.w = cvtpk(s[6] * ic - bf2f((unsigned short)(w0.w & 0xffff)), s[7] * ic - bf2f((unsigned short)(w0.w >> 16)));
        *(LAS v4u*)(dst + i * AP) = o;
        ADDX(i, -) }
#undef ADDX
}
__device__ __forceinline__ void pool_unit(const bf16* proj, bf16* y, const bf16* pwt  , const float* pool_scale, int u, LAS unsigned char* L, int tid) {
    const int lane = tid & 63, wave = tid >> 6;
    constexpr int AP = 528;
    const size_t row0 = (size_t)u * 128; const int tok0 = (u & 31) * 128;
    { const int wu = __builtin_amdgcn_readfirstlane(tid >> 6), g = wu >> 1, c32 = 8 * g + (lane & 7), run = (lane >> 3) + 8 * (wu & 1), t0 = 8 * run;
      const bf16* src = proj + (row0 + t0) * NIN + C_CX + 8 * c32; LAS unsigned char* dst = L + t0 * AP + c32 * 16; const int tk = tok0 + t0;
      if (g == 0) pool_run<2>(src, dst, tk, AP); else if (g == 1) pool_run<4>(src, dst, tk, AP); else if (g == 2) pool_run<8>(src, dst, tk, AP); else pool_run<16>(src, dst, tk, AP); }
    __syncthreads();
    { const int r = lane & 31, hh = lane >> 5, g = wave >> 1, dt = wave & 1;
      bf16x8 af[4];
#pragma unroll
      for (int ks = 0; ks < 4; ++ks) af[ks] = *(const bf16x8*)(pwt + ((size_t)g * 64 + 32 * dt + r) * 64 + 16 * ks + 8 * hh);
      f32x4 sc[4]; v2u gts[4][4];
#pragma unroll
      for (int i4 = 0; i4 < 4; ++i4) { const int d0 = 32 * dt + 8 * i4 + 4 * hh; sc[i4] = *(const f32x4*)(pool_scale + g * 64 + d0);
#pragma unroll
          for (int tt = 0; tt < 4; ++tt) gts[tt][i4] = *(const v2u*)(proj + (row0 + 32 * tt + r) * NIN + C_CG + g * 64 + d0); }
#pragma unroll
      for (int tt = 0; tt < 4; ++tt) { f32x16 acc;
#pragma unroll
          for (int i = 0; i < 16; ++i) acc[i] = 0.f;
#pragma unroll
          for (int ks = 0; ks < 4; ++ks) { const bf16x8 bfr = *(const LAS bf16x8*)(L + (32 * tt + r) * AP + (g * 64 + 16 * ks + 8 * hh) * 2); acc = MFMA32(af[ks], bfr, acc); }
          const size_t row = row0 + 32 * tt + r;
#pragma unroll
          for (int i4 = 0; i4 < 4; ++i4) { const int d0 = 32 * dt + 8 * i4 + 4 * hh; const v2u gt = gts[tt][i4];
              v2u w; w.x = cvtpk(acc[4 * i4] * sc[i4].x * bf2f((unsigned short)(gt.x & 0xffff)), acc[4 * i4 + 1] * sc[i4].y * bf2f((unsigned short)(gt.x >> 16)));
              w.y = cvtpk(acc[4 * i4 + 2] * sc[i4].z * bf2f((unsigned short)(gt.y & 0xffff)), acc[4 * i4 + 3] * sc[i4].w * bf2f((unsigned short)(gt.y >> 16)));
              *(v2u*)(y + row * DM + 512 + g * 64 + d0) = w; } } }
    __syncthreads();
}

#define PHASE_IDS() int tid = threadIdx.x; asm volatile("" : "+v"(tid)); const int lane = tid & 63; const int wave = __builtin_amdgcn_readfirstlane(tid >> 6); const int gw = (int)blockIdx.x * 8 + wave; (void)lane; (void)gw
#define PHASE_PTRS() size_t z0_ = 0; asm volatile("" : "+s"(z0_)); unsigned char* ws = p.ws + z0_;     const float* x = p.in[0]; const float* w_in = p.in[2]; const float* w_out = p.in[9]; \
    const float* PRM = (const float*)(ws + WS_SMALL); bf16* WinT = (bf16*)(ws + WS_WIN); bf16* WoutT = (bf16*)(ws + WS_WOUT); bf16* XB = (bf16*)(ws + WS_XB); bf16* PROJ = (bf16*)(ws + WS_PROJ); \
    bf16* Y = (bf16*)(ws + WS_Y); bf16* Z = (bf16*)(ws + WS_Z); float* KVT = (float*)(ws + WS_KV); bf16* OG = (bf16*)(ws + WS_OG); float* LSE = (float*)(ws + WS_LSE); \
    float* R0P_ = (float*)(ws + WS_R0 + R0_PPART); float* R0Y_ = (float*)(ws + WS_R0 + R0_Y); float* R0Z_ = (float*)(ws + WS_R0 + R0_ZPART); float* R0H_ = (float*)(ws + WS_R0 + R0_H); (void)R0H_; \
    (void)x; (void)w_in; (void)w_out; (void)PRM; (void)WinT; (void)WoutT; (void)XB; (void)PROJ; (void)Y; (void)Z; (void)KVT; (void)OG; (void)LSE; (void)R0P_; (void)R0Y_; (void)R0Z_
#ifndef PROBE_A
#define PROBE_A (-1)
#define PROBE_B (-1)
#endif
#define TS(k) do { if (PROBE_A == (k) && blockIdx.x == 0 && threadIdx.x == 0) *(volatile LAS unsigned long long*)(L + 139280) = __builtin_amdgcn_s_memrealtime(); \
                   if (PROBE_B == (k) && blockIdx.x == 0 && threadIdx.x == 0) *(volatile LAS unsigned long long*)(L + 139288) = __builtin_amdgcn_s_memrealtime() - *(volatile LAS unsigned long long*)(L + 139280); } while (0)
template <int l>
__device__ __forceinline__ void layer_body(const Params& p, LAS unsigned char* L, const XcdBarrier& bar) {
    constexpr int G = 256, NGW = G * 8;

        { PHASE_PTRS(); pg8::Gemm g{XB, WinT + (size_t)l * NIN * DM, M, NIN, DM}; pg8::StaticOrder S; S.init(M, NIN, G, (int)blockIdx.x);
          pg8::EpiOut E{PROJ, NIN, (1u << 3) | (1u << 6) | (1u << 8) | (1u << 12)};
          pg8::gemm_phase<pg8::EpiOut, pg8::StaticOrder, true, true>((PG8_LAS unsigned char*)L, g, S, E); }
        if (l == 0 && (int)blockIdx.x >= 128) { PHASE_IDS(); PHASE_PTRS();
            LAS float* scr = (LAS float*)(L + wave * 16384); const int w1 = ((int)blockIdx.x - 128) * 8 + wave;
            constexpr int I_IN = (DM / 64) * (NIN / 32), I_OUT = (DM / 64) * (DM / 32);
            for (int it = w1; it < 2 * I_OUT + I_IN; it += 1024) {
                if (it < I_OUT) p0_transpose_item(w_out, DM, DM, WoutT, nullptr, 0, scr, it, lane);
                else if (it < 2 * I_OUT) p0_transpose_item(w_out + (size_t)DM * DM, DM, DM, WoutT + (size_t)DM * DM, nullptr, 0, scr, it - I_OUT, lane);
                else p0_transpose_item(w_in + (size_t)DM * NIN, DM, NIN, WinT + (size_t)NIN * DM, PRM + P_PREG + DM, 1, scr, it - 2 * I_OUT, lane); } }
        { PHASE_IDS(); PHASE_PTRS();
          if ((int)blockIdx.x >= 128) for (int task = ((int)blockIdx.x - 128) * 8 + wave; task < 52 * R0_KC; task += 1024) r0_dot_task<2>(R0H_, w_in + (size_t)l * DM * NIN, NIN, R0P_, task, 52, lane); }
        xcd_barrier(bar); TS(1 + 5 * l + 1);
        { PHASE_IDS(); PHASE_PTRS();
          if ((int)blockIdx.x >= 248) r0_mix(R0P_, R0Y_, (int)blockIdx.x - 248, PRM + P_SGUG + l * 256, PRM + P_SGUW + (size_t)l * 65536, PRM + P_SGUB + l * 512, PRM + P_RETG + l * 256, (LAS float*)L, tid); }
        { PHASE_IDS(); PHASE_PTRS(); for (int k = 0; k < 2; ++k) retkv_pair(PROJ, KVT, 64 * ((int)blockIdx.x & 7) + ((int)blockIdx.x >> 3) + 32 * k, L, tid); }
        { PHASE_IDS(); PHASE_PTRS(); const int c = (int)blockIdx.x; attn_phase(PROJ, OG, LSE, 192 * (c & 7) + (c >> 3), 32, 192 * ((c & 7) + 1), L, tid); }
        { PHASE_IDS(); PHASE_PTRS(); { const int u = 32 * ((int)blockIdx.x & 7) + ((int)blockIdx.x >> 3); sgu_unit(PROJ, Y, PRM + P_SGUG + l * 256, (const bf16*)(ws + WS_SGUWB) + (size_t)l * 65536, PRM + P_SGUB + l * 512, u, L, tid); } }
        { PHASE_IDS(); PHASE_PTRS(); { const int u = 32 * ((int)blockIdx.x & 7) + ((int)blockIdx.x >> 3); pool_unit(PROJ, Y, (const bf16*)(ws + WS_PWT) + (size_t)l * 16384, PRM + P_POOLS + l * 256, u, L, tid); } }
        xcd_barrier(bar); TS(1 + 5 * l + 2);
        { PHASE_IDS(); PHASE_PTRS(); ret_scan(KVT, (bf16*)(ws + WS_PREV), (32 * ((int)blockIdx.x & 7) + ((int)blockIdx.x >> 3)) * 256 + tid - ((tid >= 256) ? 256 - 65536 : 0));
          if ((int)blockIdx.x < 16 * R0_KCZ) {
              LAS float* red = (LAS float*)L;
              float acc[8];
              if (wave >= 4) { r0_dot_sub(R0Y_, w_out + (size_t)l * DM * DM, DM, (int)blockIdx.x, 16, wave - 4, lane, acc);
                  if (wave > 4) {
#pragma unroll
                      for (int b = 0; b < 8; ++b) red[((wave - 5) * 8 + b) * 64 + lane] = acc[b]; } }
              __syncthreads();
              if (wave == 4) { const int ch = (int)blockIdx.x % 16, kc = (int)blockIdx.x / 16;
#pragma unroll
                  for (int b = 0; b < 8; ++b) R0Z_[((size_t)kc * 8 + b) * DM + ch * 64 + lane] = ((acc[b] + red[(0 * 8 + b) * 64 + lane]) + red[(1 * 8 + b) * 64 + lane]) + red[(2 * 8 + b) * 64 + lane]; }
              __syncthreads(); } }
        xcd_barrier(bar);
        { PHASE_IDS(); PHASE_PTRS(); for (int k = 0; k < 2; ++k) ret_pair(PROJ, (const bf16*)(ws + WS_PREV), PRM + P_RETG + l * 256, Y, 64 * ((int)blockIdx.x & 7) + ((int)blockIdx.x >> 3) + 32 * k, L, tid);
          attn_combine(PROJ, OG, LSE, Y, ((int)blockIdx.x & 7) * 131072 + ((int)blockIdx.x >> 3) * 512 + tid, 16384, (((int)blockIdx.x & 7) + 1) * 131072); }
        xcd_barrier(bar); TS(1 + 5 * l + 3);
        { PHASE_PTRS(); pg8::Gemm g{Y, WoutT + (size_t)l * DM * DM, M, DM, DM}; pg8::StaticOrder S; S.init(M, DM, G, (int)blockIdx.x);
          pg8::EpiOut E{Z, DM, 0u};
          pg8::gemm_phase<pg8::EpiOut, pg8::StaticOrder, true, true>((PG8_LAS unsigned char*)L, g, S, E); }
        xcd_barrier(bar); TS(1 + 5 * l + 4);
        { PHASE_IDS(); PHASE_PTRS(); const int NR = M / NGW; float* RS = (float*)(ws + WS_RS); float* R0X = (float*)(ws + WS_RS + 262144);
          f32x4 pg[4];
#pragma unroll
          for (int j = 0; j < 4; ++j) pg[j] = *((const f32x4*)(PRM + P_POSTG + l * DM) + lane + 64 * j);
          v2u zc[4], zn[4]; f32x4 xc[4], xn_[4]; v2u bc[4], bn[4];
          { const int m = gw % NGW;
#pragma unroll
            for (int j = 0; j < 4; ++j) { zc[j] = __builtin_nontemporal_load((const v2u*)(Z + (size_t)m * DM) + lane + 64 * j);
                if (l == 0) xc[j] = *((const f32x4*)(x + (size_t)m * DM) + lane + 64 * j); else bc[j] = *((const v2u*)(XB + (size_t)m * DM) + lane + 64 * j); } }
#pragma unroll 1
          for (int i = 0; i < NR; ++i) { const int m = i * NGW + (gw + i * 257) % NGW; const bool r0 = (m & (SEQ - 1)) == 0;
              if (i + 1 < NR) { const int mn = (i + 1) * NGW + (gw + (i + 1) * 257) % NGW;
#pragma unroll
                  for (int j = 0; j < 4; ++j) { zn[j] = __builtin_nontemporal_load((const v2u*)(Z + (size_t)mn * DM) + lane + 64 * j);
                      if (l == 0) xn_[j] = *((const f32x4*)(x + (size_t)mn * DM) + lane + 64 * j); else bn[j] = *((const v2u*)(XB + (size_t)mn * DM) + lane + 64 * j); } }
              f32x4 z[4], xv[4];
              if (r0) r0z_sum(R0Z_ + (size_t)(m >> 12) * DM, lane, z);
              else {
#pragma unroll
                  for (int j = 0; j < 4; ++j) unpack4(zc[j], z[j]); }
              if (l == 0) {
#pragma unroll
                  for (int j = 0; j < 4; ++j) xv[j] = xc[j];
              } else if (r0) {
#pragma unroll
                  for (int j = 0; j < 4; ++j) xv[j] = *((const f32x4*)(R0X + (size_t)(m >> 12) * DM) + lane + 64 * j);
              } else { const float rs = RS[m];
#pragma unroll
                  for (int j = 0; j < 4; ++j) { unpack4(bc[j], xv[j]); xv[j] = xv[j] * rs; } }
              const float rstd = 1.f / sqrtf(wave_sum(ssq4(z)) * (1.f / DM) + EPS);
#pragma unroll
              for (int j = 0; j < 4; ++j) xv[j] = xv[j] + z[j] * rstd * pg[j];
              if (l + 1 < DEPTH) {
                  const float q2 = wave_sum(ssq4(xv)) * (1.f / DM) + EPS; const float r2 = 1.f / sqrtf(q2);
                  v2u* o8 = (v2u*)(XB + (size_t)m * DM) + lane;
#pragma unroll
                  for (int j = 0; j < 4; ++j) { v2u w; w.x = cvtpk(xv[j].x * r2, xv[j].y * r2); w.y = cvtpk(xv[j].z * r2, xv[j].w * r2); o8[64 * j] = w; }
                  if (lane == 0) RS[m] = sqrtf(q2);
                  if (r0) {
#pragma unroll
                      for (int j = 0; j < 4; ++j) { *((f32x4*)(R0X + (size_t)(m >> 12) * DM) + lane + 64 * j) = xv[j];
                          *((f32x4*)(R0H_ + (size_t)(m >> 12) * DM) + lane + 64 * j) = xv[j] * r2 * *((const f32x4*)(PRM + P_PREG + (l + 1 < DEPTH ? l + 1 : 0) * DM) + lane + 64 * j); } }
              } else {
                  f32x4* o = (f32x4*)(p.out + (size_t)m * DM) + lane;
#pragma unroll
                  for (int j = 0; j < 4; ++j) __builtin_nontemporal_store(xv[j], o + 64 * j);
              }
#pragma unroll
              for (int j = 0; j < 4; ++j) { zc[j] = zn[j]; xc[j] = xn_[j]; bc[j] = bn[j]; } } }
        if (l + 1 < DEPTH) xcd_barrier(bar); TS(1 + 5 * l + 5);

}

__global__ void __launch_bounds__(512, 2) fwd(Params p) {
    extern __shared__ __attribute__((aligned(16))) unsigned char lds[];
    cg::grid_group grid = cg::this_grid();
    LAS unsigned char* L = (LAS unsigned char*)lds;
    constexpr int G = 256, NGW = G * 8;
    { volatile LAS unsigned* st = (volatile LAS unsigned*)(L + 139264); if (threadIdx.x < 2) st[threadIdx.x] = 0u; }
    __syncthreads();
    TS(0);
    const XcdBarrier bar = xcd_barrier_post((unsigned*)(p.ws + WS_CTL), (volatile LAS unsigned*)(L + 139264));
    {
        PHASE_IDS(); PHASE_PTRS();
        { float* prm = (float*)(ws + WS_SMALL);
          for (int i = (int)blockIdx.x * 512 + tid; i < P_END; i += G * 512) { float v;
              if (i < P_SGUG) v = p.in[1][i]; else if (i < P_SGUW) v = p.in[3][i - P_SGUG]; else if (i < P_SGUB) v = p.in[4][i - P_SGUW]; else if (i < P_POOLW) v = p.in[5][i - P_SGUB];
              else if (i < P_POOLS) v = p.in[6][i - P_POOLW]; else if (i < P_RETG) v = p.in[7][i - P_POOLS]; else if (i < P_POSTG) v = p.in[8][i - P_RETG]; else v = p.in[10][i - P_POSTG];
              prm[i] = v; } }
        { bf16* sw = (bf16*)(ws + WS_SGUWB); bf16* pw = (bf16*)(ws + WS_PWT);
          for (int i = (int)blockIdx.x * 512 + tid; i < 2 * 65536; i += G * 512) { const int s = i & 127, t = (i >> 7) & 127; sw[i] = (s <= t) ? (bf16)f2bf(p.in[4][i]) : (bf16)0; }
          for (int i = (int)blockIdx.x * 512 + tid; i < 2 * 16384; i += G * 512) { const int c = i & 63, d = (i >> 6) & 63, lg = i >> 12; pw[i] = (bf16)f2bf(p.in[6][(size_t)lg * 4096 + c * 64 + d]); } }
        LAS float* scr = (LAS float*)(L + wave * 16384);
        constexpr int I_IN = (DM / 64) * (NIN / 32);
        for (int it = gw; it < I_IN; it += NGW) p0_transpose_item(w_in, DM, NIN, WinT, p.in[1], 1, scr, it, lane);
        { constexpr int NR = M / NGW; f32x4 c0[4], c1[4], n0[4], n1[4];
#define ROWM(i) ((i) * NGW + (gw + (i) * 257) % NGW)
#define LDROW(dst, m) _Pragma("unroll") for (int j = 0; j < 4; ++j) dst[j] = __builtin_nontemporal_load((const f32x4*)(x + (size_t)(m) * DM) + lane + 64 * j)
#define P0ROW(cur, m) { const float rstd = 1.f / sqrtf(wave_sum(ssq4(cur)) * (1.f / DM) + EPS); v2u* o8 = (v2u*)(XB + (size_t)(m) * DM) + lane; \
              _Pragma("unroll") for (int j = 0; j < 4; ++j) { v2u w; w.x = cvtpk(cur[j].x * rstd, cur[j].y * rstd); w.y = cvtpk(cur[j].z * rstd, cur[j].w * rstd); o8[64 * j] = w; } \
              if (((m) & (SEQ - 1)) == 0) { _Pragma("unroll") for (int j = 0; j < 4; ++j) *((f32x4*)(R0H_ + (size_t)((m) >> 12) * DM) + lane + 64 * j) = cur[j] * rstd * *((const f32x4*)p.in[1] + lane + 64 * j); } }
          LDROW(c0, ROWM(0)); LDROW(c1, ROWM(1));
#pragma unroll 1
          for (int i = 0; i < NR; i += 2) {
              if (i + 2 < NR) { LDROW(n0, ROWM(i + 2)); LDROW(n1, ROWM(i + 3)); }
              P0ROW(c0, ROWM(i)); P0ROW(c1, ROWM(i + 1));
#pragma unroll
              for (int j = 0; j < 4; ++j) { c0[j] = n0[j]; c1[j] = n1[j]; } }
#undef LDROW
#undef P0ROW
#undef ROWM
        }
    }
    if (p.ws == nullptr) grid.sync();
    xcd_barrier(bar); TS(1);
    layer_body<0>(p, L, bar);
    layer_body<1>(p, L, bar);
    TS(11);
    if (PROBE_A >= 0 && blockIdx.x == 0 && threadIdx.x == 0) { const unsigned long long d = *(volatile LAS unsigned long long*)(L + 139288), t0 = __builtin_amdgcn_s_memrealtime(); while (__builtin_amdgcn_s_memrealtime() - t0 < 8ull * d) __builtin_amdgcn_s_sleep(8); }
}

extern "C" void kernel_launch(void* const* d_in, const int* in_sizes, int n_in, void* d_out, int out_size, void* d_ws, size_t ws_size, hipStream_t stream) {
    static int grid = 0;
    if (grid == 0) {
        if (n_in != 11 || in_sizes[0] != M * DM || out_size != M * DM || ws_size < WS_END) { fprintf(stderr, "kernel_launch: unexpected shapes (n_in %d, in0 %d, out %d, ws %zu)\n", n_in, n_in > 0 ? in_sizes[0] : -1, out_size, ws_size); grid = -1; return; }
        int dev = 0, cus = 0, per_cu = 0;
        hipGetDevice(&dev); hipDeviceGetAttribute(&cus, hipDeviceAttributeMultiprocessorCount, dev);
        if (hipFuncSetAttribute((const void*)fwd, hipFuncAttributeMaxDynamicSharedMemorySize, LDS_BYTES) != hipSuccess) { fprintf(stderr, "kernel_launch: hipFuncSetAttribute failed\n"); grid = -1; return; }
        if (hipOccupancyMaxActiveBlocksPerMultiprocessor(&per_cu, (const void*)fwd, 512, LDS_BYTES) != hipSuccess || per_cu < 1) { fprintf(stderr, "kernel_launch: occupancy query says %d\n", per_cu); per_cu = 1; }
        (void)hipGetLastError();
        grid = 256;
        if (cus != 256) fprintf(stderr, "kernel_launch: built for a 256-CU device, found %d CUs\n", cus);
        fprintf(stderr, "kernel_launch: cus %d per_cu %d grid %d\n", cus, per_cu, grid);
    }
    if (grid < 0) return;
    if (hipMemsetAsync((char*)d_ws + WS_CTL, 0, 65536, stream) != hipSuccess) { fprintf(stderr, "kernel_launch: memset failed\n"); return; }
    Params p{};
    for (int i = 0; i < 11; ++i) p.in[i] = (const float*)d_in[i];
    p.out = (float*)d_out; p.ws = (unsigned char*)d_ws;
    void* args[] = {&p};
    hipError_t e = hipLaunchCooperativeKernel((const void*)fwd, dim3(grid), dim3(512), args, LDS_BYTES, stream);
    if (e != hipSuccess) fprintf(stderr, "kernel_launch: cooperative launch failed: %s (grid %d)\n", hipGetErrorString(e), grid);
}
```

```cpp
#include <hip/hip_runtime.h>
#include <hip/hip_cooperative_groups.h>
#include <cstdio>
#include <cstdint>
namespace cg = cooperative_groups;
namespace pg8 {
#define PG8_LAS __attribute__((address_space(3)))
typedef unsigned short bf16_t;
typedef short bf16x8 __attribute__((ext_vector_type(8)));
typedef float f32x4 __attribute__((ext_vector_type(4)));
typedef unsigned u32x4 __attribute__((ext_vector_type(4)));
constexpr int BM = 256, BK = 64, HALF = 128, HTB = HALF * BK * 2  , STAGE_BYTES = 8 * HTB, NXCD = 8, WGM = 4;

__host__ __device__ __forceinline__ int lds_byte(int r, int c) { const int st = (r >> 4) * 2 + (c >> 5), rr = r & 15, cc = c & 31, ob = rr * 64 + cc * 2; return st * 1024 + (ob ^ (((ob >> 9) & 1) << 5)); }
__host__ __device__ __forceinline__ void stage_rc(int b, int& R, int& C) { const int st = b / 1024, sb = b % 1024, swz = sb ^ (((sb >> 9) & 1) << 5); R = (st >> 1) * 16 + swz / 64; C = (st & 1) * 32 + (swz % 64) / 2; }
__host__ __device__ __forceinline__ int perm32(int rho) { const int n = rho >> 4, i = rho & 15; return 8 * (i >> 2) + 4 * n + (i & 3); }

struct Unit { int pm, pn; };
struct Gemm { const bf16_t* A; const bf16_t* Bt; int M, N, K; };

struct StaticOrder {
    int nM, nN, nwg, G, c;
    __host__ __device__ void init(int M, int N, int G_, int c_) { nM = M / BM; nN = N / BM; nwg = nM * nN; G = G_; c = c_; }
    __host__ __device__ bool next(int i, Unit& u) const {
        const long L = (long)i * G + c; if (L >= nwg) return false;
        int wgid = (int)L; { const int q = nwg / NXCD, r = nwg % NXCD, xcd = wgid % NXCD, off = wgid / NXCD; wgid = (xcd < r ? xcd * (q + 1) : r * (q + 1) + (xcd - r) * q) + off; }
        const int nig = WGM * nN, gid = wgid / nig, fm = gid * WGM, gsz = (nM - fm) < WGM ? (nM - fm) : WGM;
        u.pm = fm + ((wgid % nig) % gsz); u.pn = (wgid % nig) / gsz; return true;
    }
    __device__ __forceinline__ void a_ready(const Unit&) const {}
    __device__ __forceinline__ void done(const Unit&) const {}
};

__device__ __forceinline__ unsigned cvt_pk_bf16(float lo, float hi) { unsigned r; asm volatile("v_cvt_pk_bf16_f32 %0, %1, %2" : "=v"(r) : "v"(lo), "v"(hi)); return r; }
__device__ __forceinline__ float silu_f(float x) { return x / (1.0f + __expf(-x)); }
__device__ __forceinline__ float silu_fast(float x) { return x * __builtin_amdgcn_rcpf(1.0f + __builtin_amdgcn_exp2f(x * -1.4426950408889634f)); }
struct EpiOut {
    static constexpr bool PERM = true, AFTER_DRAIN = false;
    bf16_t* O; int ldc; unsigned gate_mask;
    __device__ __forceinline__ void operator()(const f32x4 (&acc)[2][2][4][2], const Unit& u, int wr, int wc, int fr, int fq) const {
        const int row0 = u.pm * BM + wr * 64 + fr; const int col0 = u.pn * BM + wc * 32 + 8 * fq;
        const bool gate = (gate_mask >> u.pn) & 1u;
#pragma unroll
        for (int ai = 0; ai < 2; ++ai)
#pragma unroll
            for (int m = 0; m < 4; ++m) { bf16_t* rowp = O + (size_t)(row0 + ai * HALF + m * 16) * ldc + col0;
#pragma unroll
                for (int bj = 0; bj < 2; ++bj) { f32x4 v0 = acc[ai][bj][m][0], v1 = acc[ai][bj][m][1];
                    if (gate) { v0 = (f32x4){silu_fast(v0[0]), silu_fast(v0[1]), silu_fast(v0[2]), silu_fast(v0[3])}; v1 = (f32x4){silu_fast(v1[0]), silu_fast(v1[1]), silu_fast(v1[2]), silu_fast(v1[3])}; }
                    u32x4 w; w.x = cvt_pk_bf16(v0[0], v0[1]); w.y = cvt_pk_bf16(v0[2], v0[3]); w.z = cvt_pk_bf16(v1[0], v1[1]); w.w = cvt_pk_bf16(v1[2], v1[3]);
                    *(u32x4*)(rowp + bj * HALF) = w; } }
    }
};
template <class Epi, class Sched, bool ALIGN_EPI = false, bool SP2 = false>
__device__ __forceinline__ void gemm_phase(PG8_LAS unsigned char* lds, const Gemm g, const Sched& S, const Epi& E) {
    int tid_ = threadIdx.x; asm volatile("" : "+v"(tid_));
    const int tid = tid_, wid = __builtin_amdgcn_readfirstlane(tid >> 6), lane = tid & 63, wr = wid >> 2, wc = wid & 3, fr = lane & 15, fq = lane >> 4;
    const int K = g.K, nt = K / BK;
    unsigned voffA[2], voffB[2];
#pragma unroll
    for (int i = 0; i < 2; ++i) { int R, C; stage_rc(tid * 16 + i * 8192, R, C); const int Rb = Epi::PERM ? ((R & ~31) + perm32(R & 31)) : R;
        voffA[i] = (unsigned)(R * K + C) * 2u; voffB[i] = (unsigned)(Rb * K + C) * 2u; }
    const size_t kstep = (size_t)(BK * 2);
    const size_t hstep = (size_t)HALF * K * 2;
    const size_t tstep = 2 * hstep;
    const unsigned ldsw = (unsigned)wid * 1024u;
    const int aoff = lds_byte(wr * 64 + fr, fq * 8), boff = lds_byte(wc * 32 + fr, fq * 8);
#define PG8_SA(b, h) (((b) * 2 + (h)) * HTB)
#define PG8_SB(b, h) ((4 + (b) * 2 + (h)) * HTB)
#define PG8_STAGE(bufoff, gbase, voff) do { _Pragma("unroll") for (int _i = 0; _i < 2; ++_i) \
        __builtin_amdgcn_global_load_lds((const unsigned*)((const char*)(gbase) + (voff)[_i]), (PG8_LAS unsigned*)(lds + (bufoff) + ldsw + _i * 8192), 16, 0, 0); } while (0)
#define PG8_LDA(dst, b, h) do { _Pragma("unroll") for (int m = 0; m < 4; ++m) _Pragma("unroll") for (int k = 0; k < 2; ++k) dst[m][k] = *(const PG8_LAS bf16x8*)(lds + PG8_SA(b, h) + aoff + m * 2048 + k * 1024); } while (0)
#define PG8_LDB(dst, b, h) do { _Pragma("unroll") for (int n = 0; n < 2; ++n) _Pragma("unroll") for (int k = 0; k < 2; ++k) dst[n][k] = *(const PG8_LAS bf16x8*)(lds + PG8_SB(b, h) + boff + n * 2048 + k * 1024); } while (0)
#define PG8_MMA(ai, bj, At, Bt) do { __builtin_amdgcn_s_setprio(1); _Pragma("unroll") for (int m = 0; m < 4; ++m) _Pragma("unroll") for (int n = 0; n < 2; ++n) _Pragma("unroll") for (int k = 0; k < 2; ++k) \
        acc[ai][bj][m][n] = __builtin_amdgcn_mfma_f32_16x16x32_bf16(Bt[n][k], At[m][k], acc[ai][bj][m][n], 0, 0, 0); __builtin_amdgcn_s_setprio(0); } while (0)
#define PG8_WAIT_V(n) asm volatile("s_waitcnt vmcnt(" #n ")" ::: "memory")
#define PG8_WAIT_L(n) asm volatile("s_waitcnt lgkmcnt(" #n ")" ::: "memory")
#define PG8_BAR __builtin_amdgcn_s_barrier()
#define PG8_SCHED __builtin_amdgcn_sched_barrier(0)
    Unit cur, nxt; int ui = 0;
    if (!S.next(0, cur)) return;
    f32x4 acc[2][2][4][2];
#pragma unroll
    for (int a = 0; a < 2; ++a)
#pragma unroll
        for (int b = 0; b < 2; ++b)
#pragma unroll
            for (int m = 0; m < 4; ++m)
#pragma unroll
                for (int n = 0; n < 2; ++n) acc[a][b][m][n] = (f32x4){0.f, 0.f, 0.f, 0.f};
    bf16x8 At[4][2], B0[2][2], B1[2][2];
    const char* cA = (const char*)g.A + (size_t)cur.pm * tstep; const char* cB = (const char*)g.Bt + (size_t)cur.pn * tstep;
    S.a_ready(cur);
    if constexpr (SP2) {
        PG8_STAGE(PG8_SB(0, 0), cB, voffB); PG8_STAGE(PG8_SB(0, 1), cB + hstep, voffB); PG8_STAGE(PG8_SA(0, 0), cA, voffA); PG8_STAGE(PG8_SA(0, 1), cA + hstep, voffA);
        if (wr == 1) PG8_BAR;
        PG8_WAIT_V(2); PG8_BAR;
        PG8_STAGE(PG8_SB(1, 0), cB + kstep, voffB); PG8_STAGE(PG8_SA(1, 0), cA + kstep, voffA); PG8_STAGE(PG8_SB(1, 1), cB + hstep + kstep, voffB);
        PG8_WAIT_V(6); PG8_BAR;
    } else {
        PG8_STAGE(PG8_SB(0, 0), cB, voffB); PG8_STAGE(PG8_SA(0, 0), cA, voffA); PG8_STAGE(PG8_SB(0, 1), cB + hstep, voffB); PG8_STAGE(PG8_SA(0, 1), cA + hstep, voffA);
        if (wr == 1) PG8_BAR;
        PG8_WAIT_V(4); PG8_BAR;
        PG8_STAGE(PG8_SB(1, 0), cB + kstep, voffB); PG8_STAGE(PG8_SA(1, 0), cA + kstep, voffA); PG8_STAGE(PG8_SB(1, 1), cB + hstep + kstep, voffB);
        PG8_WAIT_V(6); PG8_BAR;
    }
    for (;;) {
        const bool has_next = S.next(ui + 1, nxt);
        const char* nA = has_next ? (const char*)g.A + (size_t)nxt.pm * tstep : cA; const char* nB = has_next ? (const char*)g.Bt + (size_t)nxt.pn * tstep : cB;
        for (int t = 0; t < nt; t += 2) {
            const bool last = (t == nt - 2);
            const char* a1 = cA + (size_t)(t + 1) * kstep;
            const char* a2 = last ? nA : cA + (size_t)(t + 2) * kstep; const char* b2 = last ? nB : cB + (size_t)(t + 2) * kstep;
            const char* a3 = a2 + kstep; const char* b3 = b2 + kstep;
            if (last && has_next) S.a_ready(nxt);
            if constexpr (SP2) {
            PG8_LDB(B0, 0, 0); PG8_LDB(B1, 0, 1); PG8_SCHED; PG8_LDA(At, 0, 0); PG8_STAGE(PG8_SA(1, 1), a1 + hstep, voffA);
            PG8_WAIT_V(8); PG8_WAIT_L(0); PG8_BAR; PG8_MMA(0, 0, At, B0); PG8_MMA(0, 1, At, B1); PG8_BAR; PG8_SCHED;
            PG8_LDA(At, 0, 1); PG8_STAGE(PG8_SB(0, 0), b2, voffB); PG8_STAGE(PG8_SB(0, 1), b2 + hstep, voffB); PG8_STAGE(PG8_SA(0, 0), a2, voffA);
            PG8_WAIT_V(8); PG8_WAIT_L(0); PG8_BAR; PG8_MMA(1, 0, At, B0); PG8_MMA(1, 1, At, B1); PG8_BAR; PG8_SCHED;
            PG8_LDB(B0, 1, 0); PG8_LDB(B1, 1, 1); PG8_SCHED; PG8_LDA(At, 1, 0); PG8_STAGE(PG8_SA(0, 1), a2 + hstep, voffA);
            PG8_WAIT_V(8); PG8_WAIT_L(0); PG8_BAR; PG8_MMA(0, 0, At, B0); PG8_MMA(0, 1, At, B1); PG8_BAR; PG8_SCHED;
            PG8_LDA(At, 1, 1); PG8_STAGE(PG8_SB(1, 0), b3, voffB); PG8_STAGE(PG8_SB(1, 1), b3 + hstep, voffB); PG8_STAGE(PG8_SA(1, 0), a3, voffA);
            PG8_WAIT_V(8); PG8_WAIT_L(0); PG8_BAR; PG8_MMA(1, 0, At, B0); PG8_MMA(1, 1, At, B1); PG8_BAR; PG8_SCHED;
            } else {
            PG8_LDB(B0, 0, 0); PG8_SCHED; PG8_LDA(At, 0, 0); PG8_STAGE(PG8_SA(1, 1), a1 + hstep, voffA);
            PG8_WAIT_L(8); PG8_BAR; PG8_WAIT_L(0); PG8_MMA(0, 0, At, B0); PG8_BAR; PG8_SCHED;
            PG8_LDB(B1, 0, 1); PG8_STAGE(PG8_SB(0, 0), b2, voffB);
            PG8_BAR; PG8_WAIT_L(0); PG8_MMA(0, 1, At, B1); PG8_BAR;
            PG8_LDA(At, 0, 1); PG8_STAGE(PG8_SA(0, 0), a2, voffA);
            PG8_BAR; PG8_WAIT_L(0); PG8_MMA(1, 0, At, B0); PG8_BAR; PG8_SCHED;
            PG8_STAGE(PG8_SB(0, 1), b2 + hstep, voffB);
            PG8_WAIT_V(6); PG8_BAR; PG8_MMA(1, 1, At, B1); PG8_BAR;
            PG8_LDB(B0, 1, 0); PG8_SCHED; PG8_LDA(At, 1, 0); PG8_STAGE(PG8_SA(0, 1), a2 + hstep, voffA);
            PG8_WAIT_L(8); PG8_BAR; PG8_WAIT_L(0); PG8_MMA(0, 0, At, B0); PG8_BAR; PG8_SCHED;
            PG8_LDB(B1, 1, 1); PG8_STAGE(PG8_SB(1, 0), b3, voffB);
            PG8_BAR; PG8_WAIT_L(0); PG8_MMA(0, 1, At, B1); PG8_BAR;
            PG8_LDA(At, 1, 1); PG8_STAGE(PG8_SA(1, 0), a3, voffA);
            PG8_BAR; PG8_WAIT_L(0); PG8_MMA(1, 0, At, B0); PG8_BAR; PG8_SCHED;
            PG8_STAGE(PG8_SB(1, 1), b3 + hstep, voffB);
            PG8_WAIT_V(6); PG8_BAR; PG8_MMA(1, 1, At, B1); PG8_BAR;
            }
        }
        if constexpr (ALIGN_EPI) { if (wr == 0) PG8_BAR; }
        if constexpr (!Epi::AFTER_DRAIN) { E(acc, cur, wr, wc, fr, fq); S.done(cur); }
        if (!has_next) break;
#pragma unroll
        for (int a = 0; a < 2; ++a)
#pragma unroll
            for (int b = 0; b < 2; ++b)
#pragma unroll
                for (int m = 0; m < 4; ++m)
#pragma unroll
                    for (int n = 0; n < 2; ++n) acc[a][b][m][n] = (f32x4){0.f, 0.f, 0.f, 0.f};
        cur = nxt; cA = nA; cB = nB; ++ui;
        if constexpr (ALIGN_EPI) { if (wr == 1) PG8_BAR; }
    }
    PG8_WAIT_V(0);
    if constexpr (!ALIGN_EPI) { if (wr == 0) PG8_BAR; }
    PG8_BAR;
    if constexpr (Epi::AFTER_DRAIN) { E.fused(acc, cur, wr, wc, fr, fq, lds, wid, lane); S.done(cur); }
#undef PG8_SA
#undef PG8_SB
#undef PG8_STAGE
#undef PG8_LDA
#undef PG8_LDB
#undef PG8_MMA
#undef PG8_WAIT_V
#undef PG8_WAIT_L
#undef PG8_BAR
#undef PG8_SCHED
}
}
#define LAS __attribute__((address_space(3)))
typedef unsigned short bf16;
typedef unsigned v4u __attribute__((ext_vector_type(4)));
typedef unsigned v2u __attribute__((ext_vector_type(2)));
typedef float f32x4 __attribute__((ext_vector_type(4)));
constexpr int SEQ = 4096, BATCH = 8, DM = 1024, M = BATCH * SEQ, NIN = 3328, DEPTH = 2;
constexpr float EPS = 1e-6f;
constexpr float LOG2E = 1.4426950408889634f;
constexpr float QSCALE = 0.125f * LOG2E;
constexpr int C_AQ = 0, C_AK = 256, C_AV = 512, C_AG = 768, C_BU = 1024, C_BV = 1280, C_BG = 1536, C_CX = 1792, C_CG = 2048, C_DQ = 2304, C_DK = 2560, C_DV = 2816, C_DG = 3072;
constexpr size_t MiB = 1u << 20;
constexpr size_t WS_WIN = 0, WS_WOUT = 13 * MiB, WS_SMALL = 17 * MiB, WS_XB = 18 * MiB, WS_PROJ = 82 * MiB, WS_Y = 290 * MiB, WS_Z = 354 * MiB, WS_OG = 418 * MiB, WS_LSE = 466 * MiB, WS_KV = 468 * MiB, WS_R0 = 484 * MiB, WS_CTL = 490 * MiB, WS_PREV = 491 * MiB, WS_RS = 499 * MiB, WS_END = 500 * MiB;
constexpr size_t R0_PPART = 0, R0_Y = 4 * MiB, R0_H = R0_Y + 65536, R0_ZPART = 5 * MiB;
constexpr int R0_KC = 16, R0_KCZ = 8;
constexpr int LDS_BYTES = 147456;
constexpr size_t WS_SGUWB = WS_SMALL + 704 * 1024, WS_PWT = WS_SMALL + 960 * 1024;
constexpr int P_PREG = 0, P_SGUG = 2048, P_SGUW = 2560, P_SGUB = 133632, P_POOLW = 134656, P_POOLS = 167424, P_RETG = 167936, P_POSTG = 168448, P_END = 170496;

__device__ __forceinline__ float bf2f(unsigned short u) { return __uint_as_float(((unsigned)u) << 16); }
__device__ __forceinline__ unsigned f2bf(float f) { unsigned u = __float_as_uint(f); return (u + 0x7fffu + ((u >> 16) & 1u)) >> 16; }
__device__ __forceinline__ unsigned pk2(float lo, float hi) { return f2bf(lo) | (f2bf(hi) << 16); }
__device__ __forceinline__ float wave_sum(float v) {
#pragma unroll
    for (int o = 1; o < 64; o <<= 1) v += __shfl_xor(v, o);
    return v;
}
#define LDS_WAIT() asm volatile("s_waitcnt lgkmcnt(0)" ::: "memory")

struct Params { const float* in[11]; float* out; unsigned char* ws; };

__device__ __forceinline__ void p0_transpose_item(const float* W, int K, int N, bf16* WT, const float* rs, int col_mode, LAS float* scr, int item, int lane) {
    const int nblk = N / 32, kb = item / nblk, nb = item % nblk, k0 = 64 * kb, n0 = 32 * nb;
    float cs = 1.f;
    if (col_mode) { const int n = n0 + (lane & 31); if (n < 256) cs = QSCALE; else if (n >= C_DK && n < C_DK + 256) cs = 0.125f; }
#pragma unroll
    for (int i = 0; i < 32; ++i) { const int kk = 2 * i + (lane >> 5); float v = W[(size_t)(k0 + kk) * N + n0 + (lane & 31)] * cs; if (rs) v *= rs[k0 + kk]; scr[kk * 33 + (lane & 31)] = v; }
    LDS_WAIT(); asm volatile("" ::: "memory");
    const int c = lane & 7;
#pragma unroll
    for (int j = 0; j < 4; ++j) { const int n = (lane >> 3) + 8 * j; const LAS float* s = scr + (8 * c) * 33 + n;
        v4u o; o.x = pk2(s[0 * 33], s[1 * 33]); o.y = pk2(s[2 * 33], s[3 * 33]); o.z = pk2(s[4 * 33], s[5 * 33]); o.w = pk2(s[6 * 33], s[7 * 33]);
        *(v4u*)(WT + (size_t)(n0 + n) * K + k0 + 8 * c) = o; }
    LDS_WAIT(); asm volatile("" ::: "memory");
}

__device__ __forceinline__ void unpack4(const v2u w, f32x4& o) { o = (f32x4){bf2f((unsigned short)(w.x & 0xffff)), bf2f((unsigned short)(w.x >> 16)), bf2f((unsigned short)(w.y & 0xffff)), bf2f((unsigned short)(w.y >> 16))}; }
__device__ __forceinline__ float ssq4(const f32x4 (&v)[4]) { float s = 0.f;
#pragma unroll
    for (int j = 0; j < 4; ++j) s += (v[j].x * v[j].x + v[j].y * v[j].y) + (v[j].z * v[j].z + v[j].w * v[j].w);
    return s; }
__device__ __forceinline__ void r0z_sum(const float* r0z, int lane, f32x4 (&z)[4]) {
#pragma unroll
    for (int j = 0; j < 4; ++j) { asm volatile("" ::: "memory"); f32x4 a = (f32x4){0.f, 0.f, 0.f, 0.f};
#pragma unroll
        for (int kc = 0; kc < R0_KCZ; ++kc) a += *((const f32x4*)(r0z + (size_t)kc * 8 * DM) + lane + 64 * j);
        z[j] = a; }
}

__device__ __forceinline__ float rdl(float v, int l) { return __int_as_float(__builtin_amdgcn_readlane(__float_as_int(v), l)); }
template <int NB  >
__device__ __forceinline__ void r0_dot_task(const float* h, const float* W, int N, float* part, int task, int nchunks, int lane) {
    const int ch = task % nchunks, kc = task / nchunks, n0 = ch * 64;
    float acc[8];
#pragma unroll
    for (int b = 0; b < 8; ++b) acc[b] = 0.f;
#pragma unroll 1
    for (int sb = 0; sb < NB; ++sb) { const int k0 = (kc * NB + sb) * 32;
        float hv[4], w[32];
#pragma unroll
        for (int i = 0; i < 4; ++i) { const int idx = lane + 64 * i; hv[i] = h[(idx >> 5) * DM + k0 + (idx & 31)]; }
#pragma unroll
        for (int kk = 0; kk < 32; ++kk) w[kk] = W[(size_t)(k0 + kk) * N + n0 + lane];
#pragma unroll
        for (int kk = 0; kk < 32; ++kk)
#pragma unroll
            for (int b = 0; b < 8; ++b) acc[b] += rdl(hv[b >> 1], (b & 1) * 32 + kk) * w[kk]; }
#pragma unroll
    for (int b = 0; b < 8; ++b) part[((size_t)kc * 8 + b) * N + n0 + lane] = acc[b];
}
__device__ __forceinline__ void r0_dot_sub(const float* h, const float* W, int N, int task, int nchunks, int sb, int lane, float (&acc)[8]) {
    const int ch = task % nchunks, kc = task / nchunks, n0 = ch * 64; const int k0 = (kc * 4 + sb) * 32;
    float hv[4], w[32];
#pragma unroll
    for (int i = 0; i < 4; ++i) { const int idx = lane + 64 * i; hv[i] = h[(idx >> 5) * DM + k0 + (idx & 31)]; }
#pragma unroll
    for (int kk = 0; kk < 32; ++kk) w[kk] = W[(size_t)(k0 + kk) * N + n0 + lane];
#pragma unroll
    for (int b = 0; b < 8; ++b) acc[b] = 0.f;
#pragma unroll
    for (int kk = 0; kk < 32; ++kk)
#pragma unroll
        for (int b = 0; b < 8; ++b) acc[b] += rdl(hv[b >> 1], (b & 1) * 32 + kk) * w[kk];
}
using pg8::silu_f;
__device__ __forceinline__ void r0_mix(const float* ppart, float* y0, int b, const float* sgu_g, const float* sgu_w, const float* sgu_b, const float* ret_g, LAS float* P, int tid) {
#pragma unroll 2
    for (int n = tid; n < NIN; n += 512) { float a = 0.f;
#pragma unroll
        for (int kc = 0; kc < R0_KC; ++kc) a += ppart[((size_t)kc * 8 + b) * NIN + n];
        P[n] = a; }
    __syncthreads();
    if (tid < 256) { const int lane = tid & 63;
        float sm = 0.f;
#pragma unroll
        for (int i = 0; i < 4; ++i) sm += P[C_BV + lane + 64 * i];
        const float mean = wave_sum(sm) * (1.f / 256.f); float sq = 0.f;
#pragma unroll
        for (int i = 0; i < 4; ++i) { const float d = P[C_BV + lane + 64 * i] - mean; sq += d * d; }
        const float rstd = 1.f / sqrtf(wave_sum(sq) * (1.f / 256.f) + EPS);
        { const int i = tid >> 6; const int c = lane + 64 * i;
            y0[b * DM + c] = P[C_AV + c] * silu_f(P[C_AG + c]);
            const float mixed = sgu_w[(size_t)i * 16384] * ((P[C_BV + c] - mean) * rstd * sgu_g[c]) + sgu_b[i * 128];
            y0[b * DM + 256 + c] = P[C_BU + c] * mixed * silu_f(P[C_BG + c]);
            y0[b * DM + 512 + c] = 0.f;
            const float cc = wave_sum(P[C_DQ + c] * P[C_DK + c]) * 0.125f; const float of = cc * P[C_DV + c];
            const float mu = wave_sum(of) * (1.f / 64.f); const float d0 = of - mu; const float var = wave_sum(d0 * d0) * (1.f / 64.f);
            y0[b * DM + 768 + c] = d0 / sqrtf(var + EPS) * ret_g[c] * silu_f(P[C_DG + c]); } }
    __syncthreads();
}

#define XB_TMO      128
#define XB_XCNT(j)  (256  + 64 * (j))
#define XB_XSUB(j)  (1280 + 64 * (j))
#define XB_XGEN(j)  (2304 + 64 * (j))
#define XB_TOP      3328
#define XB_TOPGEN   3392
#define XCD_BAR_WORDS 3456
#define XB_SPIN_CAP (1u << 18)

__device__ __forceinline__ unsigned xb_ld(unsigned* p)              { return __hip_atomic_load(p, __ATOMIC_RELAXED, __HIP_MEMORY_SCOPE_AGENT); }
__device__ __forceinline__ unsigned xb_add(unsigned* p, unsigned v) { return __hip_atomic_fetch_add(p, v, __ATOMIC_RELAXED, __HIP_MEMORY_SCOPE_AGENT); }
__device__ __forceinline__ unsigned xb_xcc_id() { return (unsigned)__builtin_amdgcn_s_getreg((3 << 11) | 20) & 0xFu; }
#define XB_SPIN(cond, bar) do { unsigned _sp = 0; while (cond) { \
    if ((++_sp & 255u) == 0u) { if (xb_ld(&(bar)[XB_TMO])) break; if (_sp > XB_SPIN_CAP) { atomicAdd(&(bar)[XB_TMO], 1u); break; } } } } while (0)

struct XcdBarrier {
    unsigned* bar; unsigned x;
    volatile LAS unsigned* st;
};

__device__ __forceinline__ XcdBarrier xcd_barrier_post(unsigned* bar, volatile LAS unsigned* st) {
    XcdBarrier b; b.bar = bar; b.x = xb_xcc_id(); b.st = st;
    if (threadIdx.x == 0) (void)xb_add(&bar[XB_XCNT(b.x)], 1u);
    return b;
}
__device__ __forceinline__ void xcd_barrier_complete(unsigned* bar, unsigned x, unsigned& nloc, unsigned& nx) {
    const unsigned G = gridDim.x * gridDim.y * gridDim.z;
    unsigned sum, cnt, mine, sp = 0u;
    for (;;) {
        sum = 0u; cnt = 0u; mine = 0u;
#pragma unroll
        for (unsigned j = 0; j < 16; ++j) { const unsigned c = xb_ld(&bar[XB_XCNT(j)]); sum += c; cnt += (c > 0u) ? 1u : 0u; mine = (j == x) ? c : mine; }
        if (sum == G) break;
        __builtin_amdgcn_s_sleep(1);
        if ((++sp & 255u) == 0u) { if (xb_ld(&bar[XB_TMO])) break; if (sp > XB_SPIN_CAP) { atomicAdd(&bar[XB_TMO], 1u); break; } }
    }
    nloc = mine > 0u ? mine : 1u; nx = cnt > 0u ? cnt : 1u;
}

__device__ __forceinline__ void xcd_barrier(const XcdBarrier& b) {
    asm volatile("s_waitcnt vmcnt(0)" ::: "memory");
    __syncthreads();
    if (threadIdx.x == 0) {
        size_t z0_ = 0; asm volatile("" : "+s"(z0_)); unsigned* bar = b.bar + z0_;
        const unsigned bx = xb_xcc_id();
        __builtin_amdgcn_s_waitcnt(0);
        unsigned nloc = b.st[0], nx = b.st[1];
        if (nloc == 0u) { xcd_barrier_complete(bar, bx, nloc, nx); b.st[0] = nloc; b.st[1] = nx; }
        const unsigned old = xb_add(&bar[XB_XSUB(bx)], 1u);
        const unsigned gen = old / nloc;
        if (old + 1u == (gen + 1u) * nloc) {
            __builtin_amdgcn_fence(__ATOMIC_RELEASE, "agent");
            asm volatile("s_waitcnt vmcnt(0)" ::: "memory");
            const unsigned og = xb_add(&bar[XB_TOP], 1u);
            const unsigned tg = og / nx;
            if (og + 1u == (tg + 1u) * nx) xb_add(&bar[XB_TOPGEN], 1u);
            else XB_SPIN(xb_ld(&bar[XB_TOPGEN]) == tg, bar);
            __builtin_amdgcn_fence(__ATOMIC_ACQUIRE, "agent");
            xb_add(&bar[XB_XGEN(bx)], 1u);
            asm volatile("s_waitcnt vmcnt(0)" ::: "memory");
        } else {
            XB_SPIN(xb_ld(&bar[XB_XGEN(bx)]) == gen, bar);
            __builtin_amdgcn_fence(__ATOMIC_ACQUIRE, "agent");
            asm volatile("s_waitcnt vmcnt(0)" ::: "memory");
        }
    }
    __syncthreads();
}


typedef short bf16x8 __attribute__((ext_vector_type(8)));
typedef float f32x16 __attribute__((ext_vector_type(16)));
typedef float f32x2 __attribute__((ext_vector_type(2)));
typedef __bf16 bf16x2_t __attribute__((ext_vector_type(2)));
__device__ __forceinline__ unsigned cvtpk(float lo, float hi) { f32x2 v = {lo, hi}; return __builtin_bit_cast(unsigned, __builtin_convertvector(v, bf16x2_t)); }
#define MFMA32(a, b, c) __builtin_amdgcn_mfma_f32_32x32x16_bf16((a), (b), (c), 0, 0, 0)
#define PACK8(x, s) __builtin_bit_cast(bf16x8, (v4u){cvtpk((x)[8 * (s)], (x)[8 * (s) + 1]), cvtpk((x)[8 * (s) + 2], (x)[8 * (s) + 3]), cvtpk((x)[8 * (s) + 4], (x)[8 * (s) + 5]), cvtpk((x)[8 * (s) + 6], (x)[8 * (s) + 7])})
__device__ __forceinline__ int crow(int reg, int h) { return (reg & 3) + 8 * (reg >> 2) + 4 * h; }
__device__ __forceinline__ int keyperm(int k) { return (k & ~12) | ((k & 4) << 1) | ((k & 8) >> 1); }
constexpr int KP = 144;
__device__ __forceinline__ int vt_off(int d, int kp, int VP) { return d * VP + ((((kp >> 3) ^ ((d >> 3) & 7))) << 4) + ((kp & 7) << 1); }
__device__ __forceinline__ void vt_write8(LAS unsigned char* Vt, int VP, int c  , int kp, v4u v) {
    LAS unsigned char* base = Vt + (((kp >> 3) ^ c) << 4) + ((kp & 7) << 1) + (8 * c) * VP;
    *(LAS unsigned short*)(base + 0 * VP) = (unsigned short)(v.x & 0xffff); *(LAS unsigned short*)(base + 1 * VP) = (unsigned short)(v.x >> 16);
    *(LAS unsigned short*)(base + 2 * VP) = (unsigned short)(v.y & 0xffff); *(LAS unsigned short*)(base + 3 * VP) = (unsigned short)(v.y >> 16);
    *(LAS unsigned short*)(base + 4 * VP) = (unsigned short)(v.z & 0xffff); *(LAS unsigned short*)(base + 5 * VP) = (unsigned short)(v.z >> 16);
    *(LAS unsigned short*)(base + 6 * VP) = (unsigned short)(v.w & 0xffff); *(LAS unsigned short*)(base + 7 * VP) = (unsigned short)(v.w >> 16);
}

struct AttnU { int b, h, g, dil, res, Q0; };
__device__ __forceinline__ AttnU attn_decode(int u) { AttnU a; const int w16 = u & 15; int t = u >> 4; a.g = t % 3; t /= 3; a.h = t & 3; a.b = t >> 2; a.dil = 1 << (2 * a.g); a.res = w16 & (a.dil - 1); a.Q0 = (w16 >> (2 * a.g)) * 256; return a; }
__device__ __forceinline__ void attn_load(const bf16* proj, const AttnU& a, int tid, v4u (&pk)[6], v4u (&pv)[6]) {
#pragma unroll
    for (int it = 0; it < 6; ++it) { const int idx = tid + it * 512; const int key = idx >> 3, c = idx & 7, i = a.Q0 - 128 + key;
        if (i >= 0) { const bf16* src = proj + ((size_t)a.b * SEQ + (size_t)i * a.dil + a.res) * NIN + a.h * 64 + c * 8; pk[it] = *(const v4u*)(src + C_AK); pv[it] = *(const v4u*)(src + C_AV); } }
}
__device__ __forceinline__ void attn_phase(const bf16* proj, bf16* og, float* lse, int u0, int ustride, int nunits, LAS unsigned char* L, int tid) {
    const int lane = tid & 63, wave = tid >> 6, wave_u = __builtin_amdgcn_readfirstlane(tid >> 6);
    constexpr int VP = 784;
    LAS unsigned char* Kimg = L; LAS unsigned char* Vt = L + 384 * KP;
    v4u pk[6], pv[6];
    if (u0 < nunits) { const AttnU a0 = attn_decode(u0); attn_load(proj, a0, tid, pk, pv); }
#pragma unroll 1
    for (int u = u0; u < nunits; u += ustride) {
        const AttnU a = attn_decode(u);
        const int r = lane & 31, hh = lane >> 5;
        const size_t rowbase = (size_t)a.b * SEQ;
        const size_t qrow = rowbase + (size_t)(a.Q0 + 32 * wave + r) * a.dil + a.res;
        bf16x8 qf[4];
#pragma unroll
        for (int s = 0; s < 4; ++s) qf[s] = *(const bf16x8*)(proj + qrow * NIN + C_AQ + a.h * 64 + 16 * s + 8 * hh);
#pragma unroll
        for (int it = 0; it < 6; ++it) { const int idx = tid + it * 512; const int key = idx >> 3, c = idx & 7, i = a.Q0 - 128 + key;
            if (i >= 0) { *(LAS v4u*)(Kimg + key * KP + c * 16) = pk[it]; vt_write8(Vt, VP, c, keyperm(key), pv[it]); } }
        __syncthreads();
        if (u + ustride < nunits) { const AttnU an = attn_decode(u + ustride); attn_load(proj, an, tid, pk, pv); }
        {
            const float slope2 = exp2f(-2.0f * (float)(a.h + 1)) * LOG2E * (float)a.dil;
            const int jt0 = (a.Q0 == 0 && wave_u < 4) ? 4 - wave_u : 0;
            float mx = -INFINITY, l = 0.f;
            f32x16 O[2];
#pragma unroll
            for (int i = 0; i < 16; ++i) { O[0][i] = 0.f; O[1][i] = 0.f; }
            const LAS unsigned char* kb = Kimg + (32 * wave + r) * KP + 16 * hh;
            bf16x8 kf[4];
#pragma unroll
            for (int s = 0; s < 4; ++s) kf[s] = *(const LAS bf16x8*)(kb + jt0 * (32 * KP) + 32 * s);
#pragma unroll 1
            for (int jt = jt0; jt < 5; ++jt) {
                f32x16 acc;
#pragma unroll
                for (int i = 0; i < 16; ++i) acc[i] = 0.f;
#pragma unroll
                for (int s = 0; s < 4; ++s) acc = MFMA32(kf[s], qf[s], acc);
                if (jt + 1 < 5) {
#pragma unroll
                    for (int s = 0; s < 4; ++s) kf[s] = *(const LAS bf16x8*)(kb + (jt + 1) * (32 * KP) + 32 * s); }
                const float bq = slope2 * (float)(128 + r - 32 * jt); float tmax = -INFINITY;
#pragma unroll
                for (int i = 0; i < 16; ++i) { const int kk = crow(i, hh); float v = acc[i] - bq + slope2 * (float)kk;
                    if (jt == 0 && kk < r) v = -INFINITY; if (jt == 4 && kk > r) v = -INFINITY; acc[i] = v; tmax = fmaxf(tmax, v); }
                tmax = fmaxf(tmax, __shfl_xor(tmax, 32));
                const float mn = fmaxf(mx, tmax), corr = __builtin_amdgcn_exp2f(mx - mn);
                l *= corr;
#pragma unroll
                for (int i = 0; i < 16; ++i) { O[0][i] *= corr; O[1][i] *= corr; }
#pragma unroll
                for (int i = 0; i < 16; ++i) { const float pvv = __builtin_amdgcn_exp2f(acc[i] - mn); acc[i] = pvv; l += pvv; }
                mx = mn;
                const int T = wave + jt;
#pragma unroll
                for (int s = 0; s < 2; ++s) { const bf16x8 pf = PACK8(acc, s);
#pragma unroll
                    for (int dt = 0; dt < 2; ++dt) { const int d = 32 * dt + r, G = 4 * T + 2 * s + hh;
                        const bf16x8 vf = *(const LAS bf16x8*)(Vt + d * VP + ((G ^ ((d >> 3) & 7)) << 4)); O[dt] = MFMA32(vf, pf, O[dt]); } }
            }
            l += __shfl_xor(l, 32);
            const float inv = 1.0f / l;
            bf16* orow = og + ((size_t)a.g * M + qrow) * 256 + a.h * 64;
#pragma unroll
            for (int dt = 0; dt < 2; ++dt)
#pragma unroll
                for (int i4 = 0; i4 < 4; ++i4) { v2u w; w.x = cvtpk(O[dt][4 * i4] * inv, O[dt][4 * i4 + 1] * inv); w.y = cvtpk(O[dt][4 * i4 + 2] * inv, O[dt][4 * i4 + 3] * inv);
                    *(v2u*)(orow + 32 * dt + 8 * i4 + 4 * hh) = w; }
            if (hh == 0) lse[((size_t)a.g * M + qrow) * 4 + a.h] = mx + __builtin_amdgcn_logf(l);
        }
        __syncthreads();
    }
}
__device__ __forceinline__ void attn_combine(const bf16* proj, const bf16* og, const float* lse, bf16* y, int gtid, int gthreads, int iend) {
#pragma unroll 4
    for (int idx = gtid; idx < iend; idx += gthreads) { const int row = idx >> 5, hc = idx & 31, h = hc >> 3, c = hc & 7;
        const size_t off = (size_t)row * 256 + h * 64 + c * 8;
        const float l0 = lse[(size_t)row * 4 + h], l1 = lse[((size_t)M + row) * 4 + h], l2 = lse[((size_t)2 * M + row) * 4 + h];
        const v4u a0 = __builtin_nontemporal_load((const v4u*)(og + off)), a1 = __builtin_nontemporal_load((const v4u*)(og + (size_t)M * 256 + off)), a2 = __builtin_nontemporal_load((const v4u*)(og + (size_t)2 * M * 256 + off));
        const v4u gt = *(const v4u*)(proj + (size_t)row * NIN + C_AG + h * 64 + c * 8);
        const float mx = fmaxf(l0, fmaxf(l1, l2)); float w0 = __builtin_amdgcn_exp2f(l0 - mx), w1 = __builtin_amdgcn_exp2f(l1 - mx), w2 = __builtin_amdgcn_exp2f(l2 - mx);
        const float inv = 1.0f / (w0 + w1 + w2); w0 *= inv; w1 *= inv; w2 *= inv;
        v4u o;
#define CMB(f) { const float e0 = (w0 * bf2f((unsigned short)(a0.f & 0xffff)) + w1 * bf2f((unsigned short)(a1.f & 0xffff)) + w2 * bf2f((unsigned short)(a2.f & 0xffff))) * bf2f((unsigned short)(gt.f & 0xffff)); \
                 const float e1 = (w0 * bf2f((unsigned short)(a0.f >> 16)) + w1 * bf2f((unsigned short)(a1.f >> 16)) + w2 * bf2f((unsigned short)(a2.f >> 16))) * bf2f((unsigned short)(gt.f >> 16)); o.f = cvtpk(e0, e1); }
        CMB(x) CMB(y) CMB(z) CMB(w)
#undef CMB
        *(v4u*)(y + (size_t)row * DM + h * 64 + c * 8) = o; }
}

__device__ __forceinline__ void retkv_pair(const bf16* proj, float* kvT, int pair, LAS unsigned char* L, int tid) {
    const int half = tid >> 8, t256 = tid & 255, lane = tid & 63, w4 = (tid >> 6) & 3;
    const int uu = pair * 2 + half, n = uu & 31, h = (uu >> 5) & 3, b = uu >> 7;
    constexpr int VP = 272;
    LAS unsigned char* Vt = L + half * (2 * 64 * VP); LAS unsigned char* Kz = Vt + 64 * VP;
    const float lg2 = __builtin_amdgcn_logf(1.0f - exp2f(-5.0f - (float)h));
    const size_t row0 = (size_t)b * SEQ + n * 128;
#pragma unroll
    for (int it = 0; it < 4; ++it) { const int idx = t256 + it * 256, j = idx >> 3, c = idx & 7;
        const bf16* src = proj + (row0 + j) * NIN + h * 64 + c * 8;
        const v4u kv = *(const v4u*)(src + C_DK), vv = *(const v4u*)(src + C_DV);
        const float z = __builtin_amdgcn_exp2f(lg2 * (float)(127 - j));
        v4u kz; kz.x = cvtpk(bf2f((unsigned short)(kv.x & 0xffff)) * z, bf2f((unsigned short)(kv.x >> 16)) * z); kz.y = cvtpk(bf2f((unsigned short)(kv.y & 0xffff)) * z, bf2f((unsigned short)(kv.y >> 16)) * z);
        kz.z = cvtpk(bf2f((unsigned short)(kv.z & 0xffff)) * z, bf2f((unsigned short)(kv.z >> 16)) * z); kz.w = cvtpk(bf2f((unsigned short)(kv.w & 0xffff)) * z, bf2f((unsigned short)(kv.w >> 16)) * z);
        vt_write8(Kz, VP, c, j, kz); vt_write8(Vt, VP, c, j, vv); }
    __syncthreads();
    { const int r = lane & 31, hh = lane >> 5, et = w4 >> 1, dt = w4 & 1;
      f32x16 acc;
#pragma unroll
      for (int i = 0; i < 16; ++i) acc[i] = 0.f;
      const int e = 32 * et + r, d = 32 * dt + r;
#pragma unroll
      for (int ks = 0; ks < 8; ++ks) { const int G = 2 * ks + hh;
          const bf16x8 af = *(const LAS bf16x8*)(Vt + e * VP + ((G ^ ((e >> 3) & 7)) << 4));
          const bf16x8 bfr = *(const LAS bf16x8*)(Kz + d * VP + ((G ^ ((d >> 3) & 7)) << 4));
          acc = MFMA32(af, bfr, acc); }
      float* o = kvT + (size_t)uu * 4096;
#pragma unroll
      for (int i = 0; i < 16; ++i) o[(32 * et + crow(i, hh)) * 64 + d] = acc[i]; }
    __syncthreads();
}
__device__ __forceinline__ void ret_scan(const float* kvT, bf16* prev, int gtid) {
    if (gtid >= 65536) return;
    const int bh = gtid >> 11, el = (gtid & 2047) * 2, h = bh & 3;
    const float lg2 = __builtin_amdgcn_logf(1.0f - exp2f(-5.0f - (float)h)); const float cd = __builtin_amdgcn_exp2f(lg2 * 128.0f);
    f32x2 v[32];
#pragma unroll
    for (int n = 0; n < 32; ++n) v[n] = *(const f32x2*)(kvT + ((size_t)bh * 32 + n) * 4096 + el);
    f32x2 st = (f32x2){0.f, 0.f};
#pragma unroll
    for (int n = 0; n < 32; ++n) { *(unsigned*)(prev + ((size_t)bh * 32 + n) * 4096 + el) = cvtpk(st.x, st.y); st = st * cd + v[n]; }
}
__device__ __forceinline__ void ret_pair(const bf16* proj, const bf16* prev, const float* ret_g, bf16* y, int pair, LAS unsigned char* L, int tid) {
    const int half = tid >> 8, t256 = tid & 255, lane = tid & 63, w4 = (tid >> 6) & 3, w4u = __builtin_amdgcn_readfirstlane((tid >> 6) & 3);
    const int uu = pair * 2 + half, n = uu & 31, h = (uu >> 5) & 3, b = uu >> 7;
    constexpr int VP = 272;
    LAS unsigned char* Kimg = L + half * 45056; LAS unsigned char* Vt = Kimg + 128 * KP; LAS unsigned char* Pv = Vt + 64 * VP;
    const float lg2 = __builtin_amdgcn_logf(1.0f - exp2f(-5.0f - (float)h));
    const size_t row0 = (size_t)b * SEQ + n * 128;
    const int r = lane & 31, hh = lane >> 5, il = 32 * w4 + r;
    const size_t qrow = row0 + il;
    bf16x8 qf[4];
#pragma unroll
    for (int s = 0; s < 4; ++s) qf[s] = *(const bf16x8*)(proj + qrow * NIN + C_DQ + h * 64 + 16 * s + 8 * hh);
    v2u gte[2][4]; f32x4 rge[2][4];
#pragma unroll
    for (int dt = 0; dt < 2; ++dt)
#pragma unroll
        for (int i4 = 0; i4 < 4; ++i4) { const int e = 32 * dt + 8 * i4 + 4 * hh; gte[dt][i4] = *(const v2u*)(proj + qrow * NIN + C_DG + h * 64 + e); rge[dt][i4] = *(const f32x4*)(ret_g + h * 64 + e); }
#pragma unroll
    for (int it = 0; it < 4; ++it) { const int idx = t256 + it * 256, j = idx >> 3, c = idx & 7;
        const bf16* src = proj + (row0 + j) * NIN + h * 64 + c * 8;
        const v4u kv = *(const v4u*)(src + C_DK), vv = *(const v4u*)(src + C_DV);
        *(LAS v4u*)(Kimg + j * KP + c * 16) = kv;
        vt_write8(Vt, VP, c, keyperm(j), vv); }
    { const int e = t256 >> 2, d0 = (t256 & 3) * 16;
      const v4u* pp = (const v4u*)(prev + (size_t)uu * 4096 + e * 64 + d0);
      const v4u w0 = pp[0], w1 = pp[1];
      *(LAS v4u*)(Pv + e * KP + d0 * 2) = w0; *(LAS v4u*)(Pv + e * KP + d0 * 2 + 16) = w1; }
    __syncthreads();
    {
        f32x16 O[2], C[2];
#pragma unroll
        for (int i = 0; i < 16; ++i) { O[0][i] = 0.f; O[1][i] = 0.f; C[0][i] = 0.f; C[1][i] = 0.f; }
#pragma unroll 1
        for (int T = 0; T <= w4u; ++T) {
            f32x16 acc;
#pragma unroll
            for (int i = 0; i < 16; ++i) acc[i] = 0.f;
#pragma unroll
            for (int s = 0; s < 4; ++s) { const bf16x8 kf = *(const LAS bf16x8*)(Kimg + (32 * T + r) * KP + 32 * s + 16 * hh); acc = MFMA32(kf, qf[s], acc); }
#pragma unroll
            for (int i = 0; i < 16; ++i) { const int diff = il - 32 * T - crow(i, hh); acc[i] = (diff >= 0) ? acc[i] * __builtin_amdgcn_exp2f(lg2 * (float)diff) : 0.f; }
#pragma unroll
            for (int s = 0; s < 2; ++s) { const bf16x8 pf = PACK8(acc, s);
#pragma unroll
                for (int dt = 0; dt < 2; ++dt) { const int d = 32 * dt + r, G = 4 * T + 2 * s + hh;
                    const bf16x8 vf = *(const LAS bf16x8*)(Vt + d * VP + ((G ^ ((d >> 3) & 7)) << 4)); O[dt] = MFMA32(vf, pf, O[dt]); } }
        }
#pragma unroll
        for (int dt = 0; dt < 2; ++dt)
#pragma unroll
            for (int s = 0; s < 4; ++s) { const bf16x8 pf = *(const LAS bf16x8*)(Pv + (32 * dt + r) * KP + 32 * s + 16 * hh); C[dt] = MFMA32(pf, qf[s], C[dt]); }
        const float xi = __builtin_amdgcn_exp2f(lg2 * (float)(il + 1));
        float sm = 0.f;
#pragma unroll
        for (int dt = 0; dt < 2; ++dt)
#pragma unroll
            for (int i = 0; i < 16; ++i) { O[dt][i] += xi * C[dt][i]; sm += O[dt][i]; }
        sm += __shfl_xor(sm, 32); const float mu = sm * (1.f / 64.f); float sq = 0.f;
#pragma unroll
        for (int dt = 0; dt < 2; ++dt)
#pragma unroll
            for (int i = 0; i < 16; ++i) { O[dt][i] -= mu; sq += O[dt][i] * O[dt][i]; }
        sq += __shfl_xor(sq, 32); const float rstd = 1.f / sqrtf(sq * (1.f / 64.f) + EPS);
#pragma unroll
        for (int dt = 0; dt < 2; ++dt)
#pragma unroll
            for (int i4 = 0; i4 < 4; ++i4) { const int e = 32 * dt + 8 * i4 + 4 * hh;
                const f32x4 rg = rge[dt][i4]; const v2u gt = gte[dt][i4];
                v2u w; w.x = cvtpk(O[dt][4 * i4] * rstd * rg.x * bf2f((unsigned short)(gt.x & 0xffff)), O[dt][4 * i4 + 1] * rstd * rg.y * bf2f((unsigned short)(gt.x >> 16)));
                w.y = cvtpk(O[dt][4 * i4 + 2] * rstd * rg.z * bf2f((unsigned short)(gt.y & 0xffff)), O[dt][4 * i4 + 3] * rstd * rg.w * bf2f((unsigned short)(gt.y >> 16)));
                *(v2u*)(y + qrow * DM + 768 + h * 64 + e) = w; }
    }
    __syncthreads();
}

__device__ __forceinline__ void sgu_unit(const bf16* proj, bf16* y, const float* sgu_g, const bf16* wb  , const float* sgu_b, int u, LAS unsigned char* L, int tid) {
    const int lane = tid & 63, wave = tid >> 6;
    constexpr int VP = 272, GI = 64 * VP + 32;
    LAS unsigned char* Vt = L;
    const size_t row0 = (size_t)u * 128;
    { const int s = tid >> 2, q = tid & 3;
      const bf16* src = proj + (row0 + s) * NIN + C_BV + 64 * q;
      v4u w[8];
#pragma unroll
      for (int c = 0; c < 8; ++c) w[c] = *(const v4u*)(src + 8 * c);
      float sm = 0.f, sq = 0.f;
#pragma unroll
      for (int c = 0; c < 8; ++c) {
          const float e0 = bf2f((unsigned short)(w[c].x & 0xffff)), e1 = bf2f((unsigned short)(w[c].x >> 16)), e2 = bf2f((unsigned short)(w[c].y & 0xffff)), e3 = bf2f((unsigned short)(w[c].y >> 16));
          const float e4 = bf2f((unsigned short)(w[c].z & 0xffff)), e5 = bf2f((unsigned short)(w[c].z >> 16)), e6 = bf2f((unsigned short)(w[c].w & 0xffff)), e7 = bf2f((unsigned short)(w[c].w >> 16));
          sm += ((e0 + e1) + (e2 + e3)) + ((e4 + e5) + (e6 + e7));
          sq += ((e0 * e0 + e1 * e1) + (e2 * e2 + e3 * e3)) + ((e4 * e4 + e5 * e5) + (e6 * e6 + e7 * e7)); }
      sm += __shfl_xor(sm, 1); sq += __shfl_xor(sq, 1); sm += __shfl_xor(sm, 2); sq += __shfl_xor(sq, 2);
      const float mean = sm * (1.f / 256.f); const float var = fmaxf(sq * (1.f / 256.f) - mean * mean, 0.f); const float rstd = 1.f / sqrtf(var + EPS);
#pragma unroll
      for (int c = 0; c < 8; ++c) { const f32x4 g0 = *(const f32x4*)(sgu_g + 64 * q + 8 * c), g1 = *(const f32x4*)(sgu_g + 64 * q + 8 * c + 4);
          v4u o; o.x = cvtpk((bf2f((unsigned short)(w[c].x & 0xffff)) - mean) * rstd * g0.x, (bf2f((unsigned short)(w[c].x >> 16)) - mean) * rstd * g0.y);
          o.y = cvtpk((bf2f((unsigned short)(w[c].y & 0xffff)) - mean) * rstd * g0.z, (bf2f((unsigned short)(w[c].y >> 16)) - mean) * rstd * g0.w);
          o.z = cvtpk((bf2f((unsigned short)(w[c].z & 0xffff)) - mean) * rstd * g1.x, (bf2f((unsigned short)(w[c].z >> 16)) - mean) * rstd * g1.y);
          o.w = cvtpk((bf2f((unsigned short)(w[c].w & 0xffff)) - mean) * rstd * g1.z, (bf2f((unsigned short)(w[c].w >> 16)) - mean) * rstd * g1.w);
          vt_write8(Vt + q * GI, VP, c, s, o); } }
    __syncthreads();
    { const int r = lane & 31, hh = lane >> 5, g = wave >> 1, dt = wave & 1, d = 32 * dt + r;
      const LAS unsigned char* vg = Vt + g * GI + d * VP; const int sw = (d >> 3) & 7;
#pragma unroll
      for (int tt = 0; tt < 4; ++tt) { f32x16 acc;
#pragma unroll
          for (int i = 0; i < 16; ++i) acc[i] = 0.f;
          const bf16* wrow = wb + ((size_t)g * 128 + 32 * tt + r) * 128 + 8 * hh;
#pragma unroll
          for (int ks = 0; ks < 2 * (tt + 1); ++ks) { const bf16x8 af = *(const LAS bf16x8*)(vg + (((2 * ks + hh) ^ sw) << 4)); const bf16x8 bfr = *(const bf16x8*)(wrow + 16 * ks); acc = MFMA32(af, bfr, acc); }
          const int t = 32 * tt + r; const size_t row = row0 + t; const float bias = sgu_b[g * 128 + t];
#pragma unroll
          for (int i4 = 0; i4 < 4; ++i4) { const int d0 = 32 * dt + 8 * i4 + 4 * hh;
              const v2u uu = *(const v2u*)(proj + row * NIN + C_BU + g * 64 + d0), gt = *(const v2u*)(proj + row * NIN + C_BG + g * 64 + d0);
              v2u w; w.x = cvtpk((acc[4 * i4] + bias) * bf2f((unsigned short)(uu.x & 0xffff)) * bf2f((unsigned short)(gt.x & 0xffff)), (acc[4 * i4 + 1] + bias) * bf2f((unsigned short)(uu.x >> 16)) * bf2f((unsigned short)(gt.x >> 16)));
              w.y = cvtpk((acc[4 * i4 + 2] + bias) * bf2f((unsigned short)(uu.y & 0xffff)) * bf2f((unsigned short)(gt.y & 0xffff)), (acc[4 * i4 + 3] + bias) * bf2f((unsigned short)(uu.y >> 16)) * bf2f((unsigned short)(gt.y >> 16)));
              *(v2u*)(y + row * DM + 256 + g * 64 + d0) = w; } } }
    __syncthreads();
}
template <int PW>
__device__ __forceinline__ void pool_run(const bf16* src  , LAS unsigned char* dst, int tok  , int AP) {
    v4u x[PW + 7];
#pragma unroll
    for (int q = 0; q < PW + 7; ++q) { const int rel = q - (PW - 1); x[q] = (tok + rel >= 0) ? *(const v4u*)(src + (ptrdiff_t)rel * NIN) : (v4u){0u, 0u, 0u, 0u}; }
    float s[8];
#pragma unroll
    for (int c = 0; c < 8; ++c) s[c] = 0.f;
#define ADDX(q, sg) { s[0] += sg bf2f((unsigned short)(x[q].x & 0xffff)); s[1] += sg bf2f((unsigned short)(x[q].x >> 16)); s[2] += sg bf2f((unsigned short)(x[q].y & 0xffff)); s[3] += sg bf2f((unsigned short)(x[q].y >> 16)); \
                      s[4] += sg bf2f((unsigned short)(x[q].z & 0xffff)); s[5] += sg bf2f((unsigned short)(x[q].z >> 16)); s[6] += sg bf2f((unsigned short)(x[q].w & 0xffff)); s[7] += sg bf2f((unsigned short)(x[q].w >> 16)); }
#pragma unroll
    for (int q = 0; q < PW - 1; ++q) ADDX(q, +)
#pragma unroll
    for (int i = 0; i < 8; ++i) { const int q = PW - 1 + i; ADDX(q, +)
        const int cnt = (tok + i + 1 < PW) ? tok + i + 1 : PW; const float ic = 1.0f / (float)cnt; const v4u w0 = x[q];
        v4u o; o.x = cvtpk(s[0] * ic - bf2f((unsigned short)(w0.x & 0xffff)), s[1] * ic - bf2f((unsigned short)(w0.x >> 16))); o.y = cvtpk(s[2] * ic - bf2f((unsigned short)(w0.y & 0xffff)), s[3] * ic - bf2f((unsigned short)(w0.y >> 16)));
        o.z = cvtpk(s[4] * ic - bf2f((unsigned short)(w0.z & 0xffff)), s[5] * ic - bf2f((unsigned short)(w0.z >> 16))); o.w = cvtpk(s[6] * ic - bf2f((unsigned short)(w0.w & 0xffff)), s[7] * ic - bf2f((unsigned short)(w0.w >> 16)));
        *(LAS v4u*)(dst + i * AP) = o;
        ADDX(i, -) }
#undef ADDX
}
__device__ __forceinline__ void pool_unit(const bf16* proj, bf16* y, const bf16* pwt  , const float* pool_scale, int u, LAS unsigned char* L, int tid) {
    const int lane = tid & 63, wave = tid >> 6;
    constexpr int AP = 528;
    const size_t row0 = (size_t)u * 128; const int tok0 = (u & 31) * 128;
    { const int wu = __builtin_amdgcn_readfirstlane(tid >> 6), g = wu >> 1, c32 = 8 * g + (lane & 7), run = (lane >> 3) + 8 * (wu & 1), t0 = 8 * run;
      const bf16* src = proj + (row0 + t0) * NIN + C_CX + 8 * c32; LAS unsigned char* dst = L + t0 * AP + c32 * 16; const int tk = tok0 + t0;
      if (g == 0) pool_run<2>(src, dst, tk, AP); else if (g == 1) pool_run<4>(src, dst, tk, AP); else if (g == 2) pool_run<8>(src, dst, tk, AP); else pool_run<16>(src, dst, tk, AP); }
    __syncthreads();
    { const int r = lane & 31, hh = lane >> 5, g = wave >> 1, dt = wave & 1;
      bf16x8 af[4];
#pragma unroll
      for (int ks = 0; ks < 4; ++ks) af[ks] = *(const bf16x8*)(pwt + ((size_t)g * 64 + 32 * dt + r) * 64 + 16 * ks + 8 * hh);
      f32x4 sc[4]; v2u gts[4][4];
#pragma unroll
      for (int i4 = 0; i4 < 4; ++i4) { const int d0 = 32 * dt + 8 * i4 + 4 * hh; sc[i4] = *(const f32x4*)(pool_scale + g * 64 + d0);
#pragma unroll
          for (int tt = 0; tt < 4; ++tt) gts[tt][i4] = *(const v2u*)(proj + (row0 + 32 * tt + r) * NIN + C_CG + g * 64 + d0); }
#pragma unroll
      for (int tt = 0; tt < 4; ++tt) { f32x16 acc;
#pragma unroll
          for (int i = 0; i < 16; ++i) acc[i] = 0.f;
#pragma unroll
          for (int ks = 0; ks < 4; ++ks) { const bf16x8 bfr = *(const LAS bf16x8*)(L + (32 * tt + r) * AP + (g * 64 + 16 * ks + 8 * hh) * 2); acc = MFMA32(af[ks], bfr, acc); }
          const size_t row = row0 + 32 * tt + r;
#pragma unroll
          for (int i4 = 0; i4 < 4; ++i4) { const int d0 = 32 * dt + 8 * i4 + 4 * hh; const v2u gt = gts[tt][i4];
              v2u w; w.x = cvtpk(acc[4 * i4] * sc[i4].x * bf2f((unsigned short)(gt.x & 0xffff)), acc[4 * i4 + 1] * sc[i4].y * bf2f((unsigned short)(gt.x >> 16)));
              w.y = cvtpk(acc[4 * i4 + 2] * sc[i4].z * bf2f((unsigned short)(gt.y & 0xffff)), acc[4 * i4 + 3] * sc[i4].w * bf2f((unsigned short)(gt.y >> 16)));
              *(v2u*)(y + row * DM + 512 + g * 64 + d0) = w; } } }
    __syncthreads();
}

#define PHASE_IDS() int tid = threadIdx.x; asm volatile("" : "+v"(tid)); const int lane = tid & 63; const int wave = __builtin_amdgcn_readfirstlane(tid >> 6); const int gw = (int)blockIdx.x * 8 + wave; (void)lane; (void)gw
#define PHASE_PTRS() size_t z0_ = 0; asm volatile("" : "+s"(z0_)); unsigned char* ws = p.ws + z0_;     const float* x = p.in[0]; const float* w_in = p.in[2]; const float* w_out = p.in[9]; \
    const float* PRM = (const float*)(ws + WS_SMALL); bf16* WinT = (bf16*)(ws + WS_WIN); bf16* WoutT = (bf16*)(ws + WS_WOUT); bf16* XB = (bf16*)(ws + WS_XB); bf16* PROJ = (bf16*)(ws + WS_PROJ); \
    bf16* Y = (bf16*)(ws + WS_Y); bf16* Z = (bf16*)(ws + WS_Z); float* KVT = (float*)(ws + WS_KV); bf16* OG = (bf16*)(ws + WS_OG); float* LSE = (float*)(ws + WS_LSE); \
    float* R0P_ = (float*)(ws + WS_R0 + R0_PPART); float* R0Y_ = (float*)(ws + WS_R0 + R0_Y); float* R0Z_ = (float*)(ws + WS_R0 + R0_ZPART); float* R0H_ = (float*)(ws + WS_R0 + R0_H); (void)R0H_; \
    (void)x; (void)w_in; (void)w_out; (void)PRM; (void)WinT; (void)WoutT; (void)XB; (void)PROJ; (void)Y; (void)Z; (void)KVT; (void)OG; (void)LSE; (void)R0P_; (void)R0Y_; (void)R0Z_
#ifndef PROBE_A
#define PROBE_A (-1)
#define PROBE_B (-1)
#endif
#define TS(k) do { if (PROBE_A == (k) && blockIdx.x == 0 && threadIdx.x == 0) *(volatile LAS unsigned long long*)(L + 139280) = __builtin_amdgcn_s_memrealtime(); \
                   if (PROBE_B == (k) && blockIdx.x == 0 && threadIdx.x == 0) *(volatile LAS unsigned long long*)(L + 139288) = __builtin_amdgcn_s_memrealtime() - *(volatile LAS unsigned long long*)(L + 139280); } while (0)
template <int l>
__device__ __forceinline__ void layer_body(const Params& p, LAS unsigned char* L, const XcdBarrier& bar) {
    constexpr int G = 256, NGW = G * 8;

        { PHASE_PTRS(); pg8::Gemm g{XB, WinT + (size_t)l * NIN * DM, M, NIN, DM}; pg8::StaticOrder S; S.init(M, NIN, G, (int)blockIdx.x);
          pg8::EpiOut E{PROJ, NIN, (1u << 3) | (1u << 6) | (1u << 8) | (1u << 12)};
          pg8::gemm_phase<pg8::EpiOut, pg8::StaticOrder, true, true>((PG8_LAS unsigned char*)L, g, S, E); }
        if (l == 0 && (int)blockIdx.x >= 128) { PHASE_IDS(); PHASE_PTRS();
            LAS float* scr = (LAS float*)(L + wave * 16384); const int w1 = ((int)blockIdx.x - 128) * 8 + wave;
            constexpr int I_IN = (DM / 64) * (NIN / 32), I_OUT = (DM / 64) * (DM / 32);
            for (int it = w1; it < 2 * I_OUT + I_IN; it += 1024) {
                if (it < I_OUT) p0_transpose_item(w_out, DM, DM, WoutT, nullptr, 0, scr, it, lane);
                else if (it < 2 * I_OUT) p0_transpose_item(w_out + (size_t)DM * DM, DM, DM, WoutT + (size_t)DM * DM, nullptr, 0, scr, it - I_OUT, lane);
                else p0_transpose_item(w_in + (size_t)DM * NIN, DM, NIN, WinT + (size_t)NIN * DM, PRM + P_PREG + DM, 1, scr, it - 2 * I_OUT, lane); } }
        { PHASE_IDS(); PHASE_PTRS();
          if ((int)blockIdx.x >= 128) for (int task = ((int)blockIdx.x - 128) * 8 + wave; task < 52 * R0_KC; task += 1024) r0_dot_task<2>(R0H_, w_in + (size_t)l * DM * NIN, NIN, R0P_, task, 52, lane); }
        xcd_barrier(bar); TS(1 + 5 * l + 1);
        { PHASE_IDS(); PHASE_PTRS();
          if ((int)blockIdx.x >= 248) r0_mix(R0P_, R0Y_, (int)blockIdx.x - 248, PRM + P_SGUG + l * 256, PRM + P_SGUW + (size_t)l * 65536, PRM + P_SGUB + l * 512, PRM + P_RETG + l * 256, (LAS float*)L, tid); }
        { PHASE_IDS(); PHASE_PTRS(); for (int k = 0; k < 2; ++k) retkv_pair(PROJ, KVT, 64 * ((int)blockIdx.x & 7) + ((int)blockIdx.x >> 3) + 32 * k, L, tid); }
        { PHASE_IDS(); PHASE_PTRS(); const int c = (int)blockIdx.x; attn_phase(PROJ, OG, LSE, 192 * (c & 7) + (c >> 3), 32, 192 * ((c & 7) + 1), L, tid); }
        { PHASE_IDS(); PHASE_PTRS(); { const int u = 32 * ((int)blockIdx.x & 7) + ((int)blockIdx.x >> 3); sgu_unit(PROJ, Y, PRM + P_SGUG + l * 256, (const bf16*)(ws + WS_SGUWB) + (size_t)l * 65536, PRM + P_SGUB + l * 512, u, L, tid); } }
        { PHASE_IDS(); PHASE_PTRS(); { const int u = 32 * ((int)blockIdx.x & 7) + ((int)blockIdx.x >> 3); pool_unit(PROJ, Y, (const bf16*)(ws + WS_PWT) + (size_t)l * 16384, PRM + P_POOLS + l * 256, u, L, tid); } }
        xcd_barrier(bar); TS(1 + 5 * l + 2);
        { PHASE_IDS(); PHASE_PTRS(); ret_scan(KVT, (bf16*)(ws + WS_PREV), (32 * ((int)blockIdx.x & 7) + ((int)blockIdx.x >> 3)) * 256 + tid - ((tid >= 256) ? 256 - 65536 : 0));
          if ((int)blockIdx.x < 16 * R0_KCZ) {
              LAS float* red = (LAS float*)L;
              float acc[8];
              if (wave >= 4) { r0_dot_sub(R0Y_, w_out + (size_t)l * DM * DM, DM, (int)blockIdx.x, 16, wave - 4, lane, acc);
                  if (wave > 4) {
#pragma unroll
                      for (int b = 0; b < 8; ++b) red[((wave - 5) * 8 + b) * 64 + lane] = acc[b]; } }
              __syncthreads();
              if (wave == 4) { const int ch = (int)blockIdx.x % 16, kc = (int)blockIdx.x / 16;
#pragma unroll
                  for (int b = 0; b < 8; ++b) R0Z_[((size_t)kc * 8 + b) * DM + ch * 64 + lane] = ((acc[b] + red[(0 * 8 + b) * 64 + lane]) + red[(1 * 8 + b) * 64 + lane]) + red[(2 * 8 + b) * 64 + lane]; }
              __syncthreads(); } }
        xcd_barrier(bar);
        { PHASE_IDS(); PHASE_PTRS(); for (int k = 0; k < 2; ++k) ret_pair(PROJ, (const bf16*)(ws + WS_PREV), PRM + P_RETG + l * 256, Y, 64 * ((int)blockIdx.x & 7) + ((int)blockIdx.x >> 3) + 32 * k, L, tid);
          attn_combine(PROJ, OG, LSE, Y, ((int)blockIdx.x & 7) * 131072 + ((int)blockIdx.x >> 3) * 512 + tid, 16384, (((int)blockIdx.x & 7) + 1) * 131072); }
        xcd_barrier(bar); TS(1 + 5 * l + 3);
        { PHASE_PTRS(); pg8::Gemm g{Y, WoutT + (size_t)l * DM * DM, M, DM, DM}; pg8::StaticOrder S; S.init(M, DM, G, (int)blockIdx.x);
          pg8::EpiOut E{Z, DM, 0u};
          pg8::gemm_phase<pg8::EpiOut, pg8::StaticOrder, true, true>((PG8_LAS unsigned char*)L, g, S, E); }
        xcd_barrier(bar); TS(1 + 5 * l + 4);
        { PHASE_IDS(); PHASE_PTRS(); const int NR = M / NGW; float* RS = (float*)(ws + WS_RS); float* R0X = (float*)(ws + WS_RS + 262144);
          f32x4 pg[4];
#pragma unroll
          for (int j = 0; j < 4; ++j) pg[j] = *((const f32x4*)(PRM + P_POSTG + l * DM) + lane + 64 * j);
          v2u zc[4], zn[4]; f32x4 xc[4], xn_[4]; v2u bc[4], bn[4];
          { const int m = gw % NGW;
#pragma unroll
            for (int j = 0; j < 4; ++j) { zc[j] = __builtin_nontemporal_load((const v2u*)(Z + (size_t)m * DM) + lane + 64 * j);
                if (l == 0) xc[j] = *((const f32x4*)(x + (size_t)m * DM) + lane + 64 * j); else bc[j] = *((const v2u*)(XB + (size_t)m * DM) + lane + 64 * j); } }
#pragma unroll 1
          for (int i = 0; i < NR; ++i) { const int m = i * NGW + (gw + i * 257) % NGW; const bool r0 = (m & (SEQ - 1)) == 0;
              if (i + 1 < NR) { const int mn = (i + 1) * NGW + (gw + (i + 1) * 257) % NGW;
#pragma unroll
                  for (int j = 0; j < 4; ++j) { zn[j] = __builtin_nontemporal_load((const v2u*)(Z + (size_t)mn * DM) + lane + 64 * j);
                      if (l == 0) xn_[j] = *((const f32x4*)(x + (size_t)mn * DM) + lane + 64 * j); else bn[j] = *((const v2u*)(XB + (size_t)mn * DM) + lane + 64 * j); } }
              f32x4 z[4], xv[4];
              if (r0) r0z_sum(R0Z_ + (size_t)(m >> 12) * DM, lane, z);
              else {
#pragma unroll
                  for (int j = 0; j < 4; ++j) unpack4(zc[j], z[j]); }
              if (l == 0) {
#pragma unroll
                  for (int j = 0; j < 4; ++j) xv[j] = xc[j];
              } else if (r0) {
#pragma unroll
                  for (int j = 0; j < 4; ++j) xv[j] = *((const f32x4*)(R0X + (size_t)(m >> 12) * DM) + lane + 64 * j);
              } else { const float rs = RS[m];
#pragma unroll
                  for (int j = 0; j < 4; ++j) { unpack4(bc[j], xv[j]); xv[j] = xv[j] * rs; } }
              const float rstd = 1.f / sqrtf(wave_sum(ssq4(z)) * (1.f / DM) + EPS);
#pragma unroll
              for (int j = 0; j < 4; ++j) xv[j] = xv[j] + z[j] * rstd * pg[j];
              if (l + 1 < DEPTH) {
                  const float q2 = wave_sum(ssq4(xv)) * (1.f / DM) + EPS; const float r2 = 1.f / sqrtf(q2);
                  v2u* o8 = (v2u*)(XB + (size_t)m * DM) + lane;
#pragma unroll
                  for (int j = 0; j < 4; ++j) { v2u w; w.x = cvtpk(xv[j].x * r2, xv[j].y * r2); w.y = cvtpk(xv[j].z * r2, xv[j].w * r2); o8[64 * j] = w; }
                  if (lane == 0) RS[m] = sqrtf(q2);
                  if (r0) {
#pragma unroll
                      for (int j = 0; j < 4; ++j) { *((f32x4*)(R0X + (size_t)(m >> 12) * DM) + lane + 64 * j) = xv[j];
                          *((f32x4*)(R0H_ + (size_t)(m >> 12) * DM) + lane + 64 * j) = xv[j] * r2 * *((const f32x4*)(PRM + P_PREG + (l + 1 < DEPTH ? l + 1 : 0) * DM) + lane + 64 * j); } }
              } else {
                  f32x4* o = (f32x4*)(p.out + (size_t)m * DM) + lane;
#pragma unroll
                  for (int j = 0; j < 4; ++j) __builtin_nontemporal_store(xv[j], o + 64 * j);
              }
#pragma unroll
              for (int j = 0; j < 4; ++j) { zc[j] = zn[j]; xc[j] = xn_[j]; bc[j] = bn[j]; } } }
        if (l + 1 < DEPTH) xcd_barrier(bar); TS(1 + 5 * l + 5);

}

__global__ void __launch_bounds__(512, 2) fwd(Params p) {
    extern __shared__ __attribute__((aligned(16))) unsigned char lds[];
    cg::grid_group grid = cg::this_grid();
    LAS unsigned char* L = (LAS unsigned char*)lds;
    constexpr int G = 256, NGW = G * 8;
    { volatile LAS unsigned* st = (volatile LAS unsigned*)(L + 139264); if (threadIdx.x < 2) st[threadIdx.x] = 0u; }
    __syncthreads();
    TS(0);
    const XcdBarrier bar = xcd_barrier_post((unsigned*)(p.ws + WS_CTL), (volatile LAS unsigned*)(L + 139264));
    {
        PHASE_IDS(); PHASE_PTRS();
        { float* prm = (float*)(ws + WS_SMALL);
          for (int i = (int)blockIdx.x * 512 + tid; i < P_END; i += G * 512) { float v;
              if (i < P_SGUG) v = p.in[1][i]; else if (i < P_SGUW) v = p.in[3][i - P_SGUG]; else if (i < P_SGUB) v = p.in[4][i - P_SGUW]; else if (i < P_POOLW) v = p.in[5][i - P_SGUB];
              else if (i < P_POOLS) v = p.in[6][i - P_POOLW]; else if (i < P_RETG) v = p.in[7][i - P_POOLS]; else if (i < P_POSTG) v = p.in[8][i - P_RETG]; else v = p.in[10][i - P_POSTG];
              prm[i] = v; } }
        { bf16* sw = (bf16*)(ws + WS_SGUWB); bf16* pw = (bf16*)(ws + WS_PWT);
          for (int i = (int)blockIdx.x * 512 + tid; i < 2 * 65536; i += G * 512) { const int s = i & 127, t = (i >> 7) & 127; sw[i] = (s <= t) ? (bf16)f2bf(p.in[4][i]) : (bf16)0; }
          for (int i = (int)blockIdx.x * 512 + tid; i < 2 * 16384; i += G * 512) { const int c = i & 63, d = (i >> 6) & 63, lg = i >> 12; pw[i] = (bf16)f2bf(p.in[6][(size_t)lg * 4096 + c * 64 + d]); } }
        LAS float* scr = (LAS float*)(L + wave * 16384);
        constexpr int I_IN = (DM / 64) * (NIN / 32);
        for (int it = gw; it < I_IN; it += NGW) p0_transpose_item(w_in, DM, NIN, WinT, p.in[1], 1, scr, it, lane);
        { constexpr int NR = M / NGW; f32x4 c0[4], c1[4], n0[4], n1[4];
#define ROWM(i) ((i) * NGW + (gw + (i) * 257) % NGW)
#define LDROW(dst, m) _Pragma("unroll") for (int j = 0; j < 4; ++j) dst[j] = __builtin_nontemporal_load((const f32x4*)(x + (size_t)(m) * DM) + lane + 64 * j)
#define P0ROW(cur, m) { const float rstd = 1.f / sqrtf(wave_sum(ssq4(cur)) * (1.f / DM) + EPS); v2u* o8 = (v2u*)(XB + (size_t)(m) * DM) + lane; \
              _Pragma("unroll") for (int j = 0; j < 4; ++j) { v2u w; w.x = cvtpk(cur[j].x * rstd, cur[j].y * rstd); w.y = cvtpk(cur[j].z * rstd, cur[j].w * rstd); o8[64 * j] = w; } \
              if (((m) & (SEQ - 1)) == 0) { _Pragma("unroll") for (int j = 0; j < 4; ++j) *((f32x4*)(R0H_ + (size_t)((m) >> 12) * DM) + lane + 64 * j) = cur[j] * rstd * *((const f32x4*)p.in[1] + lane + 64 * j); } }
          LDROW(c0, ROWM(0)); LDROW(c1, ROWM(1));
#pragma unroll 1
          for (int i = 0; i < NR; i += 2) {
              if (i + 2 < NR) { LDROW(n0, ROWM(i + 2)); LDROW(n1, ROWM(i + 3)); }
              P0ROW(c0, ROWM(i)); P0ROW(c1, ROWM(i + 1));
#pragma unroll
              for (int j = 0; j < 4; ++j) { c0[j] = n0[j]; c1[j] = n1[j]; } }
#undef LDROW
#undef P0ROW
#undef ROWM
        }
    }
    if (p.ws == nullptr) grid.sync();
    xcd_barrier(bar); TS(1);
    layer_body<0>(p, L, bar);
    layer_body<1>(p, L, bar);
    TS(11);
    if (PROBE_A >= 0 && blockIdx.x == 0 && threadIdx.x == 0) { const unsigned long long d = *(volatile LAS unsigned long long*)(L + 139288), t0 = __builtin_amdgcn_s_memrealtime(); while (__builtin_amdgcn_s_memrealtime() - t0 < 8ull * d) __builtin_amdgcn_s_sleep(8); }
}

extern "C" void kernel_launch(void* const* d_in, const int* in_sizes, int n_in, void* d_out, int out_size, void* d_ws, size_t ws_size, hipStream_t stream) {
    static int grid = 0;
    if (grid == 0) {
        if (n_in != 11 || in_sizes[0] != M * DM || out_size != M * DM || ws_size < WS_END) { fprintf(stderr, "kernel_launch: unexpected shapes (n_in %d, in0 %d, out %d, ws %zu)\n", n_in, n_in > 0 ? in_sizes[0] : -1, out_size, ws_size); grid = -1; return; }
        int dev = 0, cus = 0, per_cu = 0;
        hipGetDevice(&dev); hipDeviceGetAttribute(&cus, hipDeviceAttributeMultiprocessorCount, dev);
        if (hipFuncSetAttribute((const void*)fwd, hipFuncAttributeMaxDynamicSharedMemorySize, LDS_BYTES) != hipSuccess) { fprintf(stderr, "kernel_launch: hipFuncSetAttribute failed\n"); grid = -1; return; }
        if (hipOccupancyMaxActiveBlocksPerMultiprocessor(&per_cu, (const void*)fwd, 512, LDS_BYTES) != hipSuccess || per_cu < 1) { fprintf(stderr, "kernel_launch: occupancy query says %d\n", per_cu); per_cu = 1; }
        (void)hipGetLastError();
        grid = 256;
        if (cus != 256) fprintf(stderr, "kernel_launch: built for a 256-CU device, found %d CUs\n", cus);
        fprintf(stderr, "kernel_launch: cus %d per_cu %d grid %d\n", cus, per_cu, grid);
    }
    if (grid < 0) return;
    if (hipMemsetAsync((char*)d_ws + WS_CTL, 0, 65536, stream) != hipSuccess) { fprintf(stderr, "kernel_launch: memset failed\n"); return; }
    Params p{};
    for (int i = 0; i < 11; ++i) p.in[i] = (const float*)d_in[i];
    p.out = (float*)d_out; p.ws = (unsigned char*)d_ws;
    void* args[] = {&p};
    hipError_t e = hipLaunchCooperativeKernel((const void*)fwd, dim3(grid), dim3(512), args, LDS_BYTES, stream);
    if (e != hipSuccess) fprintf(stderr, "kernel_launch: cooperative launch failed: %s (grid %d)\n", hipGetErrorString(e), grid);
}
```

```cpp
#include <hip/hip_runtime.h>
#include <hip/hip_cooperative_groups.h>
#include <cstdio>
#include <cstdint>
namespace cg = cooperative_groups;
namespace pg8 {
#define PG8_LAS __attribute__((address_space(3)))
typedef unsigned short bf16_t;
typedef short bf16x8 __attribute__((ext_vector_type(8)));
typedef float f32x4 __attribute__((ext_vector_type(4)));
typedef unsigned u32x4 __attribute__((ext_vector_type(4)));
constexpr int BM = 256, BK = 64, HALF = 128, HTB = HALF * BK * 2  , STAGE_BYTES = 8 * HTB, NXCD = 8, WGM = 4;

__host__ __device__ __forceinline__ int lds_byte(int r, int c) { const int st = (r >> 4) * 2 + (c >> 5), rr = r & 15, cc = c & 31, ob = rr * 64 + cc * 2; return st * 1024 + (ob ^ (((ob >> 9) & 1) << 5)); }
__host__ __device__ __forceinline__ void stage_rc(int b, int& R, int& C) { const int st = b / 1024, sb = b % 1024, swz = sb ^ (((sb >> 9) & 1) << 5); R = (st >> 1) * 16 + swz / 64; C = (st & 1) * 32 + (swz % 64) / 2; }
__host__ __device__ __forceinline__ int perm32(int rho) { const int n = rho >> 4, i = rho & 15; return 8 * (i >> 2) + 4 * n + (i & 3); }

struct Unit { int pm, pn; };
struct Gemm { const bf16_t* A; const bf16_t* Bt; int M, N, K; };

struct StaticOrder {
    int nM, nN, nwg, G, c;
    __host__ __device__ void init(int M, int N, int G_, int c_) { nM = M / BM; nN = N / BM; nwg = nM * nN; G = G_; c = c_; }
    __host__ __device__ bool next(int i, Unit& u) const {
        const long L = (long)i * G + c; if (L >= nwg) return false;
        int wgid = (int)L; { const int q = nwg / NXCD, r = nwg % NXCD, xcd = wgid % NXCD, off = wgid / NXCD; wgid = (xcd < r ? xcd * (q + 1) : r * (q + 1) + (xcd - r) * q) + off; }
        const int nig = WGM * nN, gid = wgid / nig, fm = gid * WGM, gsz = (nM - fm) < WGM ? (nM - fm) : WGM;
        u.pm = fm + ((wgid % nig) % gsz); u.pn = (wgid % nig) / gsz; return true;
    }
    __device__ __forceinline__ void a_ready(const Unit&) const {}
    __device__ __forceinline__ void done(const Unit&) const {}
};

__device__ __forceinline__ unsigned cvt_pk_bf16(float lo, float hi) { unsigned r; asm volatile("v_cvt_pk_bf16_f32 %0, %1, %2" : "=v"(r) : "v"(lo), "v"(hi)); return r; }
__device__ __forceinline__ float silu_f(float x) { return x / (1.0f + __expf(-x)); }
__device__ __forceinline__ float silu_fast(float x) { return x * __builtin_amdgcn_rcpf(1.0f + __builtin_amdgcn_exp2f(x * -1.4426950408889634f)); }
struct EpiOut {
    static constexpr bool PERM = true, AFTER_DRAIN = false;
    bf16_t* O; int ldc; unsigned gate_mask;
    __device__ __forceinline__ void operator()(const f32x4 (&acc)[2][2][4][2], const Unit& u, int wr, int wc, int fr, int fq) const {
        const int row0 = u.pm * BM + wr * 64 + fr; const int col0 = u.pn * BM + wc * 32 + 8 * fq;
        const bool gate = (gate_mask >> u.pn) & 1u;
#pragma unroll
        for (int ai = 0; ai < 2; ++ai)
#pragma unroll
            for (int m = 0; m < 4; ++m) { bf16_t* rowp = O + (size_t)(row0 + ai * HALF + m * 16) * ldc + col0;
#pragma unroll
                for (int bj = 0; bj < 2; ++bj) { f32x4 v0 = acc[ai][bj][m][0], v1 = acc[ai][bj][m][1];
                    if (gate) { v0 = (f32x4){silu_fast(v0[0]), silu_fast(v0[1]), silu_fast(v0[2]), silu_fast(v0[3])}; v1 = (f32x4){silu_fast(v1[0]), silu_fast(v1[1]), silu_fast(v1[2]), silu_fast(v1[3])}; }
                    u32x4 w; w.x = cvt_pk_bf16(v0[0], v0[1]); w.y = cvt_pk_bf16(v0[2], v0[3]); w.z = cvt_pk_bf16(v1[0], v1[1]); w.w = cvt_pk_bf16(v1[2], v1[3]);
                    *(u32x4*)(rowp + bj * HALF) = w; } }
    }
};
template <class Epi, class Sched, bool ALIGN_EPI = false, bool SP2 = false>
__device__ __forceinline__ void gemm_phase(PG8_LAS unsigned char* lds, const Gemm g, const Sched& S, const Epi& E) {
    int tid_ = threadIdx.x; asm volatile("" : "+v"(tid_));
    const int tid = tid_, wid = __builtin_amdgcn_readfirstlane(tid >> 6), lane = tid & 63, wr = wid >> 2, wc = wid & 3, fr = lane & 15, fq = lane >> 4;
    const int K = g.K, nt = K / BK;
    unsigned voffA[2], voffB[2];
#pragma unroll
    for (int i = 0; i < 2; ++i) { int R, C; stage_rc(tid * 16 + i * 8192, R, C); const int Rb = Epi::PERM ? ((R & ~31) + perm32(R & 31)) : R;
        voffA[i] = (unsigned)(R * K + C) * 2u; voffB[i] = (unsigned)(Rb * K + C) * 2u; }
    const size_t kstep = (size_t)(BK * 2);
    const size_t hstep = (size_t)HALF * K * 2;
    const size_t tstep = 2 * hstep;
    const unsigned ldsw = (unsigned)wid * 1024u;
    const int aoff = lds_byte(wr * 64 + fr, fq * 8), boff = lds_byte(wc * 32 + fr, fq * 8);
#define PG8_SA(b, h) (((b) * 2 + (h)) * HTB)
#define PG8_SB(b, h) ((4 + (b) * 2 + (h)) * HTB)
#define PG8_STAGE(bufoff, gbase, voff) do { _Pragma("unroll") for (int _i = 0; _i < 2; ++_i) \
        __builtin_amdgcn_global_load_lds((const unsigned*)((const char*)(gbase) + (voff)[_i]), (PG8_LAS unsigned*)(lds + (bufoff) + ldsw + _i * 8192), 16, 0, 0); } while (0)
#define PG8_LDA(dst, b, h) do { _Pragma("unroll") for (int m = 0; m < 4; ++m) _Pragma("unroll") for (int k = 0; k < 2; ++k) dst[m][k] = *(const PG8_LAS bf16x8*)(lds + PG8_SA(b, h) + aoff + m * 2048 + k * 1024); } while (0)
#define PG8_LDB(dst, b, h) do { _Pragma("unroll") for (int n = 0; n < 2; ++n) _Pragma("unroll") for (int k = 0; k < 2; ++k) dst[n][k] = *(const PG8_LAS bf16x8*)(lds + PG8_SB(b, h) + boff + n * 2048 + k * 1024); } while (0)
#define PG8_MMA(ai, bj, At, Bt) do { __builtin_amdgcn_s_setprio(1); _Pragma("unroll") for (int m = 0; m < 4; ++m) _Pragma("unroll") for (int n = 0; n < 2; ++n) _Pragma("unroll") for (int k = 0; k < 2; ++k) \
        acc[ai][bj][m][n] = __builtin_amdgcn_mfma_f32_16x16x32_bf16(Bt[n][k], At[m][k], acc[ai][bj][m][n], 0, 0, 0); __builtin_amdgcn_s_setprio(0); } while (0)
#define PG8_WAIT_V(n) asm volatile("s_waitcnt vmcnt(" #n ")" ::: "memory")
#define PG8_WAIT_L(n) asm volatile("s_waitcnt lgkmcnt(" #n ")" ::: "memory")
#define PG8_BAR __builtin_amdgcn_s_barrier()
#define PG8_SCHED __builtin_amdgcn_sched_barrier(0)
    Unit cur, nxt; int ui = 0;
    if (!S.next(0, cur)) return;
    f32x4 acc[2][2][4][2];
#pragma unroll
    for (int a = 0; a < 2; ++a)
#pragma unroll
        for (int b = 0; b < 2; ++b)
#pragma unroll
            for (int m = 0; m < 4; ++m)
#pragma unroll
                for (int n = 0; n < 2; ++n) acc[a][b][m][n] = (f32x4){0.f, 0.f, 0.f, 0.f};
    bf16x8 At[4][2], B0[2][2], B1[2][2];
    const char* cA = (const char*)g.A + (size_t)cur.pm * tstep; const char* cB = (const char*)g.Bt + (size_t)cur.pn * tstep;
    S.a_ready(cur);
    if constexpr (SP2) {
        PG8_STAGE(PG8_SB(0, 0), cB, voffB); PG8_STAGE(PG8_SB(0, 1), cB + hstep, voffB); PG8_STAGE(PG8_SA(0, 0), cA, voffA); PG8_STAGE(PG8_SA(0, 1), cA + hstep, voffA);
        if (wr == 1) PG8_BAR;
        PG8_WAIT_V(2); PG8_BAR;
        PG8_STAGE(PG8_SB(1, 0), cB + kstep, voffB); PG8_STAGE(PG8_SA(1, 0), cA + kstep, voffA); PG8_STAGE(PG8_SB(1, 1), cB + hstep + kstep, voffB);
        PG8_WAIT_V(6); PG8_BAR;
    } else {
        PG8_STAGE(PG8_SB(0, 0), cB, voffB); PG8_STAGE(PG8_SA(0, 0), cA, voffA); PG8_STAGE(PG8_SB(0, 1), cB + hstep, voffB); PG8_STAGE(PG8_SA(0, 1), cA + hstep, voffA);
        if (wr == 1) PG8_BAR;
        PG8_WAIT_V(4); PG8_BAR;
        PG8_STAGE(PG8_SB(1, 0), cB + kstep, voffB); PG8_STAGE(PG8_SA(1, 0), cA + kstep, voffA); PG8_STAGE(PG8_SB(1, 1), cB + hstep + kstep, voffB);
        PG8_WAIT_V(6); PG8_BAR;
    }
    for (;;) {
        const bool has_next = S.next(ui + 1, nxt);
        const char* nA = has_next ? (const char*)g.A + (size_t)nxt.pm * tstep : cA; const char* nB = has_next ? (const char*)g.Bt + (size_t)nxt.pn * tstep : cB;
        for (int t = 0; t < nt; t += 2) {
            const bool last = (t == nt - 2);
            const char* a1 = cA + (size_t)(t + 1) * kstep;
            const char* a2 = last ? nA : cA + (size_t)(t + 2) * kstep; const char* b2 = last ? nB : cB + (size_t)(t + 2) * kstep;
            const char* a3 = a2 + kstep; const char* b3 = b2 + kstep;
            if (last && has_next) S.a_ready(nxt);
            if constexpr (SP2) {
            PG8_LDB(B0, 0, 0); PG8_LDB(B1, 0, 1); PG8_SCHED; PG8_LDA(At, 0, 0); PG8_STAGE(PG8_SA(1, 1), a1 + hstep, voffA);
            PG8_WAIT_V(8); PG8_WAIT_L(0); PG8_BAR; PG8_MMA(0, 0, At, B0); PG8_MMA(0, 1, At, B1); PG8_BAR; PG8_SCHED;
            PG8_LDA(At, 0, 1); PG8_STAGE(PG8_SB(0, 0), b2, voffB); PG8_STAGE(PG8_SB(0, 1), b2 + hstep, voffB); PG8_STAGE(PG8_SA(0, 0), a2, voffA);
            PG8_WAIT_V(8); PG8_WAIT_L(0); PG8_BAR; PG8_MMA(1, 0, At, B0); PG8_MMA(1, 1, At, B1); PG8_BAR; PG8_SCHED;
            PG8_LDB(B0, 1, 0); PG8_LDB(B1, 1, 1); PG8_SCHED; PG8_LDA(At, 1, 0); PG8_STAGE(PG8_SA(0, 1), a2 + hstep, voffA);
            PG8_WAIT_V(8); PG8_WAIT_L(0); PG8_BAR; PG8_MMA(0, 0, At, B0); PG8_MMA(0, 1, At, B1); PG8_BAR; PG8_SCHED;
            PG8_LDA(At, 1, 1); PG8_STAGE(PG8_SB(1, 0), b3, voffB); PG8_STAGE(PG8_SB(1, 1), b3 + hstep, voffB); PG8_STAGE(PG8_SA(1, 0), a3, voffA);
            PG8_WAIT_V(8); PG8_WAIT_L(0); PG8_BAR; PG8_MMA(1, 0, At, B0); PG8_MMA(1, 1, At, B1); PG8_BAR; PG8_SCHED;
            } else {
            PG8_LDB(B0, 0, 0); PG8_SCHED; PG8_LDA(At, 0, 0); PG8_STAGE(PG8_SA(1, 1), a1 + hstep, voffA);
            PG8_WAIT_L(8); PG8_BAR; PG8_WAIT_L(0); PG8_MMA(0, 0, At, B0); PG8_BAR; PG8_SCHED;
            PG8_LDB(B1, 0, 1); PG8_STAGE(PG8_SB(0, 0), b2, voffB);
            PG8_BAR; PG8_WAIT_L(0); PG8_MMA(0, 1, At, B1); PG8_BAR;
            PG8_LDA(At, 0, 1); PG8_STAGE(PG8_SA(0, 0), a2, voffA);
            PG8_BAR; PG8_WAIT_L(0); PG8_MMA(1, 0, At, B0); PG8_BAR; PG8_SCHED;
            PG8_STAGE(PG8_SB(0, 1), b2 + hstep, voffB);
            PG8_WAIT_V(6); PG8_BAR; PG8_MMA(1, 1, At, B1); PG8_BAR;
            PG8_LDB(B0, 1, 0); PG8_SCHED; PG8_LDA(At, 1, 0); PG8_STAGE(PG8_SA(0, 1), a2 + hstep, voffA);
            PG8_WAIT_L(8); PG8_BAR; PG8_WAIT_L(0); PG8_MMA(0, 0, At, B0); PG8_BAR; PG8_SCHED;
            PG8_LDB(B1, 1, 1); PG8_STAGE(PG8_SB(1, 0), b3, voffB);
            PG8_BAR; PG8_WAIT_L(0); PG8_MMA(0, 1, At, B1); PG8_BAR;
            PG8_LDA(At, 1, 1); PG8_STAGE(PG8_SA(1, 0), a3, voffA);
            PG8_BAR; PG8_WAIT_L(0); PG8_MMA(1, 0, At, B0); PG8_BAR; PG8_SCHED;
            PG8_STAGE(PG8_SB(1, 1), b3 + hstep, voffB);
            PG8_WAIT_V(6); PG8_BAR; PG8_MMA(1, 1, At, B1); PG8_BAR;
            }
        }
        if constexpr (ALIGN_EPI) { if (wr == 0) PG8_BAR; }
        if constexpr (!Epi::AFTER_DRAIN) { E(acc, cur, wr, wc, fr, fq); S.done(cur); }
        if (!has_next) break;
#pragma unroll
        for (int a = 0; a < 2; ++a)
#pragma unroll
            for (int b = 0; b < 2; ++b)
#pragma unroll
                for (int m = 0; m < 4; ++m)
#pragma unroll
                    for (int n = 0; n < 2; ++n) acc[a][b][m][n] = (f32x4){0.f, 0.f, 0.f, 0.f};
        cur = nxt; cA = nA; cB = nB; ++ui;
        if constexpr (ALIGN_EPI) { if (wr == 1) PG8_BAR; }
    }
    PG8_WAIT_V(0);
    if constexpr (!ALIGN_EPI) { if (wr == 0) PG8_BAR; }
    PG8_BAR;
    if constexpr (Epi::AFTER_DRAIN) { E.fused(acc, cur, wr, wc, fr, fq, lds, wid, lane); S.done(cur); }
#undef PG8_SA
#undef PG8_SB
#undef PG8_STAGE
#undef PG8_LDA
#undef PG8_LDB
#undef PG8_MMA
#undef PG8_WAIT_V
#undef PG8_WAIT_L
#undef PG8_BAR
#undef PG8_SCHED
}
}
#define LAS __attribute__((address_space(3)))
typedef unsigned short bf16;
typedef unsigned v4u __attribute__((ext_vector_type(4)));
typedef unsigned v2u __attribute__((ext_vector_type(2)));
typedef float f32x4 __attribute__((ext_vector_type(4)));
constexpr int SEQ = 4096, BATCH = 8, DM = 1024, M = BATCH * SEQ, NIN = 3328, DEPTH = 2;
constexpr float EPS = 1e-6f;
constexpr float LOG2E = 1.4426950408889634f;
constexpr float QSCALE = 0.125f * LOG2E;
constexpr int C_AQ = 0, C_AK = 256, C_AV = 512, C_AG = 768, C_BU = 1024, C_BV = 1280, C_BG = 1536, C_CX = 1792, C_CG = 2048, C_DQ = 2304, C_DK = 2560, C_DV = 2816, C_DG = 3072;
constexpr size_t MiB = 1u << 20;
constexpr size_t WS_WIN = 0, WS_WOUT = 13 * MiB, WS_SMALL = 17 * MiB, WS_XB = 18 * MiB, WS_PROJ = 82 * MiB, WS_Y = 290 * MiB, WS_Z = 354 * MiB, WS_OG = 418 * MiB, WS_LSE = 466 * MiB, WS_KV = 468 * MiB, WS_R0 = 484 * MiB, WS_CTL = 490 * MiB, WS_PREV = 491 * MiB, WS_RS = 499 * MiB, WS_END = 500 * MiB;
constexpr size_t R0_PPART = 0, R0_Y = 4 * MiB, R0_H = R0_Y + 65536, R0_ZPART = 5 * MiB;
constexpr int R0_KC = 16, R0_KCZ = 8;
constexpr int LDS_BYTES = 147456;
constexpr size_t WS_SGUWB = WS_SMALL + 704 * 1024, WS_PWT = WS_SMALL + 960 * 1024;
constexpr int P_PREG = 0, P_SGUG = 2048, P_SGUW = 2560, P_SGUB = 133632, P_POOLW = 134656, P_POOLS = 167424, P_RETG = 167936, P_POSTG = 168448, P_END = 170496;

__device__ __forceinline__ float bf2f(unsigned short u) { return __uint_as_float(((unsigned)u) << 16); }
__device__ __forceinline__ unsigned f2bf(float f) { unsigned u = __float_as_uint(f); return (u + 0x7fffu + ((u >> 16) & 1u)) >> 16; }
__device__ __forceinline__ unsigned pk2(float lo, float hi) { return f2bf(lo) | (f2bf(hi) << 16); }
__device__ __forceinline__ float wave_sum(float v) {
#pragma unroll
    for (int o = 1; o < 64; o <<= 1) v += __shfl_xor(v, o);
    return v;
}
#define LDS_WAIT() asm volatile("s_waitcnt lgkmcnt(0)" ::: "memory")

struct Params { const float* in[11]; float* out; unsigned char* ws; };

__device__ __forceinline__ void p0_transpose_item(const float* W, int K, int N, bf16* WT, const float* rs, int col_mode, LAS float* scr, int item, int lane) {
    const int nblk = N / 32, kb = item / nblk, nb = item % nblk, k0 = 64 * kb, n0 = 32 * nb;
    float cs = 1.f;
    if (col_mode) { const int n = n0 + (lane & 31); if (n < 256) cs = QSCALE; else if (n >= C_DK && n < C_DK + 256) cs = 0.125f; }
#pragma unroll
    for (int i = 0; i < 32; ++i) { const int kk = 2 * i + (lane >> 5); float v = W[(size_t)(k0 + kk) * N + n0 + (lane & 31)] * cs; if (rs) v *= rs[k0 + kk]; scr[kk * 33 + (lane & 31)] = v; }
    LDS_WAIT(); asm volatile("" ::: "memory");
    const int c = lane & 7;
#pragma unroll
    for (int j = 0; j < 4; ++j) { const int n = (lane >> 3) + 8 * j; const LAS float* s = scr + (8 * c) * 33 + n;
        v4u o; o.x = pk2(s[0 * 33], s[1 * 33]); o.y = pk2(s[2 * 33], s[3 * 33]); o.z = pk2(s[4 * 33], s[5 * 33]); o.w = pk2(s[6 * 33], s[7 * 33]);
        *(v4u*)(WT + (size_t)(n0 + n) * K + k0 + 8 * c) = o; }
    LDS_WAIT(); asm volatile("" ::: "memory");
}

__device__ __forceinline__ void unpack4(const v2u w, f32x4& o) { o = (f32x4){bf2f((unsigned short)(w.x & 0xffff)), bf2f((unsigned short)(w.x >> 16)), bf2f((unsigned short)(w.y & 0xffff)), bf2f((unsigned short)(w.y >> 16))}; }
__device__ __forceinline__ float ssq4(const f32x4 (&v)[4]) { float s = 0.f;
#pragma unroll
    for (int j = 0; j < 4; ++j) s += (v[j].x * v[j].x + v[j].y * v[j].y) + (v[j].z * v[j].z + v[j].w * v[j].w);
    return s; }
__device__ __forceinline__ void r0z_sum(const float* r0z, int lane, f32x4 (&z)[4]) {
#pragma unroll
    for (int j = 0; j < 4; ++j) { asm volatile("" ::: "memory"); f32x4 a = (f32x4){0.f, 0.f, 0.f, 0.f};
#pragma unroll
        for (int kc = 0; kc < R0_KCZ; ++kc) a += *((const f32x4*)(r0z + (size_t)kc * 8 * DM) + lane + 64 * j);
        z[j] = a; }
}

__device__ __forceinline__ float rdl(float v, int l) { return __int_as_float(__builtin_amdgcn_readlane(__float_as_int(v), l)); }
template <int NB  >
__device__ __forceinline__ void r0_dot_task(const float* h, const float* W, int N, float* part, int task, int nchunks, int lane) {
    const int ch = task % nchunks, kc = task / nchunks, n0 = ch * 64;
    float acc[8];
#pragma unroll
    for (int b = 0; b < 8; ++b) acc[b] = 0.f;
#pragma unroll 1
    for (int sb = 0; sb < NB; ++sb) { const int k0 = (kc * NB + sb) * 32;
        float hv[4], w[32];
#pragma unroll
        for (int i = 0; i < 4; ++i) { const int idx = lane + 64 * i; hv[i] = h[(idx >> 5) * DM + k0 + (idx & 31)]; }
#pragma unroll
        for (int kk = 0; kk < 32; ++kk) w[kk] = W[(size_t)(k0 + kk) * N + n0 + lane];
#pragma unroll
        for (int kk = 0; kk < 32; ++kk)
#pragma unroll
            for (int b = 0; b < 8; ++b) acc[b] += rdl(hv[b >> 1], (b & 1) * 32 + kk) * w[kk]; }
#pragma unroll
    for (int b = 0; b < 8; ++b) part[((size_t)kc * 8 + b) * N + n0 + lane] = acc[b];
}
__device__ __forceinline__ void r0_dot_sub(const float* h, const float* W, int N, int task, int nchunks, int sb, int lane, float (&acc)[8]) {
    const int ch = task % nchunks, kc = task / nchunks, n0 = ch * 64; const int k0 = (kc * 4 + sb) * 32;
    float hv[4], w[32];
#pragma unroll
    for (int i = 0; i < 4; ++i) { const int idx = lane + 64 * i; hv[i] = h[(idx >> 5) * DM + k0 + (idx & 31)]; }
#pragma unroll
    for (int kk = 0; kk < 32; ++kk) w[kk] = W[(size_t)(k0 + kk) * N + n0 + lane];
#pragma unroll
    for (int b = 0; b < 8; ++b) acc[b] = 0.f;
#pragma unroll
    for (int kk = 0; kk < 32; ++kk)
#pragma unroll
        for (int b = 0; b < 8; ++b) acc[b] += rdl(hv[b >> 1], (b & 1) * 32 + kk) * w[kk];
}
using pg8::silu_f;
__device__ __forceinline__ void r0_mix(const float* ppart, float* y0, int b, const float* sgu_g, const float* sgu_w, const float* sgu_b, const float* ret_g, LAS float* P, int tid) {
#pragma unroll 2
    for (int n = tid; n < NIN; n += 512) { float a = 0.f;
#pragma unroll
        for (int kc = 0; kc < R0_KC; ++kc) a += ppart[((size_t)kc * 8 + b) * NIN + n];
        P[n] = a; }
    __syncthreads();
    if (tid < 256) { const int lane = tid & 63;
        float sm = 0.f;
#pragma unroll
        for (int i = 0; i < 4; ++i) sm += P[C_BV + lane + 64 * i];
        const float mean = wave_sum(sm) * (1.f / 256.f); float sq = 0.f;
#pragma unroll
        for (int i = 0; i < 4; ++i) { const float d = P[C_BV + lane + 64 * i] - mean; sq += d * d; }
        const float rstd = 1.f / sqrtf(wave_sum(sq) * (1.f / 256.f) + EPS);
        { const int i = tid >> 6; const int c = lane + 64 * i;
            y0[b * DM + c] = P[C_AV + c] * silu_f(P[C_AG + c]);
            const float mixed = sgu_w[(size_t)i * 16384] * ((P[C_BV + c] - mean) * rstd * sgu_g[c]) + sgu_b[i * 128];
            y0[b * DM + 256 + c] = P[C_BU + c] * mixed * silu_f(P[C_BG + c]);
            y0[b * DM + 512 + c] = 0.f;
            const float cc = wave_sum(P[C_DQ + c] * P[C_DK + c]) * 0.125f; const float of = cc * P[C_DV + c];
            const float mu = wave_sum(of) * (1.f / 64.f); const float d0 = of - mu; const float var = wave_sum(d0 * d0) * (1.f / 64.f);
            y0[b * DM + 768 + c] = d0 / sqrtf(var + EPS) * ret_g[c] * silu_f(P[C_DG + c]); } }
    __syncthreads();
}

#define XB_TMO      128
#define XB_XCNT(j)  (256  + 64 * (j))
#define XB_XSUB(j)  (1280 + 64 * (j))
#define XB_XGEN(j)  (2304 + 64 * (j))
#define XB_TOP      3328
#define XB_TOPGEN   3392
#define XCD_BAR_WORDS 3456
#define XB_SPIN_CAP (1u << 18)

__device__ __forceinline__ unsigned xb_ld(unsigned* p)              { return __hip_atomic_load(p, __ATOMIC_RELAXED, __HIP_MEMORY_SCOPE_AGENT); }
__device__ __forceinline__ unsigned xb_add(unsigned* p, unsigned v) { return __hip_atomic_fetch_add(p, v, __ATOMIC_RELAXED, __HIP_MEMORY_SCOPE_AGENT); }
__device__ __forceinline__ unsigned xb_xcc_id() { return (unsigned)__builtin_amdgcn_s_getreg((3 << 11) | 20) & 0xFu; }
#define XB_SPIN(cond, bar) do { unsigned _sp = 0; while (cond) { \
    if ((++_sp & 255u) == 0u) { if (xb_ld(&(bar)[XB_TMO])) break; if (_sp > XB_SPIN_CAP) { atomicAdd(&(bar)[XB_TMO], 1u); break; } } } } while (0)

struct XcdBarrier {
    unsigned* bar; unsigned x;
    volatile LAS unsigned* st;
};

__device__ __forceinline__ XcdBarrier xcd_barrier_post(unsigned* bar, volatile LAS unsigned* st) {
    XcdBarrier b; b.bar = bar; b.x = xb_xcc_id(); b.st = st;
    if (threadIdx.x == 0) (void)xb_add(&bar[XB_XCNT(b.x)], 1u);
    return b;
}
__device__ __forceinline__ void xcd_barrier_complete(unsigned* bar, unsigned x, unsigned& nloc, unsigned& nx) {
    const unsigned G = gridDim.x * gridDim.y * gridDim.z;
    unsigned sum, cnt, mine, sp = 0u;
    for (;;) {
        sum = 0u; cnt = 0u; mine = 0u;
#pragma unroll
        for (unsigned j = 0; j < 16; ++j) { const unsigned c = xb_ld(&bar[XB_XCNT(j)]); sum += c; cnt += (c > 0u) ? 1u : 0u; mine = (j == x) ? c : mine; }
        if (sum == G) break;
        __builtin_amdgcn_s_sleep(1);
        if ((++sp & 255u) == 0u) { if (xb_ld(&bar[XB_TMO])) break; if (sp > XB_SPIN_CAP) { atomicAdd(&bar[XB_TMO], 1u); break; } }
    }
    nloc = mine > 0u ? mine : 1u; nx = cnt > 0u ? cnt : 1u;
}

__device__ __forceinline__ void xcd_barrier(const XcdBarrier& b) {
    asm volatile("s_waitcnt vmcnt(0)" ::: "memory");
    __syncthreads();
    if (threadIdx.x == 0) {
        size_t z0_ = 0; asm volatile("" : "+s"(z0_)); unsigned* bar = b.bar + z0_;
        const unsigned bx = xb_xcc_id();
        __builtin_amdgcn_s_waitcnt(0);
        unsigned nloc = b.st[0], nx = b.st[1];
        if (nloc == 0u) { xcd_barrier_complete(bar, bx, nloc, nx); b.st[0] = nloc; b.st[1] = nx; }
        const unsigned old = xb_add(&bar[XB_XSUB(bx)], 1u);
        const unsigned gen = old / nloc;
        if (old + 1u == (gen + 1u) * nloc) {
            __builtin_amdgcn_fence(__ATOMIC_RELEASE, "agent");
            asm volatile("s_waitcnt vmcnt(0)" ::: "memory");
            const unsigned og = xb_add(&bar[XB_TOP], 1u);
            const unsigned tg = og / nx;
            if (og + 1u == (tg + 1u) * nx) xb_add(&bar[XB_TOPGEN], 1u);
            else XB_SPIN(xb_ld(&bar[XB_TOPGEN]) == tg, bar);
            __builtin_amdgcn_fence(__ATOMIC_ACQUIRE, "agent");
            xb_add(&bar[XB_XGEN(bx)], 1u);
            asm volatile("s_waitcnt vmcnt(0)" ::: "memory");
        } else {
            XB_SPIN(xb_ld(&bar[XB_XGEN(bx)]) == gen, bar);
            __builtin_amdgcn_fence(__ATOMIC_ACQUIRE, "agent");
            asm volatile("s_waitcnt vmcnt(0)" ::: "memory");
        }
    }
    __syncthreads();
}


typedef short bf16x8 __attribute__((ext_vector_type(8)));
typedef float f32x16 __attribute__((ext_vector_type(16)));
typedef float f32x2 __attribute__((ext_vector_type(2)));
typedef __bf16 bf16x2_t __attribute__((ext_vector_type(2)));
__device__ __forceinline__ unsigned cvtpk(float lo, float hi) { f32x2 v = {lo, hi}; return __builtin_bit_cast(unsigned, __builtin_convertvector(v, bf16x2_t)); }
#define MFMA32(a, b, c) __builtin_amdgcn_mfma_f32_32x32x16_bf16((a), (b), (c), 0, 0, 0)
#define PACK8(x, s) __builtin_bit_cast(bf16x8, (v4u){cvtpk((x)[8 * (s)], (x)[8 * (s) + 1]), cvtpk((x)[8 * (s) + 2], (x)[8 * (s) + 3]), cvtpk((x)[8 * (s) + 4], (x)[8 * (s) + 5]), cvtpk((x)[8 * (s) + 6], (x)[8 * (s) + 7])})
__device__ __forceinline__ int crow(int reg, int h) { return (reg & 3) + 8 * (reg >> 2) + 4 * h; }
__device__ __forceinline__ int keyperm(int k) { return (k & ~12) | ((k & 4) << 1) | ((k & 8) >> 1); }
constexpr int KP = 144;
__device__ __forceinline__ int vt_off(int d, int kp, int VP) { return d * VP + ((((kp >> 3) ^ ((d >> 3) & 7))) << 4) + ((kp & 7) << 1); }
__device__ __forceinline__ void vt_write8(LAS unsigned char* Vt, int VP, int c  , int kp, v4u v) {
    LAS unsigned char* base = Vt + (((kp >> 3) ^ c) << 4) + ((kp & 7) << 1) + (8 * c) * VP;
    *(LAS unsigned short*)(base + 0 * VP) = (unsigned short)(v.x & 0xffff); *(LAS unsigned short*)(base + 1 * VP) = (unsigned short)(v.x >> 16);
    *(LAS unsigned short*)(base + 2 * VP) = (unsigned short)(v.y & 0xffff); *(LAS unsigned short*)(base + 3 * VP) = (unsigned short)(v.y >> 16);
    *(LAS unsigned short*)(base + 4 * VP) = (unsigned short)(v.z & 0xffff); *(LAS unsigned short*)(base + 5 * VP) = (unsigned short)(v.z >> 16);
    *(LAS unsigned short*)(base + 6 * VP) = (unsigned short)(v.w & 0xffff); *(LAS unsigned short*)(base + 7 * VP) = (unsigned short)(v.w >> 16);
}

struct AttnU { int b, h, g, dil, res, Q0; };
__device__ __forceinline__ AttnU attn_decode(int u) { AttnU a; const int w16 = u & 15; int t = u >> 4; a.g = t % 3; t /= 3; a.h = t & 3; a.b = t >> 2; a.dil = 1 << (2 * a.g); a.res = w16 & (a.dil - 1); a.Q0 = (w16 >> (2 * a.g)) * 256; return a; }
__device__ __forceinline__ void attn_load(const bf16* proj, const AttnU& a, int tid, v4u (&pk)[6], v4u (&pv)[6]) {
#pragma unroll
    for (int it = 0; it < 6; ++it) { const int idx = tid + it * 512; const int key = idx >> 3, c = idx & 7, i = a.Q0 - 128 + key;
        if (i >= 0) { const bf16* src = proj + ((size_t)a.b * SEQ + (size_t)i * a.dil + a.res) * NIN + a.h * 64 + c * 8; pk[it] = *(const v4u*)(src + C_AK); pv[it] = *(const v4u*)(src + C_AV); } }
}
__device__ __forceinline__ void attn_phase(const bf16* proj, bf16* og, float* lse, int u0, int ustride, int nunits, LAS unsigned char* L, int tid) {
    const int lane = tid & 63, wave = tid >> 6, wave_u = __builtin_amdgcn_readfirstlane(tid >> 6);
    constexpr int VP = 784;
    LAS unsigned char* Kimg = L; LAS unsigned char* Vt = L + 384 * KP;
    v4u pk[6], pv[6];
    if (u0 < nunits) { const AttnU a0 = attn_decode(u0); attn_load(proj, a0, tid, pk, pv); }
#pragma unroll 1
    for (int u = u0; u < nunits; u += ustride) {
        const AttnU a = attn_decode(u);
        const int r = lane & 31, hh = lane >> 5;
        const size_t rowbase = (size_t)a.b * SEQ;
        const size_t qrow = rowbase + (size_t)(a.Q0 + 32 * wave + r) * a.dil + a.res;
        bf16x8 qf[4];
#pragma unroll
        for (int s = 0; s < 4; ++s) qf[s] = *(const bf16x8*)(proj + qrow * NIN + C_AQ + a.h * 64 + 16 * s + 8 * hh);
#pragma unroll
        for (int it = 0; it < 6; ++it) { const int idx = tid + it * 512; const int key = idx >> 3, c = idx & 7, i = a.Q0 - 128 + key;
            if (i >= 0) { *(LAS v4u*)(Kimg + key * KP + c * 16) = pk[it]; vt_write8(Vt, VP, c, keyperm(key), pv[it]); } }
        __syncthreads();
        if (u + ustride < nunits) { const AttnU an = attn_decode(u + ustride); attn_load(proj, an, tid, pk, pv); }
        {
            const float slope2 = exp2f(-2.0f * (float)(a.h + 1)) * LOG2E * (float)a.dil;
            const int jt0 = (a.Q0 == 0 && wave_u < 4) ? 4 - wave_u : 0;
            float mx = -INFINITY, l = 0.f;
            f32x16 O[2];
#pragma unroll
            for (int i = 0; i < 16; ++i) { O[0][i] = 0.f; O[1][i] = 0.f; }
            const LAS unsigned char* kb = Kimg + (32 * wave + r) * KP + 16 * hh;
            bf16x8 kf[4];
#pragma unroll
            for (int s = 0; s < 4; ++s) kf[s] = *(const LAS bf16x8*)(kb + jt0 * (32 * KP) + 32 * s);
#pragma unroll 1
            for (int jt = jt0; jt < 5; ++jt) {
                f32x16 acc;
#pragma unroll
                for (int i = 0; i < 16; ++i) acc[i] = 0.f;
#pragma unroll
                for (int s = 0; s < 4; ++s) acc = MFMA32(kf[s], qf[s], acc);
                if (jt + 1 < 5) {
#pragma unroll
                    for (int s = 0; s < 4; ++s) kf[s] = *(const LAS bf16x8*)(kb + (jt + 1) * (32 * KP) + 32 * s); }
                const float bq = slope2 * (float)(128 + r - 32 * jt); float tmax = -INFINITY;
#pragma unroll
                for (int i = 0; i < 16; ++i) { const int kk = crow(i, hh); float v = acc[i] - bq + slope2 * (float)kk;
                    if (jt == 0 && kk < r) v = -INFINITY; if (jt == 4 && kk > r) v = -INFINITY; acc[i] = v; tmax = fmaxf(tmax, v); }
                tmax = fmaxf(tmax, __shfl_xor(tmax, 32));
                const float mn = fmaxf(mx, tmax), corr = __builtin_amdgcn_exp2f(mx - mn);
                l *= corr;
#pragma unroll
                for (int i = 0; i < 16; ++i) { O[0][i] *= corr; O[1][i] *= corr; }
#pragma unroll
                for (int i = 0; i < 16; ++i) { const float pvv = __builtin_amdgcn_exp2f(acc[i] - mn); acc[i] = pvv; l += pvv; }
                mx = mn;
                const int T = wave + jt;
#pragma unroll
                for (int s = 0; s < 2; ++s) { const bf16x8 pf = PACK8(acc, s);
#pragma unroll
                    for (int dt = 0; dt < 2; ++dt) { const int d = 32 * dt + r, G = 4 * T + 2 * s + hh;
                        const bf16x8 vf = *(const LAS bf16x8*)(Vt + d * VP + ((G ^ ((d >> 3) & 7)) << 4)); O[dt] = MFMA32(vf, pf, O[dt]); } }
            }
            l += __shfl_xor(l, 32);
            const float inv = 1.0f / l;
            bf16* orow = og + ((size_t)a.g * M + qrow) * 256 + a.h * 64;
#pragma unroll
            for (int dt = 0; dt < 2; ++dt)
#pragma unroll
                for (int i4 = 0; i4 < 4; ++i4) { v2u w; w.x = cvtpk(O[dt][4 * i4] * inv, O[dt][4 * i4 + 1] * inv); w.y = cvtpk(O[dt][4 * i4 + 2] * inv, O[dt][4 * i4 + 3] * inv);
                    *(v2u*)(orow + 32 * dt + 8 * i4 + 4 * hh) = w; }
            if (hh == 0) lse[((size_t)a.g * M + qrow) * 4 + a.h] = mx + __builtin_amdgcn_logf(l);
        }
        __syncthreads();
    }
}
__device__ __forceinline__ void attn_combine(const bf16* proj, const bf16* og, const float* lse, bf16* y, int gtid, int gthreads, int iend) {
#pragma unroll 4
    for (int idx = gtid; idx < iend; idx += gthreads) { const int row = idx >> 5, hc = idx & 31, h = hc >> 3, c = hc & 7;
        const size_t off = (size_t)row * 256 + h * 64 + c * 8;
        const float l0 = lse[(size_t)row * 4 + h], l1 = lse[((size_t)M + row) * 4 + h], l2 = lse[((size_t)2 * M + row) * 4 + h];
        const v4u a0 = __builtin_nontemporal_load((const v4u*)(og + off)), a1 = __builtin_nontemporal_load((const v4u*)(og + (size_t)M * 256 + off)), a2 = __builtin_nontemporal_load((const v4u*)(og + (size_t)2 * M * 256 + off));
        const v4u gt = __builtin_nontemporal_load((const v4u*)(proj + (size_t)row * NIN + C_AG + h * 64 + c * 8));
        const float mx = fmaxf(l0, fmaxf(l1, l2)); float w0 = __builtin_amdgcn_exp2f(l0 - mx), w1 = __builtin_amdgcn_exp2f(l1 - mx), w2 = __builtin_amdgcn_exp2f(l2 - mx);
        const float inv = 1.0f / (w0 + w1 + w2); w0 *= inv; w1 *= inv; w2 *= inv;
        v4u o;
#define CMB(f) { const float e0 = (w0 * bf2f((unsigned short)(a0.f & 0xffff)) + w1 * bf2f((unsigned short)(a1.f & 0xffff)) + w2 * bf2f((unsigned short)(a2.f & 0xffff))) * bf2f((unsigned short)(gt.f & 0xffff)); \
                 const float e1 = (w0 * bf2f((unsigned short)(a0.f >> 16)) + w1 * bf2f((unsigned short)(a1.f >> 16)) + w2 * bf2f((unsigned short)(a2.f >> 16))) * bf2f((unsigned short)(gt.f >> 16)); o.f = cvtpk(e0, e1); }
        CMB(x) CMB(y) CMB(z) CMB(w)
#undef CMB
        *(v4u*)(y + (size_t)row * DM + h * 64 + c * 8) = o; }
}

__device__ __forceinline__ void retkv_pair(const bf16* proj, float* kvT, int pair, LAS unsigned char* L, int tid) {
    const int half = tid >> 8, t256 = tid & 255, lane = tid & 63, w4 = (tid >> 6) & 3;
    const int uu = pair * 2 + half, n = uu & 31, h = (uu >> 5) & 3, b = uu >> 7;
    constexpr int VP = 272;
    LAS unsigned char* Vt = L + half * (2 * 64 * VP); LAS unsigned char* Kz = Vt + 64 * VP;
    const float lg2 = __builtin_amdgcn_logf(1.0f - exp2f(-5.0f - (float)h));
    const size_t row0 = (size_t)b * SEQ + n * 128;
#pragma unroll
    for (int it = 0; it < 4; ++it) { const int idx = t256 + it * 256, j = idx >> 3, c = idx & 7;
        const bf16* src = proj + (row0 + j) * NIN + h * 64 + c * 8;
        const v4u kv = *(const v4u*)(src + C_DK), vv = *(const v4u*)(src + C_DV);
        const float z = __builtin_amdgcn_exp2f(lg2 * (float)(127 - j));
        v4u kz; kz.x = cvtpk(bf2f((unsigned short)(kv.x & 0xffff)) * z, bf2f((unsigned short)(kv.x >> 16)) * z); kz.y = cvtpk(bf2f((unsigned short)(kv.y & 0xffff)) * z, bf2f((unsigned short)(kv.y >> 16)) * z);
        kz.z = cvtpk(bf2f((unsigned short)(kv.z & 0xffff)) * z, bf2f((unsigned short)(kv.z >> 16)) * z); kz.w = cvtpk(bf2f((unsigned short)(kv.w & 0xffff)) * z, bf2f((unsigned short)(kv.w >> 16)) * z);
        vt_write8(Kz, VP, c, j, kz); vt_write8(Vt, VP, c, j, vv); }
    __syncthreads();
    { const int r = lane & 31, hh = lane >> 5, et = w4 >> 1, dt = w4 & 1;
      f32x16 acc;
#pragma unroll
      for (int i = 0; i < 16; ++i) acc[i] = 0.f;
      const int e = 32 * et + r, d = 32 * dt + r;
#pragma unroll
      for (int ks = 0; ks < 8; ++ks) { const int G = 2 * ks + hh;
          const bf16x8 af = *(const LAS bf16x8*)(Vt + e * VP + ((G ^ ((e >> 3) & 7)) << 4));
          const bf16x8 bfr = *(const LAS bf16x8*)(Kz + d * VP + ((G ^ ((d >> 3) & 7)) << 4));
          acc = MFMA32(af, bfr, acc); }
      float* o = kvT + (size_t)uu * 4096;
#pragma unroll
      for (int i = 0; i < 16; ++i) o[(32 * et + crow(i, hh)) * 64 + d] = acc[i]; }
    __syncthreads();
}
__device__ __forceinline__ void ret_scan(const float* kvT, bf16* prev, int gtid) {
    if (gtid >= 65536) return;
    const int bh = gtid >> 11, el = (gtid & 2047) * 2, h = bh & 3;
    const float lg2 = __builtin_amdgcn_logf(1.0f - exp2f(-5.0f - (float)h)); const float cd = __builtin_amdgcn_exp2f(lg2 * 128.0f);
    f32x2 v[32];
#pragma unroll
    for (int n = 0; n < 32; ++n) v[n] = __builtin_nontemporal_load((const f32x2*)(kvT + ((size_t)bh * 32 + n) * 4096 + el));
    f32x2 st = (f32x2){0.f, 0.f};
#pragma unroll
    for (int n = 0; n < 32; ++n) { *(unsigned*)(prev + ((size_t)bh * 32 + n) * 4096 + el) = cvtpk(st.x, st.y); st = st * cd + v[n]; }
}
__device__ __forceinline__ void ret_pair(const bf16* proj, const bf16* prev, const float* ret_g, bf16* y, int pair, LAS unsigned char* L, int tid) {
    const int half = tid >> 8, t256 = tid & 255, lane = tid & 63, w4 = (tid >> 6) & 3, w4u = __builtin_amdgcn_readfirstlane((tid >> 6) & 3);
    const int uu = pair * 2 + half, n = uu & 31, h = (uu >> 5) & 3, b = uu >> 7;
    constexpr int VP = 272;
    LAS unsigned char* Kimg = L + half * 45056; LAS unsigned char* Vt = Kimg + 128 * KP; LAS unsigned char* Pv = Vt + 64 * VP;
    const float lg2 = __builtin_amdgcn_logf(1.0f - exp2f(-5.0f - (float)h));
    const size_t row0 = (size_t)b * SEQ + n * 128;
    const int r = lane & 31, hh = lane >> 5, il = 32 * w4 + r;
    const size_t qrow = row0 + il;
    bf16x8 qf[4];
#pragma unroll
    for (int s = 0; s < 4; ++s) qf[s] = *(const bf16x8*)(proj + qrow * NIN + C_DQ + h * 64 + 16 * s + 8 * hh);
    v2u gte[2][4]; f32x4 rge[2][4];
#pragma unroll
    for (int dt = 0; dt < 2; ++dt)
#pragma unroll
        for (int i4 = 0; i4 < 4; ++i4) { const int e = 32 * dt + 8 * i4 + 4 * hh; gte[dt][i4] = *(const v2u*)(proj + qrow * NIN + C_DG + h * 64 + e); rge[dt][i4] = *(const f32x4*)(ret_g + h * 64 + e); }
#pragma unroll
    for (int it = 0; it < 4; ++it) { const int idx = t256 + it * 256, j = idx >> 3, c = idx & 7;
        const bf16* src = proj + (row0 + j) * NIN + h * 64 + c * 8;
        const v4u kv = *(const v4u*)(src + C_DK), vv = *(const v4u*)(src + C_DV);
        *(LAS v4u*)(Kimg + j * KP + c * 16) = kv;
        vt_write8(Vt, VP, c, keyperm(j), vv); }
    { const int e = t256 >> 2, d0 = (t256 & 3) * 16;
      const v4u* pp = (const v4u*)(prev + (size_t)uu * 4096 + e * 64 + d0);
      const v4u w0 = __builtin_nontemporal_load(pp), w1 = __builtin_nontemporal_load(pp + 1);
      *(LAS v4u*)(Pv + e * KP + d0 * 2) = w0; *(LAS v4u*)(Pv + e * KP + d0 * 2 + 16) = w1; }
    __syncthreads();
    {
        f32x16 O[2], C[2];
#pragma unroll
        for (int i = 0; i < 16; ++i) { O[0][i] = 0.f; O[1][i] = 0.f; C[0][i] = 0.f; C[1][i] = 0.f; }
#pragma unroll 1
        for (int T = 0; T <= w4u; ++T) {
            f32x16 acc;
#pragma unroll
            for (int i = 0; i < 16; ++i) acc[i] = 0.f;
#pragma unroll
            for (int s = 0; s < 4; ++s) { const bf16x8 kf = *(const LAS bf16x8*)(Kimg + (32 * T + r) * KP + 32 * s + 16 * hh); acc = MFMA32(kf, qf[s], acc); }
#pragma unroll
            for (int i = 0; i < 16; ++i) { const int diff = il - 32 * T - crow(i, hh); acc[i] = (diff >= 0) ? acc[i] * __builtin_amdgcn_exp2f(lg2 * (float)diff) : 0.f; }
#pragma unroll
            for (int s = 0; s < 2; ++s) { const bf16x8 pf = PACK8(acc, s);
#pragma unroll
                for (int dt = 0; dt < 2; ++dt) { const int d = 32 * dt + r, G = 4 * T + 2 * s + hh;
                    const bf16x8 vf = *(const LAS bf16x8*)(Vt + d * VP + ((G ^ ((d >> 3) & 7)) << 4)); O[dt] = MFMA32(vf, pf, O[dt]); } }
        }
#pragma unroll
        for (int dt = 0; dt < 2; ++dt)
#pragma unroll
            for (int s = 0; s < 4; ++s) { const bf16x8 pf = *(const LAS bf16x8*)(Pv + (32 * dt + r) * KP + 32 * s + 16 * hh); C[dt] = MFMA32(pf, qf[s], C[dt]); }
        const float xi = __builtin_amdgcn_exp2f(lg2 * (float)(il + 1));
        float sm = 0.f;
#pragma unroll
        for (int dt = 0; dt < 2; ++dt)
#pragma unroll
            for (int i = 0; i < 16; ++i) { O[dt][i] += xi * C[dt][i]; sm += O[dt][i]; }
        sm += __shfl_xor(sm, 32); const float mu = sm * (1.f / 64.f); float sq = 0.f;
#pragma unroll
        for (int dt = 0; dt < 2; ++dt)
#pragma unroll
            for (int i = 0; i < 16; ++i) { O[dt][i] -= mu; sq += O[dt][i] * O[dt][i]; }
        sq += __shfl_xor(sq, 32); const float rstd = 1.f / sqrtf(sq * (1.f / 64.f) + EPS);
#pragma unroll
        for (int dt = 0; dt < 2; ++dt)
#pragma unroll
            for (int i4 = 0; i4 < 4; ++i4) { const int e = 32 * dt + 8 * i4 + 4 * hh;
                const f32x4 rg = rge[dt][i4]; const v2u gt = gte[dt][i4];
                v2u w; w.x = cvtpk(O[dt][4 * i4] * rstd * rg.x * bf2f((unsigned short)(gt.x & 0xffff)), O[dt][4 * i4 + 1] * rstd * rg.y * bf2f((unsigned short)(gt.x >> 16)));
                w.y = cvtpk(O[dt][4 * i4 + 2] * rstd * rg.z * bf2f((unsigned short)(gt.y & 0xffff)), O[dt][4 * i4 + 3] * rstd * rg.w * bf2f((unsigned short)(gt.y >> 16)));
                *(v2u*)(y + qrow * DM + 768 + h * 64 + e) = w; }
    }
    __syncthreads();
}

__device__ __forceinline__ void sgu_unit(const bf16* proj, bf16* y, const float* sgu_g, const bf16* wb  , const float* sgu_b, int u, LAS unsigned char* L, int tid) {
    const int lane = tid & 63, wave = tid >> 6;
    constexpr int VP = 272, GI = 64 * VP + 32;
    LAS unsigned char* Vt = L;
    const size_t row0 = (size_t)u * 128;
    { const int s = tid >> 2, q = tid & 3;
      const bf16* src = proj + (row0 + s) * NIN + C_BV + 64 * q;
      v4u w[8];
#pragma unroll
      for (int c = 0; c < 8; ++c) w[c] = *(const v4u*)(src + 8 * c);
      float sm = 0.f, sq = 0.f;
#pragma unroll
      for (int c = 0; c < 8; ++c) {
          const float e0 = bf2f((unsigned short)(w[c].x & 0xffff)), e1 = bf2f((unsigned short)(w[c].x >> 16)), e2 = bf2f((unsigned short)(w[c].y & 0xffff)), e3 = bf2f((unsigned short)(w[c].y >> 16));
          const float e4 = bf2f((unsigned short)(w[c].z & 0xffff)), e5 = bf2f((unsigned short)(w[c].z >> 16)), e6 = bf2f((unsigned short)(w[c].w & 0xffff)), e7 = bf2f((unsigned short)(w[c].w >> 16));
          sm += ((e0 + e1) + (e2 + e3)) + ((e4 + e5) + (e6 + e7));
          sq += ((e0 * e0 + e1 * e1) + (e2 * e2 + e3 * e3)) + ((e4 * e4 + e5 * e5) + (e6 * e6 + e7 * e7)); }
      sm += __shfl_xor(sm, 1); sq += __shfl_xor(sq, 1); sm += __shfl_xor(sm, 2); sq += __shfl_xor(sq, 2);
      const float mean = sm * (1.f / 256.f); const float var = fmaxf(sq * (1.f / 256.f) - mean * mean, 0.f); const float rstd = 1.f / sqrtf(var + EPS);
#pragma unroll
      for (int c = 0; c < 8; ++c) { const f32x4 g0 = *(const f32x4*)(sgu_g + 64 * q + 8 * c), g1 = *(const f32x4*)(sgu_g + 64 * q + 8 * c + 4);
          v4u o; o.x = cvtpk((bf2f((unsigned short)(w[c].x & 0xffff)) - mean) * rstd * g0.x, (bf2f((unsigned short)(w[c].x >> 16)) - mean) * rstd * g0.y);
          o.y = cvtpk((bf2f((unsigned short)(w[c].y & 0xffff)) - mean) * rstd * g0.z, (bf2f((unsigned short)(w[c].y >> 16)) - mean) * rstd * g0.w);
          o.z = cvtpk((bf2f((unsigned short)(w[c].z & 0xffff)) - mean) * rstd * g1.x, (bf2f((unsigned short)(w[c].z >> 16)) - mean) * rstd * g1.y);
          o.w = cvtpk((bf2f((unsigned short)(w[c].w & 0xffff)) - mean) * rstd * g1.z, (bf2f((unsigned short)(w[c].w >> 16)) - mean) * rstd * g1.w);
          vt_write8(Vt + q * GI, VP, c, s, o); } }
    __syncthreads();
    { const int r = lane & 31, hh = lane >> 5, g = wave >> 1, dt = wave & 1, d = 32 * dt + r;
      const LAS unsigned char* vg = Vt + g * GI + d * VP; const int sw = (d >> 3) & 7;
#pragma unroll
      for (int tt = 0; tt < 4; ++tt) { f32x16 acc;
#pragma unroll
          for (int i = 0; i < 16; ++i) acc[i] = 0.f;
          const bf16* wrow = wb + ((size_t)g * 128 + 32 * tt + r) * 128 + 8 * hh;
#pragma unroll
          for (int ks = 0; ks < 2 * (tt + 1); ++ks) { const bf16x8 af = *(const LAS bf16x8*)(vg + (((2 * ks + hh) ^ sw) << 4)); const bf16x8 bfr = *(const bf16x8*)(wrow + 16 * ks); acc = MFMA32(af, bfr, acc); }
          const int t = 32 * tt + r; const size_t row = row0 + t; const float bias = sgu_b[g * 128 + t];
#pragma unroll
          for (int i4 = 0; i4 < 4; ++i4) { const int d0 = 32 * dt + 8 * i4 + 4 * hh;
              const v2u uu = *(const v2u*)(proj + row * NIN + C_BU + g * 64 + d0), gt = *(const v2u*)(proj + row * NIN + C_BG + g * 64 + d0);
              v2u w; w.x = cvtpk((acc[4 * i4] + bias) * bf2f((unsigned short)(uu.x & 0xffff)) * bf2f((unsigned short)(gt.x & 0xffff)), (acc[4 * i4 + 1] + bias) * bf2f((unsigned short)(uu.x >> 16)) * bf2f((unsigned short)(gt.x >> 16)));
              w.y = cvtpk((acc[4 * i4 + 2] + bias) * bf2f((unsigned short)(uu.y & 0xffff)) * bf2f((unsigned short)(gt.y & 0xffff)), (acc[4 * i4 + 3] + bias) * bf2f((unsigned short)(uu.y >> 16)) * bf2f((unsigned short)(gt.y >> 16)));
              *(v2u*)(y + row * DM + 256 + g * 64 + d0) = w; } } }
    __syncthreads();
}
template <int PW>
__device__ __forceinline__ void pool_run(const bf16* src  , LAS unsigned char* dst, int tok  , int AP) {
    v4u x[PW + 7];
#pragma unroll
    for (int q = 0; q < PW + 7; ++q) { const int rel = q - (PW - 1); x[q] = (tok + rel >= 0) ? *(const v4u*)(src + (ptrdiff_t)rel * NIN) : (v4u){0u, 0u, 0u, 0u}; }
    float s[8];
#pragma unroll
    for (int c = 0; c < 8; ++c) s[c] = 0.f;
#define ADDX(q, sg) { s[0] += sg bf2f((unsigned short)(x[q].x & 0xffff)); s[1] += sg bf2f((unsigned short)(x[q].x >> 16)); s[2] += sg bf2f((unsigned short)(x[q].y & 0xffff)); s[3] += sg bf2f((unsigned short)(x[q].y >> 16)); \
                      s[4] += sg bf2f((unsigned short)(x[q].z & 0xffff)); s[5] += sg bf2f((unsigned short)(x[q].z >> 16)); s[6] += sg bf2f((unsigned short)(x[q].w & 0xffff)); s[7] += sg bf2f((unsigned short)(x[q].w >> 16)); }
#pragma unroll
    for (int q = 0; q < PW - 1; ++q) ADDX(q, +)
#pragma unroll
    for (int i = 0; i < 8; ++i) { const int q = PW - 1 + i; ADDX(q, +)
        const int cnt = (tok + i + 1 < PW) ? tok + i + 1 : PW; const float ic = 1.0f / (float)cnt; const v4u w0 = x[q];
        v4u o; o.x = cvtpk(s[0] * ic - bf2f((unsigned short)(w0.x & 0xffff)), s[1] * ic - bf2f((unsigned short)(w0.x >> 16))); o.y = cvtpk(s[2] * ic - bf2f((unsigned short)(w0.y & 0xffff)), s[3] * ic - bf2f((unsigned short)(w0.y >> 16)));
        o.z = cvtpk(s[4] * ic - bf2f((unsigned short)(w0.z & 0xffff)), s[5] * ic - bf2f((unsigned short)(w0.z >> 16))); o.w = cvtpk(s[6] * ic - bf2f((unsigned short)(w0.w & 0xffff)), s[7] * ic - bf2f((unsigned short)(w0.w >> 16)));
        *(LAS v4u*)(dst + i * AP) = o;
        ADDX(i, -) }
#undef ADDX
}
__device__ __forceinline__ void pool_unit(const bf16* proj, bf16* y, const bf16* pwt  , const float* pool_scale, int u, LAS unsigned char* L, int tid) {
    const int lane = tid & 63, wave = tid >> 6;
    constexpr int AP = 528;
    const size_t row0 = (size_t)u * 128; const int tok0 = (u & 31) * 128;
    { const int wu = __builtin_amdgcn_readfirstlane(tid >> 6), g = wu >> 1, c32 = 8 * g + (lane & 7), run = (lane >> 3) + 8 * (wu & 1), t0 = 8 * run;
      const bf16* src = proj + (row0 + t0) * NIN + C_CX + 8 * c32; LAS unsigned char* dst = L + t0 * AP + c32 * 16; const int tk = tok0 + t0;
      if (g == 0) pool_run<2>(src, dst, tk, AP); else if (g == 1) pool_run<4>(src, dst, tk, AP); else if (g == 2) pool_run<8>(src, dst, tk, AP); else pool_run<16>(src, dst, tk, AP); }
    __syncthreads();
    { const int r = lane & 31, hh = lane >> 5, g = wave >> 1, dt = wave & 1;
      bf16x8 af[4];
#pragma unroll
      for (int ks = 0; ks < 4; ++ks) af[ks] = *(const bf16x8*)(pwt + ((size_t)g * 64 + 32 * dt + r) * 64 + 16 * ks + 8 * hh);
      f32x4 sc[4]; v2u gts[4][4];
#pragma unroll
      for (int i4 = 0; i4 < 4; ++i4) { const int d0 = 32 * dt + 8 * i4 + 4 * hh; sc[i4] = *(const f32x4*)(pool_scale + g * 64 + d0);
#pragma unroll
          for (int tt = 0; tt < 4; ++tt) gts[tt][i4] = *(const v2u*)(proj + (row0 + 32 * tt + r) * NIN + C_CG + g * 64 + d0); }
#pragma unroll
      for (int tt = 0; tt < 4; ++tt) { f32x16 acc;
#pragma unroll
          for (int i = 0; i < 16; ++i) acc[i] = 0.f;
#pragma unroll
          for (int ks = 0; ks < 4; ++ks) { const bf16x8 bfr = *(const LAS bf16x8*)(L + (32 * tt + r) * AP + (g * 64 + 16 * ks + 8 * hh) * 2); acc = MFMA32(af[ks], bfr, acc); }
          const size_t row = row0 + 32 * tt + r;
#pragma unroll
          for (int i4 = 0; i4 < 4; ++i4) { const int d0 = 32 * dt + 8 * i4 + 4 * hh; const v2u gt = gts[tt][i4];
              v2u w; w.x = cvtpk(acc[4 * i4] * sc[i4].x * bf2f((unsigned short)(gt.x & 0xffff)), acc[4 * i4 + 1] * sc[i4].y * bf2f((unsigned short)(gt.x >> 16)));
              w.y = cvtpk(acc[4 * i4 + 2] * sc[i4].z * bf2f((unsigned short)(gt.y & 0xffff)), acc[4 * i4 + 3] * sc[i4].w * bf2f((unsigned short)(gt.y >> 16)));
              *(v2u*)(y + row * DM + 512 + g * 64 + d0) = w; } } }
    __syncthreads();
}

#define PHASE_IDS() int tid = threadIdx.x; asm volatile("" : "+v"(tid)); const int lane = tid & 63; const int wave = __builtin_amdgcn_readfirstlane(tid >> 6); const int gw = (int)blockIdx.x * 8 + wave; (void)lane; (void)gw
#define PHASE_PTRS() size_t z0_ = 0; asm volatile("" : "+s"(z0_)); unsigned char* ws = p.ws + z0_;     const float* x = p.in[0]; const float* w_in = p.in[2]; const float* w_out = p.in[9]; \
    const float* PRM = (const float*)(ws + WS_SMALL); bf16* WinT = (bf16*)(ws + WS_WIN); bf16* WoutT = (bf16*)(ws + WS_WOUT); bf16* XB = (bf16*)(ws + WS_XB); bf16* PROJ = (bf16*)(ws + WS_PROJ); \
    bf16* Y = (bf16*)(ws + WS_Y); bf16* Z = (bf16*)(ws + WS_Z); float* KVT = (float*)(ws + WS_KV); bf16* OG = (bf16*)(ws + WS_OG); float* LSE = (float*)(ws + WS_LSE); \
    float* R0P_ = (float*)(ws + WS_R0 + R0_PPART); float* R0Y_ = (float*)(ws + WS_R0 + R0_Y); float* R0Z_ = (float*)(ws + WS_R0 + R0_ZPART); float* R0H_ = (float*)(ws + WS_R0 + R0_H); (void)R0H_; \
    (void)x; (void)w_in; (void)w_out; (void)PRM; (void)WinT; (void)WoutT; (void)XB; (void)PROJ; (void)Y; (void)Z; (void)KVT; (void)OG; (void)LSE; (void)R0P_; (void)R0Y_; (void)R0Z_
#ifndef PROBE_A
#define PROBE_A (-1)
#define PROBE_B (-1)
#endif
#define TS(k) do { if (PROBE_A == (k) && blockIdx.x == 0 && threadIdx.x == 0) *(volatile LAS unsigned long long*)(L + 139280) = __builtin_amdgcn_s_memrealtime(); \
                   if (PROBE_B == (k) && blockIdx.x == 0 && threadIdx.x == 0) *(volatile LAS unsigned long long*)(L + 139288) = __builtin_amdgcn_s_memrealtime() - *(volatile LAS unsigned long long*)(L + 139280); } while (0)
template <int l>
__device__ __forceinline__ void layer_body(const Params& p, LAS unsigned char* L, const XcdBarrier& bar) {
    constexpr int G = 256, NGW = G * 8;

        { PHASE_PTRS(); pg8::Gemm g{XB, WinT + (size_t)l * NIN * DM, M, NIN, DM}; pg8::StaticOrder S; S.init(M, NIN, G, (int)blockIdx.x);
          pg8::EpiOut E{PROJ, NIN, (1u << 3) | (1u << 6) | (1u << 8) | (1u << 12)};
          pg8::gemm_phase<pg8::EpiOut, pg8::StaticOrder, true, true>((PG8_LAS unsigned char*)L, g, S, E); }
        if (l == 0 && (int)blockIdx.x >= 128) { PHASE_IDS(); PHASE_PTRS();
            LAS float* scr = (LAS float*)(L + wave * 16384); const int w1 = ((int)blockIdx.x - 128) * 8 + wave;
            constexpr int I_IN = (DM / 64) * (NIN / 32), I_OUT = (DM / 64) * (DM / 32);
            for (int it = w1; it < 2 * I_OUT + I_IN; it += 1024) {
                if (it < I_OUT) p0_transpose_item(w_out, DM, DM, WoutT, nullptr, 0, scr, it, lane);
                else if (it < 2 * I_OUT) p0_transpose_item(w_out + (size_t)DM * DM, DM, DM, WoutT + (size_t)DM * DM, nullptr, 0, scr, it - I_OUT, lane);
                else p0_transpose_item(w_in + (size_t)DM * NIN, DM, NIN, WinT + (size_t)NIN * DM, PRM + P_PREG + DM, 1, scr, it - 2 * I_OUT, lane); } }
        { PHASE_IDS(); PHASE_PTRS();
          if ((int)blockIdx.x >= 128) for (int task = ((int)blockIdx.x - 128) * 8 + wave; task < 52 * R0_KC; task += 1024) r0_dot_task<2>(R0H_, w_in + (size_t)l * DM * NIN, NIN, R0P_, task, 52, lane); }
        xcd_barrier(bar); TS(1 + 5 * l + 1);
        { PHASE_IDS(); PHASE_PTRS();
          if ((int)blockIdx.x >= 248) r0_mix(R0P_, R0Y_, (int)blockIdx.x - 248, PRM + P_SGUG + l * 256, PRM + P_SGUW + (size_t)l * 65536, PRM + P_SGUB + l * 512, PRM + P_RETG + l * 256, (LAS float*)L, tid); }
        { PHASE_IDS(); PHASE_PTRS(); for (int k = 0; k < 2; ++k) retkv_pair(PROJ, KVT, 64 * ((int)blockIdx.x & 7) + ((int)blockIdx.x >> 3) + 32 * k, L, tid); }
        { PHASE_IDS(); PHASE_PTRS(); const int c = (int)blockIdx.x; attn_phase(PROJ, OG, LSE, 192 * (c & 7) + (c >> 3), 32, 192 * ((c & 7) + 1), L, tid); }
        { PHASE_IDS(); PHASE_PTRS(); { const int u = 32 * ((int)blockIdx.x & 7) + ((int)blockIdx.x >> 3); sgu_unit(PROJ, Y, PRM + P_SGUG + l * 256, (const bf16*)(ws + WS_SGUWB) + (size_t)l * 65536, PRM + P_SGUB + l * 512, u, L, tid); } }
        { PHASE_IDS(); PHASE_PTRS(); { const int u = 32 * ((int)blockIdx.x & 7) + ((int)blockIdx.x >> 3); pool_unit(PROJ, Y, (const bf16*)(ws + WS_PWT) + (size_t)l * 16384, PRM + P_POOLS + l * 256, u, L, tid); } }
        xcd_barrier(bar); TS(1 + 5 * l + 2);
        { PHASE_IDS(); PHASE_PTRS(); ret_scan(KVT, (bf16*)(ws + WS_PREV), (32 * ((int)blockIdx.x & 7) + ((int)blockIdx.x >> 3)) * 256 + tid - ((tid >= 256) ? 256 - 65536 : 0));
          if ((int)blockIdx.x < 16 * R0_KCZ) {
              LAS float* red = (LAS float*)L;
              float acc[8];
              if (wave >= 4) { r0_dot_sub(R0Y_, w_out + (size_t)l * DM * DM, DM, (int)blockIdx.x, 16, wave - 4, lane, acc);
                  if (wave > 4) {
#pragma unroll
                      for (int b = 0; b < 8; ++b) red[((wave - 5) * 8 + b) * 64 + lane] = acc[b]; } }
              __syncthreads();
              if (wave == 4) { const int ch = (int)blockIdx.x % 16, kc = (int)blockIdx.x / 16;
#pragma unroll
                  for (int b = 0; b < 8; ++b) R0Z_[((size_t)kc * 8 + b) * DM + ch * 64 + lane] = ((acc[b] + red[(0 * 8 + b) * 64 + lane]) + red[(1 * 8 + b) * 64 + lane]) + red[(2 * 8 + b) * 64 + lane]; }
              __syncthreads(); } }
        xcd_barrier(bar);
        { PHASE_IDS(); PHASE_PTRS(); for (int k = 0; k < 2; ++k) ret_pair(PROJ, (const bf16*)(ws + WS_PREV), PRM + P_RETG + l * 256, Y, 64 * ((int)blockIdx.x & 7) + ((int)blockIdx.x >> 3) + 32 * k, L, tid);
          attn_combine(PROJ, OG, LSE, Y, ((int)blockIdx.x & 7) * 131072 + ((int)blockIdx.x >> 3) * 512 + tid, 16384, (((int)blockIdx.x & 7) + 1) * 131072); }
        xcd_barrier(bar); TS(1 + 5 * l + 3);
        { PHASE_PTRS(); pg8::Gemm g{Y, WoutT + (size_t)l * DM * DM, M, DM, DM}; pg8::StaticOrder S; S.init(M, DM, G, (int)blockIdx.x);
          pg8::EpiOut E{Z, DM, 0u};
          pg8::gemm_phase<pg8::EpiOut, pg8::StaticOrder, true, true>((PG8_LAS unsigned char*)L, g, S, E); }
        xcd_barrier(bar); TS(1 + 5 * l + 4);
        { PHASE_IDS(); PHASE_PTRS(); const int NR = M / NGW; float* RS = (float*)(ws + WS_RS); float* R0X = (float*)(ws + WS_RS + 262144);
          f32x4 pg[4];
#pragma unroll
          for (int j = 0; j < 4; ++j) pg[j] = *((const f32x4*)(PRM + P_POSTG + l * DM) + lane + 64 * j);
          v2u zc[4], zn[4]; f32x4 xc[4], xn_[4]; v2u bc[4], bn[4];
          { const int m = gw % NGW;
#pragma unroll
            for (int j = 0; j < 4; ++j) { zc[j] = __builtin_nontemporal_load((const v2u*)(Z + (size_t)m * DM) + lane + 64 * j);
                if (l == 0) xc[j] = __builtin_nontemporal_load((const f32x4*)(x + (size_t)m * DM) + lane + 64 * j); else bc[j] = __builtin_nontemporal_load((const v2u*)(XB + (size_t)m * DM) + lane + 64 * j); } }
#pragma unroll 1
          for (int i = 0; i < NR; ++i) { const int m = i * NGW + (gw + i * 257) % NGW; const bool r0 = (m & (SEQ - 1)) == 0;
              if (i + 1 < NR) { const int mn = (i + 1) * NGW + (gw + (i + 1) * 257) % NGW;
#pragma unroll
                  for (int j = 0; j < 4; ++j) { zn[j] = __builtin_nontemporal_load((const v2u*)(Z + (size_t)mn * DM) + lane + 64 * j);
                      if (l == 0) xn_[j] = __builtin_nontemporal_load((const f32x4*)(x + (size_t)mn * DM) + lane + 64 * j); else bn[j] = __builtin_nontemporal_load((const v2u*)(XB + (size_t)mn * DM) + lane + 64 * j); } }
              f32x4 z[4], xv[4];
              if (r0) r0z_sum(R0Z_ + (size_t)(m >> 12) * DM, lane, z);
              else {
#pragma unroll
                  for (int j = 0; j < 4; ++j) unpack4(zc[j], z[j]); }
              if (l == 0) {
#pragma unroll
                  for (int j = 0; j < 4; ++j) xv[j] = xc[j];
              } else if (r0) {
#pragma unroll
                  for (int j = 0; j < 4; ++j) xv[j] = *((const f32x4*)(R0X + (size_t)(m >> 12) * DM) + lane + 64 * j);
              } else { const float rs = RS[m];
#pragma unroll
                  for (int j = 0; j < 4; ++j) { unpack4(bc[j], xv[j]); xv[j] = xv[j] * rs; } }
              const float rstd = 1.f / sqrtf(wave_sum(ssq4(z)) * (1.f / DM) + EPS);
#pragma unroll
              for (int j = 0; j < 4; ++j) xv[j] = xv[j] + z[j] * rstd * pg[j];
              if (l + 1 < DEPTH) {
                  const float q2 = wave_sum(ssq4(xv)) * (1.f / DM) + EPS; const float r2 = 1.f / sqrtf(q2);
                  v2u* o8 = (v2u*)(XB + (size_t)m * DM) + lane;
#pragma unroll
                  for (int j = 0; j < 4; ++j) { v2u w; w.x = cvtpk(xv[j].x * r2, xv[j].y * r2); w.y = cvtpk(xv[j].z * r2, xv[j].w * r2); o8[64 * j] = w; }
                  if (lane == 0) RS[m] = sqrtf(q2);
                  if (r0) {
#pragma unroll
                      for (int j = 0; j < 4; ++j) { *((f32x4*)(R0X + (size_t)(m >> 12) * DM) + lane + 64 * j) = xv[j];
                          *((f32x4*)(R0H_ + (size_t)(m >> 12) * DM) + lane + 64 * j) = xv[j] * r2 * *((const f32x4*)(PRM + P_PREG + (l + 1 < DEPTH ? l + 1 : 0) * DM) + lane + 64 * j); } }
              } else {
                  f32x4* o = (f32x4*)(p.out + (size_t)m * DM) + lane;
#pragma unroll
                  for (int j = 0; j < 4; ++j) __builtin_nontemporal_store(xv[j], o + 64 * j);
              }
#pragma unroll
              for (int j = 0; j < 4; ++j) { zc[j] = zn[j]; xc[j] = xn_[j]; bc[j] = bn[j]; } } }
        if (l + 1 < DEPTH) xcd_barrier(bar); TS(1 + 5 * l + 5);

}

__global__ void __launch_bounds__(512, 2) fwd(Params p) {
    extern __shared__ __attribute__((aligned(16))) unsigned char lds[];
    cg::grid_group grid = cg::this_grid();
    LAS unsigned char* L = (LAS unsigned char*)lds;
    constexpr int G = 256, NGW = G * 8;
    { volatile LAS unsigned* st = (volatile LAS unsigned*)(L + 139264); if (threadIdx.x < 2) st[threadIdx.x] = 0u; }
    __syncthreads();
    TS(0);
    const XcdBarrier bar = xcd_barrier_post((unsigned*)(p.ws + WS_CTL), (volatile LAS unsigned*)(L + 139264));
    {
        PHASE_IDS(); PHASE_PTRS();
        { float* prm = (float*)(ws + WS_SMALL);
          for (int i = (int)blockIdx.x * 512 + tid; i < P_END; i += G * 512) { float v;
              if (i < P_SGUG) v = p.in[1][i]; else if (i < P_SGUW) v = p.in[3][i - P_SGUG]; else if (i < P_SGUB) v = p.in[4][i - P_SGUW]; else if (i < P_POOLW) v = p.in[5][i - P_SGUB];
              else if (i < P_POOLS) v = p.in[6][i - P_POOLW]; else if (i < P_RETG) v = p.in[7][i - P_POOLS]; else if (i < P_POSTG) v = p.in[8][i - P_RETG]; else v = p.in[10][i - P_POSTG];
              prm[i] = v; } }
        { bf16* sw = (bf16*)(ws + WS_SGUWB); bf16* pw = (bf16*)(ws + WS_PWT);
          for (int i = (int)blockIdx.x * 512 + tid; i < 2 * 65536; i += G * 512) { const int s = i & 127, t = (i >> 7) & 127; sw[i] = (s <= t) ? (bf16)f2bf(p.in[4][i]) : (bf16)0; }
          for (int i = (int)blockIdx.x * 512 + tid; i < 2 * 16384; i += G * 512) { const int c = i & 63, d = (i >> 6) & 63, lg = i >> 12; pw[i] = (bf16)f2bf(p.in[6][(size_t)lg * 4096 + c * 64 + d]); } }
        LAS float* scr = (LAS float*)(L + wave * 16384);
        constexpr int I_IN = (DM / 64) * (NIN / 32);
        for (int it = gw; it < I_IN; it += NGW) p0_transpose_item(w_in, DM, NIN, WinT, p.in[1], 1, scr, it, lane);
        { constexpr int NR = M / NGW; f32x4 c0[4], c1[4], n0[4], n1[4];
#define ROWM(i) ((i) * NGW + (gw + (i) * 257) % NGW)
#define LDROW(dst, m) _Pragma("unroll") for (int j = 0; j < 4; ++j) dst[j] = __builtin_nontemporal_load((const f32x4*)(x + (size_t)(m) * DM) + lane + 64 * j)
#define P0ROW(cur, m) { const float rstd = 1.f / sqrtf(wave_sum(ssq4(cur)) * (1.f / DM) + EPS); v2u* o8 = (v2u*)(XB + (size_t)(m) * DM) + lane; \
              _Pragma("unroll") for (int j = 0; j < 4; ++j) { v2u w; w.x = cvtpk(cur[j].x * rstd, cur[j].y * rstd); w.y = cvtpk(cur[j].z * rstd, cur[j].w * rstd); o8[64 * j] = w; } \
              if (((m) & (SEQ - 1)) == 0) { _Pragma("unroll") for (int j = 0; j < 4; ++j) *((f32x4*)(R0H_ + (size_t)((m) >> 12) * DM) + lane + 64 * j) = cur[j] * rstd * *((const f32x4*)p.in[1] + lane + 64 * j); } }
          LDROW(c0, ROWM(0)); LDROW(c1, ROWM(1));
#pragma unroll 1
          for (int i = 0; i < NR; i += 2) {
              if (i + 2 < NR) { LDROW(n0, ROWM(i + 2)); LDROW(n1, ROWM(i + 3)); }
              P0ROW(c0, ROWM(i)); P0ROW(c1, ROWM(i + 1));
#pragma unroll
              for (int j = 0; j < 4; ++j) { c0[j] = n0[j]; c1[j] = n1[j]; } }
#undef LDROW
#undef P0ROW
#undef ROWM
        }
    }
    if (p.ws == nullptr) grid.sync();
    xcd_barrier(bar); TS(1);
    layer_body<0>(p, L, bar);
    layer_body<1>(p, L, bar);
    TS(11);
    if (PROBE_A >= 0 && blockIdx.x == 0 && threadIdx.x == 0) { const unsigned long long d = *(volatile LAS unsigned long long*)(L + 139288), t0 = __builtin_amdgcn_s_memrealtime(); while (__builtin_amdgcn_s_memrealtime() - t0 < 8ull * d) __builtin_amdgcn_s_sleep(8); }
}

extern "C" void kernel_launch(void* const* d_in, const int* in_sizes, int n_in, void* d_out, int out_size, void* d_ws, size_t ws_size, hipStream_t stream) {
    static int grid = 0;
    if (grid == 0) {
        if (n_in != 11 || in_sizes[0] != M * DM || out_size != M * DM || ws_size < WS_END) { fprintf(stderr, "kernel_launch: unexpected shapes (n_in %d, in0 %d, out %d, ws %zu)\n", n_in, n_in > 0 ? in_sizes[0] : -1, out_size, ws_size); grid = -1; return; }
        int dev = 0, cus = 0, per_cu = 0;
        hipGetDevice(&dev); hipDeviceGetAttribute(&cus, hipDeviceAttributeMultiprocessorCount, dev);
        if (hipFuncSetAttribute((const void*)fwd, hipFuncAttributeMaxDynamicSharedMemorySize, LDS_BYTES) != hipSuccess) { fprintf(stderr, "kernel_launch: hipFuncSetAttribute failed\n"); grid = -1; return; }
        if (hipOccupancyMaxActiveBlocksPerMultiprocessor(&per_cu, (const void*)fwd, 512, LDS_BYTES) != hipSuccess || per_cu < 1) { fprintf(stderr, "kernel_launch: occupancy query says %d\n", per_cu); per_cu = 1; }
        (void)hipGetLastError();
        grid = 256;
        if (cus != 256) fprintf(stderr, "kernel_launch: built for a 256-CU device, found %d CUs\n", cus);
        fprintf(stderr, "kernel_launch: cus %d per_cu %d grid %d\n", cus, per_cu, grid);
    }
    if (grid < 0) return;
    if (hipMemsetAsync((char*)d_ws + WS_CTL, 0, 65536, stream) != hipSuccess) { fprintf(stderr, "kernel_launch: memset failed\n"); return; }
    Params p{};
    for (int i = 0; i < 11; ++i) p.in[i] = (const float*)d_in[i];
    p.out = (float*)d_out; p.ws = (unsigned char*)d_ws;
    void* args[] = {&p};
    hipError_t e = hipLaunchCooperativeKernel((const void*)fwd, dim3(grid), dim3(512), args, LDS_BYTES, stream);
    if (e != hipSuccess) fprintf(stderr, "kernel_launch: cooperative launch failed: %s (grid %d)\n", hipGetErrorString(e), grid);
}
```

```cpp
#include <hip/hip_runtime.h>
#include <hip/hip_cooperative_groups.h>
#include <cstdio>
#include <cstdint>
namespace cg = cooperative_groups;
namespace pg8 {
#define PG8_LAS __attribute__((address_space(3)))
typedef unsigned short bf16_t;
typedef short bf16x8 __attribute__((ext_vector_type(8)));
typedef float f32x4 __attribute__((ext_vector_type(4)));
typedef unsigned u32x4 __attribute__((ext_vector_type(4)));
constexpr int BM = 256, BK = 64, HALF = 128, HTB = HALF * BK * 2  , STAGE_BYTES = 8 * HTB, NXCD = 8, WGM = 4;

__host__ __device__ __forceinline__ int lds_byte(int r, int c) { const int st = (r >> 4) * 2 + (c >> 5), rr = r & 15, cc = c & 31, ob = rr * 64 + cc * 2; return st * 1024 + (ob ^ (((ob >> 9) & 1) << 5)); }
__host__ __device__ __forceinline__ void stage_rc(int b, int& R, int& C) { const int st = b / 1024, sb = b % 1024, swz = sb ^ (((sb >> 9) & 1) << 5); R = (st >> 1) * 16 + swz / 64; C = (st & 1) * 32 + (swz % 64) / 2; }
__host__ __device__ __forceinline__ int perm32(int rho) { const int n = rho >> 4, i = rho & 15; return 8 * (i >> 2) + 4 * n + (i & 3); }

struct Unit { int pm, pn; };
struct Gemm { const bf16_t* A; const bf16_t* Bt; int M, N, K; };

struct StaticOrder {
    int nM, nN, nwg, G, c;
    __host__ __device__ void init(int M, int N, int G_, int c_) { nM = M / BM; nN = N / BM; nwg = nM * nN; G = G_; c = c_; }
    __host__ __device__ bool next(int i, Unit& u) const {
        const long L = (long)i * G + c; if (L >= nwg) return false;
        int wgid = (int)L; { const int q = nwg / NXCD, r = nwg % NXCD, xcd = wgid % NXCD, off = wgid / NXCD; wgid = (xcd < r ? xcd * (q + 1) : r * (q + 1) + (xcd - r) * q) + off; }
        const int nig = WGM * nN, gid = wgid / nig, fm = gid * WGM, gsz = (nM - fm) < WGM ? (nM - fm) : WGM;
        u.pm = fm + ((wgid % nig) % gsz); u.pn = (wgid % nig) / gsz; return true;
    }
    __device__ __forceinline__ void a_ready(const Unit&) const {}
    __device__ __forceinline__ void done(const Unit&) const {}
};

__device__ __forceinline__ unsigned cvt_pk_bf16(float lo, float hi) { unsigned r; asm volatile("v_cvt_pk_bf16_f32 %0, %1, %2" : "=v"(r) : "v"(lo), "v"(hi)); return r; }
__device__ __forceinline__ float silu_f(float x) { return x / (1.0f + __expf(-x)); }
__device__ __forceinline__ float silu_fast(float x) { return x * __builtin_amdgcn_rcpf(1.0f + __builtin_amdgcn_exp2f(x * -1.4426950408889634f)); }
struct EpiOut {
    static constexpr bool PERM = true, AFTER_DRAIN = false;
    bf16_t* O; int ldc; unsigned gate_mask;
    __device__ __forceinline__ void operator()(const f32x4 (&acc)[2][2][4][2], const Unit& u, int wr, int wc, int fr, int fq) const {
        const int row0 = u.pm * BM + wr * 64 + fr; const int col0 = u.pn * BM + wc * 32 + 8 * fq;
        const bool gate = (gate_mask >> u.pn) & 1u;
#pragma unroll
        for (int ai = 0; ai < 2; ++ai)
#pragma unroll
            for (int m = 0; m < 4; ++m) { bf16_t* rowp = O + (size_t)(row0 + ai * HALF + m * 16) * ldc + col0;
#pragma unroll
                for (int bj = 0; bj < 2; ++bj) { f32x4 v0 = acc[ai][bj][m][0], v1 = acc[ai][bj][m][1];
                    if (gate) { v0 = (f32x4){silu_fast(v0[0]), silu_fast(v0[1]), silu_fast(v0[2]), silu_fast(v0[3])}; v1 = (f32x4){silu_fast(v1[0]), silu_fast(v1[1]), silu_fast(v1[2]), silu_fast(v1[3])}; }
                    u32x4 w; w.x = cvt_pk_bf16(v0[0], v0[1]); w.y = cvt_pk_bf16(v0[2], v0[3]); w.z = cvt_pk_bf16(v1[0], v1[1]); w.w = cvt_pk_bf16(v1[2], v1[3]);
                    *(u32x4*)(rowp + bj * HALF) = w; } }
    }
};
template <class Epi, class Sched, bool ALIGN_EPI = false, bool SP2 = false>
__device__ __forceinline__ void gemm_phase(PG8_LAS unsigned char* lds, const Gemm g, const Sched& S, const Epi& E) {
    int tid_ = threadIdx.x; asm volatile("" : "+v"(tid_));
    const int tid = tid_, wid = __builtin_amdgcn_readfirstlane(tid >> 6), lane = tid & 63, wr = wid >> 2, wc = wid & 3, fr = lane & 15, fq = lane >> 4;
    const int K = g.K, nt = K / BK;
    unsigned voffA[2], voffB[2];
#pragma unroll
    for (int i = 0; i < 2; ++i) { int R, C; stage_rc(tid * 16 + i * 8192, R, C); const int Rb = Epi::PERM ? ((R & ~31) + perm32(R & 31)) : R;
        voffA[i] = (unsigned)(R * K + C) * 2u; voffB[i] = (unsigned)(Rb * K + C) * 2u; }
    const size_t kstep = (size_t)(BK * 2);
    const size_t hstep = (size_t)HALF * K * 2;
    const size_t tstep = 2 * hstep;
    const unsigned ldsw = (unsigned)wid * 1024u;
    const int aoff = lds_byte(wr * 64 + fr, fq * 8), boff = lds_byte(wc * 32 + fr, fq * 8);
#define PG8_SA(b, h) (((b) * 2 + (h)) * HTB)
#define PG8_SB(b, h) ((4 + (b) * 2 + (h)) * HTB)
#define PG8_STAGE(bufoff, gbase, voff) do { _Pragma("unroll") for (int _i = 0; _i < 2; ++_i) \
        __builtin_amdgcn_global_load_lds((const unsigned*)((const char*)(gbase) + (voff)[_i]), (PG8_LAS unsigned*)(lds + (bufoff) + ldsw + _i * 8192), 16, 0, 0); } while (0)
#define PG8_LDA(dst, b, h) do { _Pragma("unroll") for (int m = 0; m < 4; ++m) _Pragma("unroll") for (int k = 0; k < 2; ++k) dst[m][k] = *(const PG8_LAS bf16x8*)(lds + PG8_SA(b, h) + aoff + m * 2048 + k * 1024); } while (0)
#define PG8_LDB(dst, b, h) do { _Pragma("unroll") for (int n = 0; n < 2; ++n) _Pragma("unroll") for (int k = 0; k < 2; ++k) dst[n][k] = *(const PG8_LAS bf16x8*)(lds + PG8_SB(b, h) + boff + n * 2048 + k * 1024); } while (0)
#define PG8_MMA(ai, bj, At, Bt) do { __builtin_amdgcn_s_setprio(1); _Pragma("unroll") for (int m = 0; m < 4; ++m) _Pragma("unroll") for (int n = 0; n < 2; ++n) _Pragma("unroll") for (int k = 0; k < 2; ++k) \
        acc[ai][bj][m][n] = __builtin_amdgcn_mfma_f32_16x16x32_bf16(Bt[n][k], At[m][k], acc[ai][bj][m][n], 0, 0, 0); __builtin_amdgcn_s_setprio(0); } while (0)
#define PG8_WAIT_V(n) asm volatile("s_waitcnt vmcnt(" #n ")" ::: "memory")
#define PG8_WAIT_L(n) asm volatile("s_waitcnt lgkmcnt(" #n ")" ::: "memory")
#define PG8_BAR __builtin_amdgcn_s_barrier()
#define PG8_SCHED __builtin_amdgcn_sched_barrier(0)
    Unit cur, nxt; int ui = 0;
    if (!S.next(0, cur)) return;
    f32x4 acc[2][2][4][2];
#pragma unroll
    for (int a = 0; a < 2; ++a)
#pragma unroll
        for (int b = 0; b < 2; ++b)
#pragma unroll
            for (int m = 0; m < 4; ++m)
#pragma unroll
                for (int n = 0; n < 2; ++n) acc[a][b][m][n] = (f32x4){0.f, 0.f, 0.f, 0.f};
    bf16x8 At[4][2], B0[2][2], B1[2][2];
    const char* cA = (const char*)g.A + (size_t)cur.pm * tstep; const char* cB = (const char*)g.Bt + (size_t)cur.pn * tstep;
    S.a_ready(cur);
    if constexpr (SP2) {
        PG8_STAGE(PG8_SB(0, 0), cB, voffB); PG8_STAGE(PG8_SB(0, 1), cB + hstep, voffB); PG8_STAGE(PG8_SA(0, 0), cA, voffA); PG8_STAGE(PG8_SA(0, 1), cA + hstep, voffA);
        if (wr == 1) PG8_BAR;
        PG8_WAIT_V(2); PG8_BAR;
        PG8_STAGE(PG8_SB(1, 0), cB + kstep, voffB); PG8_STAGE(PG8_SA(1, 0), cA + kstep, voffA); PG8_STAGE(PG8_SB(1, 1), cB + hstep + kstep, voffB);
        PG8_WAIT_V(6); PG8_BAR;
    } else {
        PG8_STAGE(PG8_SB(0, 0), cB, voffB); PG8_STAGE(PG8_SA(0, 0), cA, voffA); PG8_STAGE(PG8_SB(0, 1), cB + hstep, voffB); PG8_STAGE(PG8_SA(0, 1), cA + hstep, voffA);
        if (wr == 1) PG8_BAR;
        PG8_WAIT_V(4); PG8_BAR;
        PG8_STAGE(PG8_SB(1, 0), cB + kstep, voffB); PG8_STAGE(PG8_SA(1, 0), cA + kstep, voffA); PG8_STAGE(PG8_SB(1, 1), cB + hstep + kstep, voffB);
        PG8_WAIT_V(6); PG8_BAR;
    }
    for (;;) {
        const bool has_next = S.next(ui + 1, nxt);
        const char* nA = has_next ? (const char*)g.A + (size_t)nxt.pm * tstep : cA; const char* nB = has_next ? (const char*)g.Bt + (size_t)nxt.pn * tstep : cB;
        for (int t = 0; t < nt; t += 2) {
            const bool last = (t == nt - 2);
            const char* a1 = cA + (size_t)(t + 1) * kstep;
            const char* a2 = last ? nA : cA + (size_t)(t + 2) * kstep; const char* b2 = last ? nB : cB + (size_t)(t + 2) * kstep;
            const char* a3 = a2 + kstep; const char* b3 = b2 + kstep;
            if (last && has_next) S.a_ready(nxt);
            if constexpr (SP2) {
            PG8_LDB(B0, 0, 0); PG8_LDB(B1, 0, 1); PG8_SCHED; PG8_LDA(At, 0, 0); PG8_STAGE(PG8_SA(1, 1), a1 + hstep, voffA);
            PG8_WAIT_V(8); PG8_WAIT_L(0); PG8_BAR; PG8_MMA(0, 0, At, B0); PG8_MMA(0, 1, At, B1); PG8_BAR; PG8_SCHED;
            PG8_LDA(At, 0, 1); PG8_STAGE(PG8_SB(0, 0), b2, voffB); PG8_STAGE(PG8_SB(0, 1), b2 + hstep, voffB); PG8_STAGE(PG8_SA(0, 0), a2, voffA);
            PG8_WAIT_V(8); PG8_WAIT_L(0); PG8_BAR; PG8_MMA(1, 0, At, B0); PG8_MMA(1, 1, At, B1); PG8_BAR; PG8_SCHED;
            PG8_LDB(B0, 1, 0); PG8_LDB(B1, 1, 1); PG8_SCHED; PG8_LDA(At, 1, 0); PG8_STAGE(PG8_SA(0, 1), a2 + hstep, voffA);
            PG8_WAIT_V(8); PG8_WAIT_L(0); PG8_BAR; PG8_MMA(0, 0, At, B0); PG8_MMA(0, 1, At, B1); PG8_BAR; PG8_SCHED;
            PG8_LDA(At, 1, 1); PG8_STAGE(PG8_SB(1, 0), b3, voffB); PG8_STAGE(PG8_SB(1, 1), b3 + hstep, voffB); PG8_STAGE(PG8_SA(1, 0), a3, voffA);
            PG8_WAIT_V(8); PG8_WAIT_L(0); PG8_BAR; PG8_MMA(1, 0, At, B0); PG8_MMA(1, 1, At, B1); PG8_BAR; PG8_SCHED;
            } else {
            PG8_LDB(B0, 0, 0); PG8_SCHED; PG8_LDA(At, 0, 0); PG8_STAGE(PG8_SA(1, 1), a1 + hstep, voffA);
            PG8_WAIT_L(8); PG8_BAR; PG8_WAIT_L(0); PG8_MMA(0, 0, At, B0); PG8_BAR; PG8_SCHED;
            PG8_LDB(B1, 0, 1); PG8_STAGE(PG8_SB(0, 0), b2, voffB);
            PG8_BAR; PG8_WAIT_L(0); PG8_MMA(0, 1, At, B1); PG8_BAR;
            PG8_LDA(At, 0, 1); PG8_STAGE(PG8_SA(0, 0), a2, voffA);
            PG8_BAR; PG8_WAIT_L(0); PG8_MMA(1, 0, At, B0); PG8_BAR; PG8_SCHED;
            PG8_STAGE(PG8_SB(0, 1), b2 + hstep, voffB);
            PG8_WAIT_V(6); PG8_BAR; PG8_MMA(1, 1, At, B1); PG8_BAR;
            PG8_LDB(B0, 1, 0); PG8_SCHED; PG8_LDA(At, 1, 0); PG8_STAGE(PG8_SA(0, 1), a2 + hstep, voffA);
            PG8_WAIT_L(8); PG8_BAR; PG8_WAIT_L(0); PG8_MMA(0, 0, At, B0); PG8_BAR; PG8_SCHED;
            PG8_LDB(B1, 1, 1); PG8_STAGE(PG8_SB(1, 0), b3, voffB);
            PG8_BAR; PG8_WAIT_L(0); PG8_MMA(0, 1, At, B1); PG8_BAR;
            PG8_LDA(At, 1, 1); PG8_STAGE(PG8_SA(1, 0), a3, voffA);
            PG8_BAR; PG8_WAIT_L(0); PG8_MMA(1, 0, At, B0); PG8_BAR; PG8_SCHED;
            PG8_STAGE(PG8_SB(1, 1), b3 + hstep, voffB);
            PG8_WAIT_V(6); PG8_BAR; PG8_MMA(1, 1, At, B1); PG8_BAR;
            }
        }
        if constexpr (ALIGN_EPI) { if (wr == 0) PG8_BAR; }
        if constexpr (!Epi::AFTER_DRAIN) { E(acc, cur, wr, wc, fr, fq); S.done(cur); }
        if (!has_next) break;
#pragma unroll
        for (int a = 0; a < 2; ++a)
#pragma unroll
            for (int b = 0; b < 2; ++b)
#pragma unroll
                for (int m = 0; m < 4; ++m)
#pragma unroll
                    for (int n = 0; n < 2; ++n) acc[a][b][m][n] = (f32x4){0.f, 0.f, 0.f, 0.f};
        cur = nxt; cA = nA; cB = nB; ++ui;
        if constexpr (ALIGN_EPI) { if (wr == 1) PG8_BAR; }
    }
    PG8_WAIT_V(0);
    if constexpr (!ALIGN_EPI) { if (wr == 0) PG8_BAR; }
    PG8_BAR;
    if constexpr (Epi::AFTER_DRAIN) { E.fused(acc, cur, wr, wc, fr, fq, lds, wid, lane); S.done(cur); }
#undef PG8_SA
#undef PG8_SB
#undef PG8_STAGE
#undef PG8_LDA
#undef PG8_LDB
#undef PG8_MMA
#undef PG8_WAIT_V
#undef PG8_WAIT_L
#undef PG8_BAR
#undef PG8_SCHED
}
}
#define LAS __attribute__((address_space(3)))
typedef unsigned short bf16;
typedef unsigned v4u __attribute__((ext_vector_type(4)));
typedef unsigned v2u __attribute__((ext_vector_type(2)));
typedef float f32x4 __attribute__((ext_vector_type(4)));
constexpr int SEQ = 4096, BATCH = 8, DM = 1024, M = BATCH * SEQ, NIN = 3328, DEPTH = 2;
constexpr float EPS = 1e-6f;
constexpr float LOG2E = 1.4426950408889634f;
constexpr float QSCALE = 0.125f * LOG2E;
constexpr int C_AQ = 0, C_AK = 256, C_AV = 512, C_AG = 768, C_BU = 1024, C_BV = 1280, C_BG = 1536, C_CX = 1792, C_CG = 2048, C_DQ = 2304, C_DK = 2560, C_DV = 2816, C_DG = 3072;
constexpr size_t MiB = 1u << 20;
constexpr size_t WS_WIN = 0, WS_WOUT = 13 * MiB, WS_SMALL = 17 * MiB, WS_XB = 18 * MiB, WS_PROJ = 82 * MiB, WS_Y = 290 * MiB, WS_Z = 354 * MiB, WS_OG = 418 * MiB, WS_LSE = 466 * MiB, WS_KV = 468 * MiB, WS_R0 = 484 * MiB, WS_CTL = 490 * MiB, WS_PREV = 491 * MiB, WS_RS = 499 * MiB, WS_END = 500 * MiB;
constexpr size_t R0_PPART = 0, R0_Y = 4 * MiB, R0_H = R0_Y + 65536, R0_ZPART = 5 * MiB;
constexpr int R0_KC = 16, R0_KCZ = 8;
constexpr int LDS_BYTES = 147456;
constexpr size_t WS_SGUWB = WS_SMALL + 704 * 1024, WS_PWT = WS_SMALL + 960 * 1024;
constexpr int P_PREG = 0, P_SGUG = 2048, P_SGUW = 2560, P_SGUB = 133632, P_POOLW = 134656, P_POOLS = 167424, P_RETG = 167936, P_POSTG = 168448, P_END = 170496;

__device__ __forceinline__ float bf2f(unsigned short u) { return __uint_as_float(((unsigned)u) << 16); }
__device__ __forceinline__ unsigned f2bf(float f) { unsigned u = __float_as_uint(f); return (u + 0x7fffu + ((u >> 16) & 1u)) >> 16; }
__device__ __forceinline__ unsigned pk2(float lo, float hi) { return f2bf(lo) | (f2bf(hi) << 16); }
__device__ __forceinline__ float wave_sum(float v) {
#pragma unroll
    for (int o = 1; o < 64; o <<= 1) v += __shfl_xor(v, o);
    return v;
}
#define LDS_WAIT() asm volatile("s_waitcnt lgkmcnt(0)" ::: "memory")

struct Params { const float* in[11]; float* out; unsigned char* ws; };

__device__ __forceinline__ void p0_transpose_item(const float* W, int K, int N, bf16* WT, const float* rs, int col_mode, LAS float* scr, int item, int lane) {
    const int nblk = N / 32, kb = item / nblk, nb = item % nblk, k0 = 64 * kb, n0 = 32 * nb;
    float cs = 1.f;
    if (col_mode) { const int n = n0 + (lane & 31); if (n < 256) cs = QSCALE; else if (n >= C_DK && n < C_DK + 256) cs = 0.125f; }
#pragma unroll
    for (int i = 0; i < 32; ++i) { const int kk = 2 * i + (lane >> 5); float v = __builtin_nontemporal_load(W + (size_t)(k0 + kk) * N + n0 + (lane & 31)) * cs; if (rs) v *= rs[k0 + kk]; scr[kk * 33 + (lane & 31)] = v; }
    LDS_WAIT(); asm volatile("" ::: "memory");
    const int c = lane & 7;
#pragma unroll
    for (int j = 0; j < 4; ++j) { const int n = (lane >> 3) + 8 * j; const LAS float* s = scr + (8 * c) * 33 + n;
        v4u o; o.x = pk2(s[0 * 33], s[1 * 33]); o.y = pk2(s[2 * 33], s[3 * 33]); o.z = pk2(s[4 * 33], s[5 * 33]); o.w = pk2(s[6 * 33], s[7 * 33]);
        *(v4u*)(WT + (size_t)(n0 + n) * K + k0 + 8 * c) = o; }
    LDS_WAIT(); asm volatile("" ::: "memory");
}

__device__ __forceinline__ void unpack4(const v2u w, f32x4& o) { o = (f32x4){bf2f((unsigned short)(w.x & 0xffff)), bf2f((unsigned short)(w.x >> 16)), bf2f((unsigned short)(w.y & 0xffff)), bf2f((unsigned short)(w.y >> 16))}; }
__device__ __forceinline__ float ssq4(const f32x4 (&v)[4]) { float s = 0.f;
#pragma unroll
    for (int j = 0; j < 4; ++j) s += (v[j].x * v[j].x + v[j].y * v[j].y) + (v[j].z * v[j].z + v[j].w * v[j].w);
    return s; }
__device__ __forceinline__ void r0z_sum(const float* r0z, int lane, f32x4 (&z)[4]) {
#pragma unroll
    for (int j = 0; j < 4; ++j) { asm volatile("" ::: "memory"); f32x4 a = (f32x4){0.f, 0.f, 0.f, 0.f};
#pragma unroll
        for (int kc = 0; kc < R0_KCZ; ++kc) a += *((const f32x4*)(r0z + (size_t)kc * 8 * DM) + lane + 64 * j);
        z[j] = a; }
}

__device__ __forceinline__ float rdl(float v, int l) { return __int_as_float(__builtin_amdgcn_readlane(__float_as_int(v), l)); }
template <int NB  >
__device__ __forceinline__ void r0_dot_task(const float* h, const float* W, int N, float* part, int task, int nchunks, int lane) {
    const int ch = task % nchunks, kc = task / nchunks, n0 = ch * 64;
    float acc[8];
#pragma unroll
    for (int b = 0; b < 8; ++b) acc[b] = 0.f;
#pragma unroll 1
    for (int sb = 0; sb < NB; ++sb) { const int k0 = (kc * NB + sb) * 32;
        float hv[4], w[32];
#pragma unroll
        for (int i = 0; i < 4; ++i) { const int idx = lane + 64 * i; hv[i] = h[(idx >> 5) * DM + k0 + (idx & 31)]; }
#pragma unroll
        for (int kk = 0; kk < 32; ++kk) w[kk] = __builtin_nontemporal_load(W + (size_t)(k0 + kk) * N + n0 + lane);
#pragma unroll
        for (int kk = 0; kk < 32; ++kk)
#pragma unroll
            for (int b = 0; b < 8; ++b) acc[b] += rdl(hv[b >> 1], (b & 1) * 32 + kk) * w[kk]; }
#pragma unroll
    for (int b = 0; b < 8; ++b) part[((size_t)kc * 8 + b) * N + n0 + lane] = acc[b];
}
__device__ __forceinline__ void r0_dot_sub(const float* h, const float* W, int N, int task, int nchunks, int sb, int lane, float (&acc)[8]) {
    const int ch = task % nchunks, kc = task / nchunks, n0 = ch * 64; const int k0 = (kc * 4 + sb) * 32;
    float hv[4], w[32];
#pragma unroll
    for (int i = 0; i < 4; ++i) { const int idx = lane + 64 * i; hv[i] = h[(idx >> 5) * DM + k0 + (idx & 31)]; }
#pragma unroll
    for (int kk = 0; kk < 32; ++kk) w[kk] = __builtin_nontemporal_load(W + (size_t)(k0 + kk) * N + n0 + lane);
#pragma unroll
    for (int b = 0; b < 8; ++b) acc[b] = 0.f;
#pragma unroll
    for (int kk = 0; kk < 32; ++kk)
#pragma unroll
        for (int b = 0; b < 8; ++b) acc[b] += rdl(hv[b >> 1], (b & 1) * 32 + kk) * w[kk];
}
using pg8::silu_f;
__device__ __forceinline__ void r0_mix(const float* ppart, float* y0, int b, const float* sgu_g, const float* sgu_w, const float* sgu_b, const float* ret_g, LAS float* P, int tid) {
#pragma unroll 2
    for (int n = tid; n < NIN; n += 512) { float a = 0.f;
#pragma unroll
        for (int kc = 0; kc < R0_KC; ++kc) a += ppart[((size_t)kc * 8 + b) * NIN + n];
        P[n] = a; }
    __syncthreads();
    if (tid < 256) { const int lane = tid & 63;
        float sm = 0.f;
#pragma unroll
        for (int i = 0; i < 4; ++i) sm += P[C_BV + lane + 64 * i];
        const float mean = wave_sum(sm) * (1.f / 256.f); float sq = 0.f;
#pragma unroll
        for (int i = 0; i < 4; ++i) { const float d = P[C_BV + lane + 64 * i] - mean; sq += d * d; }
        const float rstd = 1.f / sqrtf(wave_sum(sq) * (1.f / 256.f) + EPS);
        { const int i = tid >> 6; const int c = lane + 64 * i;
            y0[b * DM + c] = P[C_AV + c] * silu_f(P[C_AG + c]);
            const float mixed = sgu_w[(size_t)i * 16384] * ((P[C_BV + c] - mean) * rstd * sgu_g[c]) + sgu_b[i * 128];
            y0[b * DM + 256 + c] = P[C_BU + c] * mixed * silu_f(P[C_BG + c]);
            y0[b * DM + 512 + c] = 0.f;
            const float cc = wave_sum(P[C_DQ + c] * P[C_DK + c]) * 0.125f; const float of = cc * P[C_DV + c];
            const float mu = wave_sum(of) * (1.f / 64.f); const float d0 = of - mu; const float var = wave_sum(d0 * d0) * (1.f / 64.f);
            y0[b * DM + 768 + c] = d0 / sqrtf(var + EPS) * ret_g[c] * silu_f(P[C_DG + c]); } }
    __syncthreads();
}

#define XB_TMO      128
#define XB_XCNT(j)  (256  + 64 * (j))
#define XB_XSUB(j)  (1280 + 64 * (j))
#define XB_XGEN(j)  (2304 + 64 * (j))
#define XB_TOP      3328
#define XB_TOPGEN   3392
#define XCD_BAR_WORDS 3456
#define XB_SPIN_CAP (1u << 18)

__device__ __forceinline__ unsigned xb_ld(unsigned* p)              { return __hip_atomic_load(p, __ATOMIC_RELAXED, __HIP_MEMORY_SCOPE_AGENT); }
__device__ __forceinline__ unsigned xb_add(unsigned* p, unsigned v) { return __hip_atomic_fetch_add(p, v, __ATOMIC_RELAXED, __HIP_MEMORY_SCOPE_AGENT); }
__device__ __forceinline__ unsigned xb_xcc_id() { return (unsigned)__builtin_amdgcn_s_getreg((3 << 11) | 20) & 0xFu; }
#define XB_SPIN(cond, bar) do { unsigned _sp = 0; while (cond) { \
    if ((++_sp & 255u) == 0u) { if (xb_ld(&(bar)[XB_TMO])) break; if (_sp > XB_SPIN_CAP) { atomicAdd(&(bar)[XB_TMO], 1u); break; } } } } while (0)

struct XcdBarrier {
    unsigned* bar; unsigned x;
    volatile LAS unsigned* st;
};

__device__ __forceinline__ XcdBarrier xcd_barrier_post(unsigned* bar, volatile LAS unsigned* st) {
    XcdBarrier b; b.bar = bar; b.x = xb_xcc_id(); b.st = st;
    if (threadIdx.x == 0) (void)xb_add(&bar[XB_XCNT(b.x)], 1u);
    return b;
}
__device__ __forceinline__ void xcd_barrier_complete(unsigned* bar, unsigned x, unsigned& nloc, unsigned& nx) {
    const unsigned G = gridDim.x * gridDim.y * gridDim.z;
    unsigned sum, cnt, mine, sp = 0u;
    for (;;) {
        sum = 0u; cnt = 0u; mine = 0u;
#pragma unroll
        for (unsigned j = 0; j < 16; ++j) { const unsigned c = xb_ld(&bar[XB_XCNT(j)]); sum += c; cnt += (c > 0u) ? 1u : 0u; mine = (j == x) ? c : mine; }
        if (sum == G) break;
        __builtin_amdgcn_s_sleep(1);
        if ((++sp & 255u) == 0u) { if (xb_ld(&bar[XB_TMO])) break; if (sp > XB_SPIN_CAP) { atomicAdd(&bar[XB_TMO], 1u); break; } }
    }
    nloc = mine > 0u ? mine : 1u; nx = cnt > 0u ? cnt : 1u;
}

__device__ __forceinline__ void xcd_barrier(const XcdBarrier& b) {
    asm volatile("s_waitcnt vmcnt(0)" ::: "memory");
    __syncthreads();
    if (threadIdx.x == 0) {
        size_t z0_ = 0; asm volatile("" : "+s"(z0_)); unsigned* bar = b.bar + z0_;
        const unsigned bx = xb_xcc_id();
        __builtin_amdgcn_s_waitcnt(0);
        unsigned nloc = b.st[0], nx = b.st[1];
        if (nloc == 0u) { xcd_barrier_complete(bar, bx, nloc, nx); b.st[0] = nloc; b.st[1] = nx; }
        const unsigned old = xb_add(&bar[XB_XSUB(bx)], 1u);
        const unsigned gen = old / nloc;
        if (old + 1u == (gen + 1u) * nloc) {
            __builtin_amdgcn_fence(__ATOMIC_RELEASE, "agent");
            asm volatile("s_waitcnt vmcnt(0)" ::: "memory");
            const unsigned og = xb_add(&bar[XB_TOP], 1u);
            const unsigned tg = og / nx;
            if (og + 1u == (tg + 1u) * nx) xb_add(&bar[XB_TOPGEN], 1u);
            else XB_SPIN(xb_ld(&bar[XB_TOPGEN]) == tg, bar);
            __builtin_amdgcn_fence(__ATOMIC_ACQUIRE, "agent");
            xb_add(&bar[XB_XGEN(bx)], 1u);
            asm volatile("s_waitcnt vmcnt(0)" ::: "memory");
        } else {
            XB_SPIN(xb_ld(&bar[XB_XGEN(bx)]) == gen, bar);
            __builtin_amdgcn_fence(__ATOMIC_ACQUIRE, "agent");
            asm volatile("s_waitcnt vmcnt(0)" ::: "memory");
        }
    }
    __syncthreads();
}


typedef short bf16x8 __attribute__((ext_vector_type(8)));
typedef float f32x16 __attribute__((ext_vector_type(16)));
typedef float f32x2 __attribute__((ext_vector_type(2)));
typedef __bf16 bf16x2_t __attribute__((ext_vector_type(2)));
__device__ __forceinline__ unsigned cvtpk(float lo, float hi) { f32x2 v = {lo, hi}; return __builtin_bit_cast(unsigned, __builtin_convertvector(v, bf16x2_t)); }
#define MFMA32(a, b, c) __builtin_amdgcn_mfma_f32_32x32x16_bf16((a), (b), (c), 0, 0, 0)
#define PACK8(x, s) __builtin_bit_cast(bf16x8, (v4u){cvtpk((x)[8 * (s)], (x)[8 * (s) + 1]), cvtpk((x)[8 * (s) + 2], (x)[8 * (s) + 3]), cvtpk((x)[8 * (s) + 4], (x)[8 * (s) + 5]), cvtpk((x)[8 * (s) + 6], (x)[8 * (s) + 7])})
__device__ __forceinline__ int crow(int reg, int h) { return (reg & 3) + 8 * (reg >> 2) + 4 * h; }
__device__ __forceinline__ int keyperm(int k) { return (k & ~12) | ((k & 4) << 1) | ((k & 8) >> 1); }
constexpr int KP = 144;
__device__ __forceinline__ int vt_off(int d, int kp, int VP) { return d * VP + ((((kp >> 3) ^ ((d >> 3) & 7))) << 4) + ((kp & 7) << 1); }
__device__ __forceinline__ void vt_write8(LAS unsigned char* Vt, int VP, int c  , int kp, v4u v) {
    LAS unsigned char* base = Vt + (((kp >> 3) ^ c) << 4) + ((kp & 7) << 1) + (8 * c) * VP;
    *(LAS unsigned short*)(base + 0 * VP) = (unsigned short)(v.x & 0xffff); *(LAS unsigned short*)(base + 1 * VP) = (unsigned short)(v.x >> 16);
    *(LAS unsigned short*)(base + 2 * VP) = (unsigned short)(v.y & 0xffff); *(LAS unsigned short*)(base + 3 * VP) = (unsigned short)(v.y >> 16);
    *(LAS unsigned short*)(base + 4 * VP) = (unsigned short)(v.z & 0xffff); *(LAS unsigned short*)(base + 5 * VP) = (unsigned short)(v.z >> 16);
    *(LAS unsigned short*)(base + 6 * VP) = (unsigned short)(v.w & 0xffff); *(LAS unsigned short*)(base + 7 * VP) = (unsigned short)(v.w >> 16);
}

struct AttnU { int b, h, g, dil, res, Q0; };
__device__ __forceinline__ AttnU attn_decode(int u) { AttnU a; const int w16 = u & 15; int t = u >> 4; a.g = t % 3; t /= 3; a.h = t & 3; a.b = t >> 2; a.dil = 1 << (2 * a.g); a.res = w16 & (a.dil - 1); a.Q0 = (w16 >> (2 * a.g)) * 256; return a; }
__device__ __forceinline__ void attn_load(const bf16* proj, const AttnU& a, int tid, v4u (&pk)[6], v4u (&pv)[6]) {
#pragma unroll
    for (int it = 0; it < 6; ++it) { const int idx = tid + it * 512; const int key = idx >> 3, c = idx & 7, i = a.Q0 - 128 + key;
        if (i >= 0) { const bf16* src = proj + ((size_t)a.b * SEQ + (size_t)i * a.dil + a.res) * NIN + a.h * 64 + c * 8; pk[it] = *(const v4u*)(src + C_AK); pv[it] = *(const v4u*)(src + C_AV); } }
}
__device__ __forceinline__ void attn_phase(const bf16* proj, bf16* og, float* lse, int u0, int ustride, int nunits, LAS unsigned char* L, int tid) {
    const int lane = tid & 63, wave = tid >> 6, wave_u = __builtin_amdgcn_readfirstlane(tid >> 6);
    constexpr int VP = 784;
    LAS unsigned char* Kimg = L; LAS unsigned char* Vt = L + 384 * KP;
    v4u pk[6], pv[6];
    if (u0 < nunits) { const AttnU a0 = attn_decode(u0); attn_load(proj, a0, tid, pk, pv); }
#pragma unroll 1
    for (int u = u0; u < nunits; u += ustride) {
        const AttnU a = attn_decode(u);
        const int r = lane & 31, hh = lane >> 5;
        const size_t rowbase = (size_t)a.b * SEQ;
        const size_t qrow = rowbase + (size_t)(a.Q0 + 32 * wave + r) * a.dil + a.res;
        bf16x8 qf[4];
#pragma unroll
        for (int s = 0; s < 4; ++s) qf[s] = *(const bf16x8*)(proj + qrow * NIN + C_AQ + a.h * 64 + 16 * s + 8 * hh);
#pragma unroll
        for (int it = 0; it < 6; ++it) { const int idx = tid + it * 512; const int key = idx >> 3, c = idx & 7, i = a.Q0 - 128 + key;
            if (i >= 0) { *(LAS v4u*)(Kimg + key * KP + c * 16) = pk[it]; vt_write8(Vt, VP, c, keyperm(key), pv[it]); } }
        __syncthreads();
        if (u + ustride < nunits) { const AttnU an = attn_decode(u + ustride); attn_load(proj, an, tid, pk, pv); }
        {
            const float slope2 = exp2f(-2.0f * (float)(a.h + 1)) * LOG2E * (float)a.dil;
            const int jt0 = (a.Q0 == 0 && wave_u < 4) ? 4 - wave_u : 0;
            float mx = -INFINITY, l = 0.f;
            f32x16 O[2];
#pragma unroll
            for (int i = 0; i < 16; ++i) { O[0][i] = 0.f; O[1][i] = 0.f; }
            const LAS unsigned char* kb = Kimg + (32 * wave + r) * KP + 16 * hh;
            bf16x8 kf[4];
#pragma unroll
            for (int s = 0; s < 4; ++s) kf[s] = *(const LAS bf16x8*)(kb + jt0 * (32 * KP) + 32 * s);
#pragma unroll 1
            for (int jt = jt0; jt < 5; ++jt) {
                f32x16 acc;
#pragma unroll
                for (int i = 0; i < 16; ++i) acc[i] = 0.f;
#pragma unroll
                for (int s = 0; s < 4; ++s) acc = MFMA32(kf[s], qf[s], acc);
                if (jt + 1 < 5) {
#pragma unroll
                    for (int s = 0; s < 4; ++s) kf[s] = *(const LAS bf16x8*)(kb + (jt + 1) * (32 * KP) + 32 * s); }
                const float bq = slope2 * (float)(128 + r - 32 * jt); float tmax = -INFINITY;
#pragma unroll
                for (int i = 0; i < 16; ++i) { const int kk = crow(i, hh); float v = acc[i] - bq + slope2 * (float)kk;
                    if (jt == 0 && kk < r) v = -INFINITY; if (jt == 4 && kk > r) v = -INFINITY; acc[i] = v; tmax = fmaxf(tmax, v); }
                tmax = fmaxf(tmax, __shfl_xor(tmax, 32));
                const float mn = fmaxf(mx, tmax), corr = __builtin_amdgcn_exp2f(mx - mn);
                l *= corr;
#pragma unroll
                for (int i = 0; i < 16; ++i) { O[0][i] *= corr; O[1][i] *= corr; }
#pragma unroll
                for (int i = 0; i < 16; ++i) { const float pvv = __builtin_amdgcn_exp2f(acc[i] - mn); acc[i] = pvv; l += pvv; }
                mx = mn;
                const int T = wave + jt;
#pragma unroll
                for (int s = 0; s < 2; ++s) { const bf16x8 pf = PACK8(acc, s);
#pragma unroll
                    for (int dt = 0; dt < 2; ++dt) { const int d = 32 * dt + r, G = 4 * T + 2 * s + hh;
                        const bf16x8 vf = *(const LAS bf16x8*)(Vt + d * VP + ((G ^ ((d >> 3) & 7)) << 4)); O[dt] = MFMA32(vf, pf, O[dt]); } }
            }
            l += __shfl_xor(l, 32);
            const float inv = 1.0f / l;
            bf16* orow = og + ((size_t)a.g * M + qrow) * 256 + a.h * 64;
#pragma unroll
            for (int dt = 0; dt < 2; ++dt)
#pragma unroll
                for (int i4 = 0; i4 < 4; ++i4) { v2u w; w.x = cvtpk(O[dt][4 * i4] * inv, O[dt][4 * i4 + 1] * inv); w.y = cvtpk(O[dt][4 * i4 + 2] * inv, O[dt][4 * i4 + 3] * inv);
                    *(v2u*)(orow + 32 * dt + 8 * i4 + 4 * hh) = w; }
            if (hh == 0) lse[((size_t)a.g * M + qrow) * 4 + a.h] = mx + __builtin_amdgcn_logf(l);
        }
        __syncthreads();
    }
}
__device__ __forceinline__ void attn_combine(const bf16* proj, const bf16* og, const float* lse, bf16* y, int gtid, int gthreads, int iend) {
#pragma unroll 4
    for (int idx = gtid; idx < iend; idx += gthreads) { const int row = idx >> 5, hc = idx & 31, h = hc >> 3, c = hc & 7;
        const size_t off = (size_t)row * 256 + h * 64 + c * 8;
        const float l0 = lse[(size_t)row * 4 + h], l1 = lse[((size_t)M + row) * 4 + h], l2 = lse[((size_t)2 * M + row) * 4 + h];
        const v4u a0 = __builtin_nontemporal_load((const v4u*)(og + off)), a1 = __builtin_nontemporal_load((const v4u*)(og + (size_t)M * 256 + off)), a2 = __builtin_nontemporal_load((const v4u*)(og + (size_t)2 * M * 256 + off));
        const v4u gt = __builtin_nontemporal_load((const v4u*)(proj + (size_t)row * NIN + C_AG + h * 64 + c * 8));
        const float mx = fmaxf(l0, fmaxf(l1, l2)); float w0 = __builtin_amdgcn_exp2f(l0 - mx), w1 = __builtin_amdgcn_exp2f(l1 - mx), w2 = __builtin_amdgcn_exp2f(l2 - mx);
        const float inv = 1.0f / (w0 + w1 + w2); w0 *= inv; w1 *= inv; w2 *= inv;
        v4u o;
#define CMB(f) { const float e0 = (w0 * bf2f((unsigned short)(a0.f & 0xffff)) + w1 * bf2f((unsigned short)(a1.f & 0xffff)) + w2 * bf2f((unsigned short)(a2.f & 0xffff))) * bf2f((unsigned short)(gt.f & 0xffff)); \
                 const float e1 = (w0 * bf2f((unsigned short)(a0.f >> 16)) + w1 * bf2f((unsigned short)(a1.f >> 16)) + w2 * bf2f((unsigned short)(a2.f >> 16))) * bf2f((unsigned short)(gt.f >> 16)); o.f = cvtpk(e0, e1); }
        CMB(x) CMB(y) CMB(z) CMB(w)
#undef CMB
        *(v4u*)(y + (size_t)row * DM + h * 64 + c * 8) = o; }
}

__device__ __forceinline__ void retkv_pair(const bf16* proj, float* kvT, int pair, LAS unsigned char* L, int tid) {
    const int half = tid >> 8, t256 = tid & 255, lane = tid & 63, w4 = (tid >> 6) & 3;
    const int uu = pair * 2 + half, n = uu & 31, h = (uu >> 5) & 3, b = uu >> 7;
    constexpr int VP = 272;
    LAS unsigned char* Vt = L + half * (2 * 64 * VP); LAS unsigned char* Kz = Vt + 64 * VP;
    const float lg2 = __builtin_amdgcn_logf(1.0f - exp2f(-5.0f - (float)h));
    const size_t row0 = (size_t)b * SEQ + n * 128;
#pragma unroll
    for (int it = 0; it < 4; ++it) { const int idx = t256 + it * 256, j = idx >> 3, c = idx & 7;
        const bf16* src = proj + (row0 + j) * NIN + h * 64 + c * 8;
        const v4u kv = *(const v4u*)(src + C_DK), vv = *(const v4u*)(src + C_DV);
        const float z = __builtin_amdgcn_exp2f(lg2 * (float)(127 - j));
        v4u kz; kz.x = cvtpk(bf2f((unsigned short)(kv.x & 0xffff)) * z, bf2f((unsigned short)(kv.x >> 16)) * z); kz.y = cvtpk(bf2f((unsigned short)(kv.y & 0xffff)) * z, bf2f((unsigned short)(kv.y >> 16)) * z);
        kz.z = cvtpk(bf2f((unsigned short)(kv.z & 0xffff)) * z, bf2f((unsigned short)(kv.z >> 16)) * z); kz.w = cvtpk(bf2f((unsigned short)(kv.w & 0xffff)) * z, bf2f((unsigned short)(kv.w >> 16)) * z);
        vt_write8(Kz, VP, c, j, kz); vt_write8(Vt, VP, c, j, vv); }
    __syncthreads();
    { const int r = lane & 31, hh = lane >> 5, et = w4 >> 1, dt = w4 & 1;
      f32x16 acc;
#pragma unroll
      for (int i = 0; i < 16; ++i) acc[i] = 0.f;
      const int e = 32 * et + r, d = 32 * dt + r;
#pragma unroll
      for (int ks = 0; ks < 8; ++ks) { const int G = 2 * ks + hh;
          const bf16x8 af = *(const LAS bf16x8*)(Vt + e * VP + ((G ^ ((e >> 3) & 7)) << 4));
          const bf16x8 bfr = *(const LAS bf16x8*)(Kz + d * VP + ((G ^ ((d >> 3) & 7)) << 4));
          acc = MFMA32(af, bfr, acc); }
      float* o = kvT + (size_t)uu * 4096;
#pragma unroll
      for (int i = 0; i < 16; ++i) o[(32 * et + crow(i, hh)) * 64 + d] = acc[i]; }
    __syncthreads();
}
__device__ __forceinline__ void ret_scan(const float* kvT, bf16* prev, int gtid) {
    if (gtid >= 65536) return;
    const int bh = gtid >> 11, el = (gtid & 2047) * 2, h = bh & 3;
    const float lg2 = __builtin_amdgcn_logf(1.0f - exp2f(-5.0f - (float)h)); const float cd = __builtin_amdgcn_exp2f(lg2 * 128.0f);
    f32x2 v[32];
#pragma unroll
    for (int n = 0; n < 32; ++n) v[n] = __builtin_nontemporal_load((const f32x2*)(kvT + ((size_t)bh * 32 + n) * 4096 + el));
    f32x2 st = (f32x2){0.f, 0.f};
#pragma unroll
    for (int n = 0; n < 32; ++n) { *(unsigned*)(prev + ((size_t)bh * 32 + n) * 4096 + el) = cvtpk(st.x, st.y); st = st * cd + v[n]; }
}
__device__ __forceinline__ void ret_pair(const bf16* proj, const bf16* prev, const float* ret_g, bf16* y, int pair, LAS unsigned char* L, int tid) {
    const int half = tid >> 8, t256 = tid & 255, lane = tid & 63, w4 = (tid >> 6) & 3, w4u = __builtin_amdgcn_readfirstlane((tid >> 6) & 3);
    const int uu = pair * 2 + half, n = uu & 31, h = (uu >> 5) & 3, b = uu >> 7;
    constexpr int VP = 272;
    LAS unsigned char* Kimg = L + half * 45056; LAS unsigned char* Vt = Kimg + 128 * KP; LAS unsigned char* Pv = Vt + 64 * VP;
    const float lg2 = __builtin_amdgcn_logf(1.0f - exp2f(-5.0f - (float)h));
    const size_t row0 = (size_t)b * SEQ + n * 128;
    const int r = lane & 31, hh = lane >> 5, il = 32 * w4 + r;
    const size_t qrow = row0 + il;
    bf16x8 qf[4];
#pragma unroll
    for (int s = 0; s < 4; ++s) qf[s] = *(const bf16x8*)(proj + qrow * NIN + C_DQ + h * 64 + 16 * s + 8 * hh);
    v2u gte[2][4]; f32x4 rge[2][4];
#pragma unroll
    for (int dt = 0; dt < 2; ++dt)
#pragma unroll
        for (int i4 = 0; i4 < 4; ++i4) { const int e = 32 * dt + 8 * i4 + 4 * hh; gte[dt][i4] = *(const v2u*)(proj + qrow * NIN + C_DG + h * 64 + e); rge[dt][i4] = *(const f32x4*)(ret_g + h * 64 + e); }
#pragma unroll
    for (int it = 0; it < 4; ++it) { const int idx = t256 + it * 256, j = idx >> 3, c = idx & 7;
        const bf16* src = proj + (row0 + j) * NIN + h * 64 + c * 8;
        const v4u kv = *(const v4u*)(src + C_DK), vv = *(const v4u*)(src + C_DV);
        *(LAS v4u*)(Kimg + j * KP + c * 16) = kv;
        vt_write8(Vt, VP, c, keyperm(j), vv); }
    { const int e = t256 >> 2, d0 = (t256 & 3) * 16;
      const v4u* pp = (const v4u*)(prev + (size_t)uu * 4096 + e * 64 + d0);
      const v4u w0 = __builtin_nontemporal_load(pp), w1 = __builtin_nontemporal_load(pp + 1);
      *(LAS v4u*)(Pv + e * KP + d0 * 2) = w0; *(LAS v4u*)(Pv + e * KP + d0 * 2 + 16) = w1; }
    __syncthreads();
    {
        f32x16 O[2], C[2];
#pragma unroll
        for (int i = 0; i < 16; ++i) { O[0][i] = 0.f; O[1][i] = 0.f; C[0][i] = 0.f; C[1][i] = 0.f; }
#pragma unroll 1
        for (int T = 0; T <= w4u; ++T) {
            f32x16 acc;
#pragma unroll
            for (int i = 0; i < 16; ++i) acc[i] = 0.f;
#pragma unroll
            for (int s = 0; s < 4; ++s) { const bf16x8 kf = *(const LAS bf16x8*)(Kimg + (32 * T + r) * KP + 32 * s + 16 * hh); acc = MFMA32(kf, qf[s], acc); }
#pragma unroll
            for (int i = 0; i < 16; ++i) { const int diff = il - 32 * T - crow(i, hh); acc[i] = (diff >= 0) ? acc[i] * __builtin_amdgcn_exp2f(lg2 * (float)diff) : 0.f; }
#pragma unroll
            for (int s = 0; s < 2; ++s) { const bf16x8 pf = PACK8(acc, s);
#pragma unroll
                for (int dt = 0; dt < 2; ++dt) { const int d = 32 * dt + r, G = 4 * T + 2 * s + hh;
                    const bf16x8 vf = *(const LAS bf16x8*)(Vt + d * VP + ((G ^ ((d >> 3) & 7)) << 4)); O[dt] = MFMA32(vf, pf, O[dt]); } }
        }
#pragma unroll
        for (int dt = 0; dt < 2; ++dt)
#pragma unroll
            for (int s = 0; s < 4; ++s) { const bf16x8 pf = *(const LAS bf16x8*)(Pv + (32 * dt + r) * KP + 32 * s + 16 * hh); C[dt] = MFMA32(pf, qf[s], C[dt]); }
        const float xi = __builtin_amdgcn_exp2f(lg2 * (float)(il + 1));
        float sm = 0.f;
#pragma unroll
        for (int dt = 0; dt < 2; ++dt)
#pragma unroll
            for (int i = 0; i < 16; ++i) { O[dt][i] += xi * C[dt][i]; sm += O[dt][i]; }
        sm += __shfl_xor(sm, 32); const float mu = sm * (1.f / 64.f); float sq = 0.f;
#pragma unroll
        for (int dt = 0; dt < 2; ++dt)
#pragma unroll
            for (int i = 0; i < 16; ++i) { O[dt][i] -= mu; sq += O[dt][i] * O[dt][i]; }
        sq += __shfl_xor(sq, 32); const float rstd = 1.f / sqrtf(sq * (1.f / 64.f) + EPS);
#pragma unroll
        for (int dt = 0; dt < 2; ++dt)
#pragma unroll
            for (int i4 = 0; i4 < 4; ++i4) { const int e = 32 * dt + 8 * i4 + 4 * hh;
                const f32x4 rg = rge[dt][i4]; const v2u gt = gte[dt][i4];
                v2u w; w.x = cvtpk(O[dt][4 * i4] * rstd * rg.x * bf2f((unsigned short)(gt.x & 0xffff)), O[dt][4 * i4 + 1] * rstd * rg.y * bf2f((unsigned short)(gt.x >> 16)));
                w.y = cvtpk(O[dt][4 * i4 + 2] * rstd * rg.z * bf2f((unsigned short)(gt.y & 0xffff)), O[dt][4 * i4 + 3] * rstd * rg.w * bf2f((unsigned short)(gt.y >> 16)));
                *(v2u*)(y + qrow * DM + 768 + h * 64 + e) = w; }
    }
    __syncthreads();
}

__device__ __forceinline__ void sgu_unit(const bf16* proj, bf16* y, const float* sgu_g, const bf16* wb  , const float* sgu_b, int u, LAS unsigned char* L, int tid) {
    const int lane = tid & 63, wave = tid >> 6;
    constexpr int VP = 272, GI = 64 * VP + 32;
    LAS unsigned char* Vt = L;
    const size_t row0 = (size_t)u * 128;
    { const int s = tid >> 2, q = tid & 3;
      const bf16* src = proj + (row0 + s) * NIN + C_BV + 64 * q;
      v4u w[8];
#pragma unroll
      for (int c = 0; c < 8; ++c) w[c] = *(const v4u*)(src + 8 * c);
      float sm = 0.f, sq = 0.f;
#pragma unroll
      for (int c = 0; c < 8; ++c) {
          const float e0 = bf2f((unsigned short)(w[c].x & 0xffff)), e1 = bf2f((unsigned short)(w[c].x >> 16)), e2 = bf2f((unsigned short)(w[c].y & 0xffff)), e3 = bf2f((unsigned short)(w[c].y >> 16));
          const float e4 = bf2f((unsigned short)(w[c].z & 0xffff)), e5 = bf2f((unsigned short)(w[c].z >> 16)), e6 = bf2f((unsigned short)(w[c].w & 0xffff)), e7 = bf2f((unsigned short)(w[c].w >> 16));
          sm += ((e0 + e1) + (e2 + e3)) + ((e4 + e5) + (e6 + e7));
          sq += ((e0 * e0 + e1 * e1) + (e2 * e2 + e3 * e3)) + ((e4 * e4 + e5 * e5) + (e6 * e6 + e7 * e7)); }
      sm += __shfl_xor(sm, 1); sq += __shfl_xor(sq, 1); sm += __shfl_xor(sm, 2); sq += __shfl_xor(sq, 2);
      const float mean = sm * (1.f / 256.f); const float var = fmaxf(sq * (1.f / 256.f) - mean * mean, 0.f); const float rstd = 1.f / sqrtf(var + EPS);
#pragma unroll
      for (int c = 0; c < 8; ++c) { const f32x4 g0 = *(const f32x4*)(sgu_g + 64 * q + 8 * c), g1 = *(const f32x4*)(sgu_g + 64 * q + 8 * c + 4);
          v4u o; o.x = cvtpk((bf2f((unsigned short)(w[c].x & 0xffff)) - mean) * rstd * g0.x, (bf2f((unsigned short)(w[c].x >> 16)) - mean) * rstd * g0.y);
          o.y = cvtpk((bf2f((unsigned short)(w[c].y & 0xffff)) - mean) * rstd * g0.z, (bf2f((unsigned short)(w[c].y >> 16)) - mean) * rstd * g0.w);
          o.z = cvtpk((bf2f((unsigned short)(w[c].z & 0xffff)) - mean) * rstd * g1.x, (bf2f((unsigned short)(w[c].z >> 16)) - mean) * rstd * g1.y);
          o.w = cvtpk((bf2f((unsigned short)(w[c].w & 0xffff)) - mean) * rstd * g1.z, (bf2f((unsigned short)(w[c].w >> 16)) - mean) * rstd * g1.w);
          vt_write8(Vt + q * GI, VP, c, s, o); } }
    __syncthreads();
    { const int r = lane & 31, hh = lane >> 5, g = wave >> 1, dt = wave & 1, d = 32 * dt + r;
      const LAS unsigned char* vg = Vt + g * GI + d * VP; const int sw = (d >> 3) & 7;
#pragma unroll
      for (int tt = 0; tt < 4; ++tt) { f32x16 acc;
#pragma unroll
          for (int i = 0; i < 16; ++i) acc[i] = 0.f;
          const bf16* wrow = wb + ((size_t)g * 128 + 32 * tt + r) * 128 + 8 * hh;
#pragma unroll
          for (int ks = 0; ks < 2 * (tt + 1); ++ks) { const bf16x8 af = *(const LAS bf16x8*)(vg + (((2 * ks + hh) ^ sw) << 4)); const bf16x8 bfr = *(const bf16x8*)(wrow + 16 * ks); acc = MFMA32(af, bfr, acc); }
          const int t = 32 * tt + r; const size_t row = row0 + t; const float bias = sgu_b[g * 128 + t];
#pragma unroll
          for (int i4 = 0; i4 < 4; ++i4) { const int d0 = 32 * dt + 8 * i4 + 4 * hh;
              const v2u uu = *(const v2u*)(proj + row * NIN + C_BU + g * 64 + d0), gt = *(const v2u*)(proj + row * NIN + C_BG + g * 64 + d0);
              v2u w; w.x = cvtpk((acc[4 * i4] + bias) * bf2f((unsigned short)(uu.x & 0xffff)) * bf2f((unsigned short)(gt.x & 0xffff)), (acc[4 * i4 + 1] + bias) * bf2f((unsigned short)(uu.x >> 16)) * bf2f((unsigned short)(gt.x >> 16)));
              w.y = cvtpk((acc[4 * i4 + 2] + bias) * bf2f((unsigned short)(uu.y & 0xffff)) * bf2f((unsigned short)(gt.y & 0xffff)), (acc[4 * i4 + 3] + bias) * bf2f((unsigned short)(uu.y >> 16)) * bf2f((unsigned short)(gt.y >> 16)));
              *(v2u*)(y + row * DM + 256 + g * 64 + d0) = w; } } }
    __syncthreads();
}
template <int PW>
__device__ __forceinline__ void pool_run(const bf16* src  , LAS unsigned char* dst, int tok  , int AP) {
    v4u x[PW + 7];
#pragma unroll
    for (int q = 0; q < PW + 7; ++q) { const int rel = q - (PW - 1); x[q] = (tok + rel >= 0) ? *(const v4u*)(src + (ptrdiff_t)rel * NIN) : (v4u){0u, 0u, 0u, 0u}; }
    float s[8];
#pragma unroll
    for (int c = 0; c < 8; ++c) s[c] = 0.f;
#define ADDX(q, sg) { s[0] += sg bf2f((unsigned short)(x[q].x & 0xffff)); s[1] += sg bf2f((unsigned short)(x[q].x >> 16)); s[2] += sg bf2f((unsigned short)(x[q].y & 0xffff)); s[3] += sg bf2f((unsigned short)(x[q].y >> 16)); \
                      s[4] += sg bf2f((unsigned short)(x[q].z & 0xffff)); s[5] += sg bf2f((unsigned short)(x[q].z >> 16)); s[6] += sg bf2f((unsigned short)(x[q].w & 0xffff)); s[7] += sg bf2f((unsigned short)(x[q].w >> 16)); }
#pragma unroll
    for (int q = 0; q < PW - 1; ++q) ADDX(q, +)
#pragma unroll
    for (int i = 0; i < 8; ++i) { const int q = PW - 1 + i; ADDX(q, +)
        const int cnt = (tok + i + 1 < PW) ? tok + i + 1 : PW; const float ic = 1.0f / (float)cnt; const v4u w0 = x[q];
        v4u o; o.x = cvtpk(s[0] * ic - bf2f((unsigned short)(w0.x & 0xffff)), s[1] * ic - bf2f((unsigned short)(w0.x >> 16))); o.y = cvtpk(s[2] * ic - bf2f((unsigned short)(w0.y & 0xffff)), s[3] * ic - bf2f((unsigned short)(w0.y >> 16)));
        o.z = cvtpk(s[4] * ic - bf2f((unsigned short)(w0.z & 0xffff)), s[5] * ic - bf2f((unsigned short)(w0.z >> 16))); o.w = cvtpk(s[6] * ic - bf2f((unsigned short)(w0.w & 0xffff)), s[7] * ic - bf2f((unsigned short)(w0.w >> 16)));
        *(LAS v4u*)(dst + i * AP) = o;
        ADDX(i, -) }
#undef ADDX
}
__device__ __forceinline__ void pool_unit(const bf16* proj, bf16* y, const bf16* pwt  , const float* pool_scale, int u, LAS unsigned char* L, int tid) {
    const int lane = tid & 63, wave = tid >> 6;
    constexpr int AP = 528;
    const size_t row0 = (size_t)u * 128; const int tok0 = (u & 31) * 128;
    { const int wu = __builtin_amdgcn_readfirstlane(tid >> 6), g = wu >> 1, c32 = 8 * g + (lane & 7), run = (lane >> 3) + 8 * (wu & 1), t0 = 8 * run;
      const bf16* src = proj + (row0 + t0) * NIN + C_CX + 8 * c32; LAS unsigned char* dst = L + t0 * AP + c32 * 16; const int tk = tok0 + t0;
      if (g == 0) pool_run<2>(src, dst, tk, AP); else if (g == 1) pool_run<4>(src, dst, tk, AP); else if (g == 2) pool_run<8>(src, dst, tk, AP); else pool_run<16>(src, dst, tk, AP); }
    __syncthreads();
    { const int r = lane & 31, hh = lane >> 5, g = wave >> 1, dt = wave & 1;
      bf16x8 af[4];
#pragma unroll
      for (int ks = 0; ks < 4; ++ks) af[ks] = *(const bf16x8*)(pwt + ((size_t)g * 64 + 32 * dt + r) * 64 + 16 * ks + 8 * hh);
      f32x4 sc[4]; v2u gts[4][4];
#pragma unroll
      for (int i4 = 0; i4 < 4; ++i4) { const int d0 = 32 * dt + 8 * i4 + 4 * hh; sc[i4] = *(const f32x4*)(pool_scale + g * 64 + d0);
#pragma unroll
          for (int tt = 0; tt < 4; ++tt) gts[tt][i4] = *(const v2u*)(proj + (row0 + 32 * tt + r) * NIN + C_CG + g * 64 + d0); }
#pragma unroll
      for (int tt = 0; tt < 4; ++tt) { f32x16 acc;
#pragma unroll
          for (int i = 0; i < 16; ++i) acc[i] = 0.f;
#pragma unroll
          for (int ks = 0; ks < 4; ++ks) { const bf16x8 bfr = *(const LAS bf16x8*)(L + (32 * tt + r) * AP + (g * 64 + 16 * ks + 8 * hh) * 2); acc = MFMA32(af[ks], bfr, acc); }
          const size_t row = row0 + 32 * tt + r;
#pragma unroll
          for (int i4 = 0; i4 < 4; ++i4) { const int d0 = 32 * dt + 8 * i4 + 4 * hh; const v2u gt = gts[tt][i4];
              v2u w; w.x = cvtpk(acc[4 * i4] * sc[i4].x * bf2f((unsigned short)(gt.x & 0xffff)), acc[4 * i4 + 1] * sc[i4].y * bf2f((unsigned short)(gt.x >> 16)));
              w.y = cvtpk(acc[4 * i4 + 2] * sc[i4].z * bf2f((unsigned short)(gt.y & 0xffff)), acc[4 * i4 + 3] * sc[i4].w * bf2f((unsigned short)(gt.y >> 16)));
              *(v2u*)(y + row * DM + 512 + g * 64 + d0) = w; } } }
    __syncthreads();
}

#define PHASE_IDS() int tid = threadIdx.x; asm volatile("" : "+v"(tid)); const int lane = tid & 63; const int wave = __builtin_amdgcn_readfirstlane(tid >> 6); const int gw = (int)blockIdx.x * 8 + wave; (void)lane; (void)gw
#define PHASE_PTRS() size_t z0_ = 0; asm volatile("" : "+s"(z0_)); unsigned char* ws = p.ws + z0_;     const float* x = p.in[0]; const float* w_in = p.in[2]; const float* w_out = p.in[9]; \
    const float* PRM = (const float*)(ws + WS_SMALL); bf16* WinT = (bf16*)(ws + WS_WIN); bf16* WoutT = (bf16*)(ws + WS_WOUT); bf16* XB = (bf16*)(ws + WS_XB); bf16* PROJ = (bf16*)(ws + WS_PROJ); \
    bf16* Y = (bf16*)(ws + WS_Y); bf16* Z = (bf16*)(ws + WS_Z); float* KVT = (float*)(ws + WS_KV); bf16* OG = (bf16*)(ws + WS_OG); float* LSE = (float*)(ws + WS_LSE); \
    float* R0P_ = (float*)(ws + WS_R0 + R0_PPART); float* R0Y_ = (float*)(ws + WS_R0 + R0_Y); float* R0Z_ = (float*)(ws + WS_R0 + R0_ZPART); float* R0H_ = (float*)(ws + WS_R0 + R0_H); (void)R0H_; \
    (void)x; (void)w_in; (void)w_out; (void)PRM; (void)WinT; (void)WoutT; (void)XB; (void)PROJ; (void)Y; (void)Z; (void)KVT; (void)OG; (void)LSE; (void)R0P_; (void)R0Y_; (void)R0Z_
#ifndef PROBE_A
#define PROBE_A (-1)
#define PROBE_B (-1)
#endif
#define TS(k) do { if (PROBE_A == (k) && blockIdx.x == 0 && threadIdx.x == 0) *(volatile LAS unsigned long long*)(L + 139280) = __builtin_amdgcn_s_memrealtime(); \
                   if (PROBE_B == (k) && blockIdx.x == 0 && threadIdx.x == 0) *(volatile LAS unsigned long long*)(L + 139288) = __builtin_amdgcn_s_memrealtime() - *(volatile LAS unsigned long long*)(L + 139280); } while (0)
template <int l>
__device__ __forceinline__ void layer_body(const Params& p, LAS unsigned char* L, const XcdBarrier& bar) {
    constexpr int G = 256, NGW = G * 8;

        { PHASE_PTRS(); pg8::Gemm g{XB, WinT + (size_t)l * NIN * DM, M, NIN, DM}; pg8::StaticOrder S; S.init(M, NIN, G, (int)blockIdx.x);
          pg8::EpiOut E{PROJ, NIN, (1u << 3) | (1u << 6) | (1u << 8) | (1u << 12)};
          pg8::gemm_phase<pg8::EpiOut, pg8::StaticOrder, true, true>((PG8_LAS unsigned char*)L, g, S, E); }
        if (l == 0 && (int)blockIdx.x >= 128) { PHASE_IDS(); PHASE_PTRS();
            LAS float* scr = (LAS float*)(L + wave * 16384); const int w1 = ((int)blockIdx.x - 128) * 8 + wave;
            constexpr int I_IN = (DM / 64) * (NIN / 32), I_OUT = (DM / 64) * (DM / 32);
            for (int it = w1; it < 2 * I_OUT + I_IN; it += 1024) {
                if (it < I_OUT) p0_transpose_item(w_out, DM, DM, WoutT, nullptr, 0, scr, it, lane);
                else if (it < 2 * I_OUT) p0_transpose_item(w_out + (size_t)DM * DM, DM, DM, WoutT + (size_t)DM * DM, nullptr, 0, scr, it - I_OUT, lane);
                else p0_transpose_item(w_in + (size_t)DM * NIN, DM, NIN, WinT + (size_t)NIN * DM, PRM + P_PREG + DM, 1, scr, it - 2 * I_OUT, lane); } }
        { PHASE_IDS(); PHASE_PTRS();
          if ((int)blockIdx.x >= 128) for (int task = ((int)blockIdx.x - 128) * 8 + wave; task < 52 * R0_KC; task += 1024) r0_dot_task<2>(R0H_, w_in + (size_t)l * DM * NIN, NIN, R0P_, task, 52, lane); }
        xcd_barrier(bar); TS(1 + 5 * l + 1);
        { PHASE_IDS(); PHASE_PTRS();
          if ((int)blockIdx.x >= 248) r0_mix(R0P_, R0Y_, (int)blockIdx.x - 248, PRM + P_SGUG + l * 256, PRM + P_SGUW + (size_t)l * 65536, PRM + P_SGUB + l * 512, PRM + P_RETG + l * 256, (LAS float*)L, tid); }
        { PHASE_IDS(); PHASE_PTRS(); for (int k = 0; k < 2; ++k) retkv_pair(PROJ, KVT, 64 * ((int)blockIdx.x & 7) + ((int)blockIdx.x >> 3) + 32 * k, L, tid); }
        { PHASE_IDS(); PHASE_PTRS(); const int c = (int)blockIdx.x; attn_phase(PROJ, OG, LSE, 192 * (c & 7) + (c >> 3), 32, 192 * ((c & 7) + 1), L, tid); }
        { PHASE_IDS(); PHASE_PTRS(); { const int u = 32 * ((int)blockIdx.x & 7) + ((int)blockIdx.x >> 3); sgu_unit(PROJ, Y, PRM + P_SGUG + l * 256, (const bf16*)(ws + WS_SGUWB) + (size_t)l * 65536, PRM + P_SGUB + l * 512, u, L, tid); } }
        { PHASE_IDS(); PHASE_PTRS(); { const int u = 32 * ((int)blockIdx.x & 7) + ((int)blockIdx.x >> 3); pool_unit(PROJ, Y, (const bf16*)(ws + WS_PWT) + (size_t)l * 16384, PRM + P_POOLS + l * 256, u, L, tid); } }
        xcd_barrier(bar); TS(1 + 5 * l + 2);
        { PHASE_IDS(); PHASE_PTRS(); ret_scan(KVT, (bf16*)(ws + WS_PREV), (32 * ((int)blockIdx.x & 7) + ((int)blockIdx.x >> 3)) * 256 + tid - ((tid >= 256) ? 256 - 65536 : 0));
          if ((int)blockIdx.x < 16 * R0_KCZ) {
              LAS float* red = (LAS float*)L;
              float acc[8];
              if (wave >= 4) { r0_dot_sub(R0Y_, w_out + (size_t)l * DM * DM, DM, (int)blockIdx.x, 16, wave - 4, lane, acc);
                  if (wave > 4) {
#pragma unroll
                      for (int b = 0; b < 8; ++b) red[((wave - 5) * 8 + b) * 64 + lane] = acc[b]; } }
              __syncthreads();
              if (wave == 4) { const int ch = (int)blockIdx.x % 16, kc = (int)blockIdx.x / 16;
#pragma unroll
                  for (int b = 0; b < 8; ++b) R0Z_[((size_t)kc * 8 + b) * DM + ch * 64 + lane] = ((acc[b] + red[(0 * 8 + b) * 64 + lane]) + red[(1 * 8 + b) * 64 + lane]) + red[(2 * 8 + b) * 64 + lane]; }
              __syncthreads(); } }
        xcd_barrier(bar);
        { PHASE_IDS(); PHASE_PTRS(); for (int k = 0; k < 2; ++k) ret_pair(PROJ, (const bf16*)(ws + WS_PREV), PRM + P_RETG + l * 256, Y, 64 * ((int)blockIdx.x & 7) + ((int)blockIdx.x >> 3) + 32 * k, L, tid);
          attn_combine(PROJ, OG, LSE, Y, ((int)blockIdx.x & 7) * 131072 + ((int)blockIdx.x >> 3) * 512 + tid, 16384, (((int)blockIdx.x & 7) + 1) * 131072); }
        xcd_barrier(bar); TS(1 + 5 * l + 3);
        { PHASE_PTRS(); pg8::Gemm g{Y, WoutT + (size_t)l * DM * DM, M, DM, DM}; pg8::StaticOrder S; S.init(M, DM, G, (int)blockIdx.x);
          pg8::EpiOut E{Z, DM, 0u};
          pg8::gemm_phase<pg8::EpiOut, pg8::StaticOrder, true, true>((PG8_LAS unsigned char*)L, g, S, E); }
        xcd_barrier(bar); TS(1 + 5 * l + 4);
        { PHASE_IDS(); PHASE_PTRS(); const int NR = M / NGW; float* RS = (float*)(ws + WS_RS); float* R0X = (float*)(ws + WS_RS + 262144);
          f32x4 pg[4];
#pragma unroll
          for (int j = 0; j < 4; ++j) pg[j] = *((const f32x4*)(PRM + P_POSTG + l * DM) + lane + 64 * j);
          v2u zc[4], zn[4]; f32x4 xc[4], xn_[4]; v2u bc[4], bn[4];
          { const int m = gw % NGW;
#pragma unroll
            for (int j = 0; j < 4; ++j) { zc[j] = __builtin_nontemporal_load((const v2u*)(Z + (size_t)m * DM) + lane + 64 * j);
                if (l == 0) xc[j] = __builtin_nontemporal_load((const f32x4*)(x + (size_t)m * DM) + lane + 64 * j); else bc[j] = __builtin_nontemporal_load((const v2u*)(XB + (size_t)m * DM) + lane + 64 * j); } }
#pragma unroll 1
          for (int i = 0; i < NR; ++i) { const int m = i * NGW + (gw + i * 257) % NGW; const bool r0 = (m & (SEQ - 1)) == 0;
              if (i + 1 < NR) { const int mn = (i + 1) * NGW + (gw + (i + 1) * 257) % NGW;
#pragma unroll
                  for (int j = 0; j < 4; ++j) { zn[j] = __builtin_nontemporal_load((const v2u*)(Z + (size_t)mn * DM) + lane + 64 * j);
                      if (l == 0) xn_[j] = __builtin_nontemporal_load((const f32x4*)(x + (size_t)mn * DM) + lane + 64 * j); else bn[j] = __builtin_nontemporal_load((const v2u*)(XB + (size_t)mn * DM) + lane + 64 * j); } }
              f32x4 z[4], xv[4];
              if (r0) r0z_sum(R0Z_ + (size_t)(m >> 12) * DM, lane, z);
              else {
#pragma unroll
                  for (int j = 0; j < 4; ++j) unpack4(zc[j], z[j]); }
              if (l == 0) {
#pragma unroll
                  for (int j = 0; j < 4; ++j) xv[j] = xc[j];
              } else if (r0) {
#pragma unroll
                  for (int j = 0; j < 4; ++j) xv[j] = *((const f32x4*)(R0X + (size_t)(m >> 12) * DM) + lane + 64 * j);
              } else { const float rs = RS[m];
#pragma unroll
                  for (int j = 0; j < 4; ++j) { unpack4(bc[j], xv[j]); xv[j] = xv[j] * rs; } }
              const float rstd = 1.f / sqrtf(wave_sum(ssq4(z)) * (1.f / DM) + EPS);
#pragma unroll
              for (int j = 0; j < 4; ++j) xv[j] = xv[j] + z[j] * rstd * pg[j];
              if (l + 1 < DEPTH) {
                  const float q2 = wave_sum(ssq4(xv)) * (1.f / DM) + EPS; const float r2 = 1.f / sqrtf(q2);
                  v2u* o8 = (v2u*)(XB + (size_t)m * DM) + lane;
#pragma unroll
                  for (int j = 0; j < 4; ++j) { v2u w; w.x = cvtpk(xv[j].x * r2, xv[j].y * r2); w.y = cvtpk(xv[j].z * r2, xv[j].w * r2); o8[64 * j] = w; }
                  if (lane == 0) RS[m] = sqrtf(q2);
                  if (r0) {
#pragma unroll
                      for (int j = 0; j < 4; ++j) { *((f32x4*)(R0X + (size_t)(m >> 12) * DM) + lane + 64 * j) = xv[j];
                          *((f32x4*)(R0H_ + (size_t)(m >> 12) * DM) + lane + 64 * j) = xv[j] * r2 * *((const f32x4*)(PRM + P_PREG + (l + 1 < DEPTH ? l + 1 : 0) * DM) + lane + 64 * j); } }
              } else {
                  f32x4* o = (f32x4*)(p.out + (size_t)m * DM) + lane;
#pragma unroll
                  for (int j = 0; j < 4; ++j) __builtin_nontemporal_store(xv[j], o + 64 * j);
              }
#pragma unroll
              for (int j = 0; j < 4; ++j) { zc[j] = zn[j]; xc[j] = xn_[j]; bc[j] = bn[j]; } } }
        if (l + 1 < DEPTH) xcd_barrier(bar); TS(1 + 5 * l + 5);

}

__global__ void __launch_bounds__(512, 2) fwd(Params p) {
    extern __shared__ __attribute__((aligned(16))) unsigned char lds[];
    cg::grid_group grid = cg::this_grid();
    LAS unsigned char* L = (LAS unsigned char*)lds;
    constexpr int G = 256, NGW = G * 8;
    { volatile LAS unsigned* st = (volatile LAS unsigned*)(L + 139264); if (threadIdx.x < 2) st[threadIdx.x] = 0u; }
    __syncthreads();
    TS(0);
    const XcdBarrier bar = xcd_barrier_post((unsigned*)(p.ws + WS_CTL), (volatile LAS unsigned*)(L + 139264));
    {
        PHASE_IDS(); PHASE_PTRS();
        { float* prm = (float*)(ws + WS_SMALL);
          for (int i = (int)blockIdx.x * 512 + tid; i < P_END; i += G * 512) { float v;
              if (i < P_SGUG) v = p.in[1][i]; else if (i < P_SGUW) v = p.in[3][i - P_SGUG]; else if (i < P_SGUB) v = p.in[4][i - P_SGUW]; else if (i < P_POOLW) v = p.in[5][i - P_SGUB];
              else if (i < P_POOLS) v = p.in[6][i - P_POOLW]; else if (i < P_RETG) v = p.in[7][i - P_POOLS]; else if (i < P_POSTG) v = p.in[8][i - P_RETG]; else v = p.in[10][i - P_POSTG];
              prm[i] = v; } }
        { bf16* sw = (bf16*)(ws + WS_SGUWB); bf16* pw = (bf16*)(ws + WS_PWT);
          for (int i = (int)blockIdx.x * 512 + tid; i < 2 * 65536; i += G * 512) { const int s = i & 127, t = (i >> 7) & 127; sw[i] = (s <= t) ? (bf16)f2bf(p.in[4][i]) : (bf16)0; }
          for (int i = (int)blockIdx.x * 512 + tid; i < 2 * 16384; i += G * 512) { const int c = i & 63, d = (i >> 6) & 63, lg = i >> 12; pw[i] = (bf16)f2bf(p.in[6][(size_t)lg * 4096 + c * 64 + d]); } }
        LAS float* scr = (LAS float*)(L + wave * 16384);
        constexpr int I_IN = (DM / 64) * (NIN / 32);
        for (int it = gw; it < I_IN; it += NGW) p0_transpose_item(w_in, DM, NIN, WinT, p.in[1], 1, scr, it, lane);
        { constexpr int NR = M / NGW; f32x4 c0[4], c1[4], n0[4], n1[4];
#define ROWM(i) ((i) * NGW + (gw + (i) * 257) % NGW)
#define LDROW(dst, m) _Pragma("unroll") for (int j = 0; j < 4; ++j) dst[j] = __builtin_nontemporal_load((const f32x4*)(x + (size_t)(m) * DM) + lane + 64 * j)
#define P0ROW(cur, m) { const float rstd = 1.f / sqrtf(wave_sum(ssq4(cur)) * (1.f / DM) + EPS); v2u* o8 = (v2u*)(XB + (size_t)(m) * DM) + lane; \
              _Pragma("unroll") for (int j = 0; j < 4; ++j) { v2u w; w.x = cvtpk(cur[j].x * rstd, cur[j].y * rstd); w.y = cvtpk(cur[j].z * rstd, cur[j].w * rstd); o8[64 * j] = w; } \
              if (((m) & (SEQ - 1)) == 0) { _Pragma("unroll") for (int j = 0; j < 4; ++j) *((f32x4*)(R0H_ + (size_t)((m) >> 12) * DM) + lane + 64 * j) = cur[j] * rstd * *((const f32x4*)p.in[1] + lane + 64 * j); } }
          LDROW(c0, ROWM(0)); LDROW(c1, ROWM(1));
#pragma unroll 1
          for (int i = 0; i < NR; i += 2) {
              if (i + 2 < NR) { LDROW(n0, ROWM(i + 2)); LDROW(n1, ROWM(i + 3)); }
              P0ROW(c0, ROWM(i)); P0ROW(c1, ROWM(i + 1));
#pragma unroll
              for (int j = 0; j < 4; ++j) { c0[j] = n0[j]; c1[j] = n1[j]; } }
#undef LDROW
#undef P0ROW
#undef ROWM
        }
    }
    if (p.ws == nullptr) grid.sync();
    xcd_barrier(bar); TS(1);
    layer_body<0>(p, L, bar);
    layer_body<1>(p, L, bar);
    TS(11);
    if (PROBE_A >= 0 && blockIdx.x == 0 && threadIdx.x == 0) { const unsigned long long d = *(volatile LAS unsigned long long*)(L + 139288), t0 = __builtin_amdgcn_s_memrealtime(); while (__builtin_amdgcn_s_memrealtime() - t0 < 8ull * d) __builtin_amdgcn_s_sleep(8); }
}

extern "C" void kernel_launch(void* const* d_in, const int* in_sizes, int n_in, void* d_out, int out_size, void* d_ws, size_t ws_size, hipStream_t stream) {
    static int grid = 0;
    if (grid == 0) {
        if (n_in != 11 || in_sizes[0] != M * DM || out_size != M * DM || ws_size < WS_END) { fprintf(stderr, "kernel_launch: unexpected shapes (n_in %d, in0 %d, out %d, ws %zu)\n", n_in, n_in > 0 ? in_sizes[0] : -1, out_size, ws_size); grid = -1; return; }
        int dev = 0, cus = 0, per_cu = 0;
        hipGetDevice(&dev); hipDeviceGetAttribute(&cus, hipDeviceAttributeMultiprocessorCount, dev);
        if (hipFuncSetAttribute((const void*)fwd, hipFuncAttributeMaxDynamicSharedMemorySize, LDS_BYTES) != hipSuccess) { fprintf(stderr, "kernel_launch: hipFuncSetAttribute failed\n"); grid = -1; return; }
        if (hipOccupancyMaxActiveBlocksPerMultiprocessor(&per_cu, (const void*)fwd, 512, LDS_BYTES) != hipSuccess || per_cu < 1) { fprintf(stderr, "kernel_launch: occupancy query says %d\n", per_cu); per_cu = 1; }
        (void)hipGetLastError();
        grid = 256;
        if (cus != 256) fprintf(stderr, "kernel_launch: built for a 256-CU device, found %d CUs\n", cus);
        fprintf(stderr, "kernel_launch: cus %d per_cu %d grid %d\n", cus, per_cu, grid);
    }
    if (grid < 0) return;
    if (hipMemsetAsync((char*)d_ws + WS_CTL, 0, 65536, stream) != hipSuccess) { fprintf(stderr, "kernel_launch: memset failed\n"); return; }
    Params p{};
    for (int i = 0; i < 11; ++i) p.in[i] = (const float*)d_in[i];
    p.out = (float*)d_out; p.ws = (unsigned char*)d_ws;
    void* args[] = {&p};
    hipError_t e = hipLaunchCooperativeKernel((const void*)fwd, dim3(grid), dim3(512), args, LDS_BYTES, stream);
    if (e != hipSuccess) fprintf(stderr, "kernel_launch: cooperative launch failed: %s (grid %d)\n", hipGetErrorString(e), grid);
}
```
